# Optimizing an MI355X kernel written in HIP

```python
import math
import jax, jax.numpy as jnp
from jax import lax
import numpy as np

D_MODEL = 1024
BATCH = 8
SEQ = 4096
DEPTH = 4

N_Q_HEADS = 8
N_KV_HEADS = 2
HEAD_DIM = 64
ATTN_WIDTH = N_Q_HEADS * HEAD_DIM
KV_WIDTH = N_KV_HEADS * HEAD_DIM
Q_BLOCK = 128
ROPE_THETA = 10000.0
ROPE_AXIS_DIM = HEAD_DIM // 2
GRID_W = 64
SSM_WIDTH = D_MODEL // 2
SSM_GROUP = 16
SSM_GROUPS = SSM_WIDTH // SSM_GROUP
SSM_STATE = 64
N_DIRS = 2
DT_MIN = 1e-3
DT_MAX = 1e-1
LAMBDA_RE_MAX = -1e-4
MIX_WIDTH = ATTN_WIDTH + SSM_WIDTH
IN_WIDTH = ATTN_WIDTH + 2 * KV_WIDTH + SSM_WIDTH
FFN_HIDDEN = -(-8 * D_MODEL // (3 * 256)) * 256
N_MOD = 6
NORM_EPS = 1e-6

kernel_name = "hymba_style_gqa_s5_bidir_encoder"


def rms_norm(x, gain):
    xf = x.astype(jnp.float32)
    y = xf * lax.rsqrt(jnp.mean(xf * xf, axis=-1, keepdims=True) + NORM_EPS)
    return (y * gain.astype(jnp.float32)).astype(x.dtype)


def axial_rope_tables(seq_len):
    rows = seq_len // GRID_W
    row_idx = jnp.repeat(jnp.arange(rows, dtype=jnp.float32), GRID_W)
    col_idx = jnp.tile(jnp.arange(GRID_W, dtype=jnp.float32), rows)
    inv_freq = 1.0 / (ROPE_THETA ** (jnp.arange(0, ROPE_AXIS_DIM, 2, dtype=jnp.float32) / ROPE_AXIS_DIM))
    ang = jnp.concatenate([row_idx[:, None] * inv_freq, col_idx[:, None] * inv_freq], axis=-1)
    return jnp.cos(ang), jnp.sin(ang)


def apply_rope(x, cos, sin):
    xf = x.astype(jnp.float32).reshape(*x.shape[:-1], HEAD_DIM // 2, 2)
    x1, x2 = xf[..., 0], xf[..., 1]
    cs = cos[None, :, None, :]
    sn = sin[None, :, None, :]
    out = jnp.stack([x1 * cs - x2 * sn, x1 * sn + x2 * cs], axis=-1).reshape(x.shape)
    return out.astype(x.dtype)


def block_attention(q, k, v):
    bsz, seq_len = q.shape[0], q.shape[1]
    n_blocks = seq_len // Q_BLOCK
    rep = N_Q_HEADS // N_KV_HEADS
    scale = HEAD_DIM ** -0.5
    qb = q.reshape(bsz, n_blocks, Q_BLOCK, N_KV_HEADS, rep, HEAD_DIM).transpose(1, 0, 2, 3, 4, 5)

    def one_block(q_blk):
        s = jnp.einsum('bqgrd,bkgd->bgrqk', q_blk, k, preferred_element_type=jnp.float32) * scale
        p = jax.nn.softmax(s, axis=-1)
        return jnp.einsum('bgrqk,bkgd->bqgrd', p.astype(v.dtype), v)

    o = lax.map(one_block, qb)
    return o.transpose(1, 0, 2, 3, 4, 5).reshape(bsz, seq_len, ATTN_WIDTH)


def _ssm_combine(e1, e2):
    a1r, a1i, b1r, b1i = e1
    a2r, a2i, b2r, b2i = e2
    return (a2r * a1r - a2i * a1i,
            a2r * a1i + a2i * a1r,
            a2r * b1r - a2i * b1i + b2r,
            a2r * b1i + a2i * b1r + b2i)


def ssm_direction(u, lam_re, lam_im, log_dt, b_re, b_im, c_re, c_im, reverse):
    lr = jnp.minimum(lam_re.astype(jnp.float32), LAMBDA_RE_MAX)
    li = lam_im.astype(jnp.float32)
    dt = jnp.exp(log_dt.astype(jnp.float32))[:, None]
    mag = jnp.exp(lr * dt)
    a_re = mag * jnp.cos(li * dt)
    a_im = mag * jnp.sin(li * dt)
    den = lr * lr + li * li
    n_re = a_re - 1.0
    k_re = (n_re * lr + a_im * li) / den
    k_im = (a_im * lr - n_re * li) / den
    br = b_re.astype(jnp.float32)
    bi = b_im.astype(jnp.float32)
    bb_re = k_re[..., None] * br - k_im[..., None] * bi
    bb_im = k_re[..., None] * bi + k_im[..., None] * br
    x_re = jnp.einsum('gpc,blgc->blgp', bb_re, u)
    x_im = jnp.einsum('gpc,blgc->blgp', bb_im, u)
    a_re_b = jnp.broadcast_to(a_re, x_re.shape)
    a_im_b = jnp.broadcast_to(a_im, x_im.shape)
    _, _, h_re, h_im = lax.associative_scan(_ssm_combine, (a_re_b, a_im_b, x_re, x_im),
                                            reverse=reverse, axis=1)
    return (jnp.einsum('gcp,blgp->blgc', c_re.astype(jnp.float32), h_re)
            - jnp.einsum('gcp,blgp->blgc', c_im.astype(jnp.float32), h_im))


def ssm_mixer(u, lam_re, lam_im, log_dt, b_re, b_im, c_re, c_im, d_skip, w_glu, b_glu):
    bsz, seq_len = u.shape[0], u.shape[1]
    uf = u.astype(jnp.float32).reshape(bsz, seq_len, SSM_GROUPS, SSM_GROUP)
    y = ssm_direction(uf, lam_re[0], lam_im[0], log_dt[0], b_re[0], b_im[0], c_re[0], c_im[0], False)
    y = y + ssm_direction(uf, lam_re[1], lam_im[1], log_dt[1], b_re[1], b_im[1], c_re[1], c_im[1], True)
    y = y.reshape(bsz, seq_len, SSM_WIDTH) + d_skip.astype(jnp.float32) * uf.reshape(bsz, seq_len, SSM_WIDTH)
    y = jax.nn.gelu(y).astype(u.dtype)
    return y * jax.nn.sigmoid(y @ w_glu + b_glu)


def setup_inputs(seed: int = 0) -> dict:
    key = jax.random.key(seed)
    ks = jax.random.split(key, 24)
    f32 = jnp.float32
    nrm = lambda k, shape, s: jax.random.normal(k, shape, f32) * s
    G, P, C = SSM_GROUPS, SSM_STATE, SSM_GROUP
    lam_im_base = math.pi * jnp.arange(P, dtype=f32)
    return {
        "x": nrm(ks[0], (BATCH, SEQ, D_MODEL), 1.0),
        "c": nrm(ks[1], (BATCH, D_MODEL), 1.0),
        "w_ada": nrm(ks[2], (DEPTH, D_MODEL, N_MOD * D_MODEL), 0.5 * D_MODEL ** -0.5),
        "b_ada": nrm(ks[3], (DEPTH, N_MOD * D_MODEL), 0.01),
        "norm1": 1.0 + nrm(ks[4], (DEPTH, D_MODEL), 0.02),
        "w_in": nrm(ks[5], (DEPTH, D_MODEL, IN_WIDTH), D_MODEL ** -0.5),
        "q_norm": 1.0 + nrm(ks[6], (DEPTH, HEAD_DIM), 0.02),
        "k_norm": 1.0 + nrm(ks[7], (DEPTH, HEAD_DIM), 0.02),
        "ssm_lam_re": -0.5 + nrm(ks[8], (DEPTH, N_DIRS, G, P), 0.01),
        "ssm_lam_im": lam_im_base + nrm(ks[9], (DEPTH, N_DIRS, G, P), 0.01),
        "ssm_log_dt": jax.random.uniform(ks[10], (DEPTH, N_DIRS, G), f32, math.log(DT_MIN), math.log(DT_MAX)),
        "ssm_b_re": nrm(ks[11], (DEPTH, N_DIRS, G, P, C), (2.0 * C) ** -0.5),
        "ssm_b_im": nrm(ks[12], (DEPTH, N_DIRS, G, P, C), (2.0 * C) ** -0.5),
        "ssm_c_re": nrm(ks[13], (DEPTH, N_DIRS, G, C, P), (2.0 * P) ** -0.5),
        "ssm_c_im": nrm(ks[14], (DEPTH, N_DIRS, G, C, P), (2.0 * P) ** -0.5),
        "ssm_d": nrm(ks[15], (DEPTH, SSM_WIDTH), 1.0),
        "w_glu": nrm(ks[16], (DEPTH, SSM_WIDTH, SSM_WIDTH), SSM_WIDTH ** -0.5),
        "b_glu": nrm(ks[17], (DEPTH, SSM_WIDTH), 0.01),
        "attn_out_norm": 1.0 + nrm(ks[18], (DEPTH, ATTN_WIDTH), 0.02),
        "ssm_out_norm": 1.0 + nrm(ks[19], (DEPTH, SSM_WIDTH), 0.02),
        "w_out": nrm(ks[20], (DEPTH, MIX_WIDTH, D_MODEL), MIX_WIDTH ** -0.5),
        "norm2": 1.0 + nrm(ks[21], (DEPTH, D_MODEL), 0.02),
        "w_ffn_in": nrm(ks[22], (DEPTH, D_MODEL, 2 * FFN_HIDDEN), D_MODEL ** -0.5),
        "w_ffn_out": nrm(ks[23], (DEPTH, FFN_HIDDEN, D_MODEL), FFN_HIDDEN ** -0.5),
        "final_norm": 1.0 + nrm(jax.random.fold_in(key, 99), (D_MODEL,), 0.02),
    }


def reference(x, c, w_ada, b_ada, norm1, w_in, q_norm, k_norm, ssm_lam_re, ssm_lam_im, ssm_log_dt,
              ssm_b_re, ssm_b_im, ssm_c_re, ssm_c_im, ssm_d, w_glu, b_glu, attn_out_norm, ssm_out_norm,
              w_out, norm2, w_ffn_in, w_ffn_out, final_norm):
    bsz, seq_len = x.shape[0], x.shape[1]
    cos, sin = axial_rope_tables(seq_len)
    c_act = jax.nn.silu(c)
    split_pts = [ATTN_WIDTH, ATTN_WIDTH + KV_WIDTH, ATTN_WIDTH + 2 * KV_WIDTH]
    for i in range(DEPTH):
        mod = (c_act @ w_ada[i] + b_ada[i])[:, None, :]
        sh1, sc1, g1, sh2, sc2, g2 = jnp.split(mod, N_MOD, axis=-1)
        h = rms_norm(x, norm1[i]) * (1.0 + sc1) + sh1
        z = h @ w_in[i]
        q, k, v, u = jnp.split(z, split_pts, axis=-1)
        q = apply_rope(rms_norm(q.reshape(bsz, seq_len, N_Q_HEADS, HEAD_DIM), q_norm[i]), cos, sin)
        k = apply_rope(rms_norm(k.reshape(bsz, seq_len, N_KV_HEADS, HEAD_DIM), k_norm[i]), cos, sin)
        v = v.reshape(bsz, seq_len, N_KV_HEADS, HEAD_DIM)
        o_attn = block_attention(q, k, v)
        o_ssm = ssm_mixer(u, ssm_lam_re[i], ssm_lam_im[i], ssm_log_dt[i], ssm_b_re[i], ssm_b_im[i],
                          ssm_c_re[i], ssm_c_im[i], ssm_d[i], w_glu[i], b_glu[i])
        mix = jnp.concatenate([rms_norm(o_attn, attn_out_norm[i]), rms_norm(o_ssm, ssm_out_norm[i])], axis=-1)
        x = x + g1 * (mix @ w_out[i])
        h = rms_norm(x, norm2[i]) * (1.0 + sc2) + sh2
        gt, up = jnp.split(h @ w_ffn_in[i], 2, axis=-1)
        x = x + g2 * ((jax.nn.silu(gt) * up) @ w_ffn_out[i])
    return rms_norm(x, final_norm)
```

```cpp
#include <hip/hip_runtime.h>
#include <hip/hip_cooperative_groups.h>
#include <cstdio>
namespace cg = cooperative_groups;

typedef __attribute__((ext_vector_type(8))) short bf16x8;
typedef __attribute__((ext_vector_type(16))) float f32x16;
typedef __attribute__((ext_vector_type(2))) __bf16 bf2v;
typedef __attribute__((ext_vector_type(2))) float f2v;
typedef unsigned short u16;

#define DI __device__ __forceinline__
#define MFMA(a, b, c) __builtin_amdgcn_mfma_f32_32x32x16_bf16((a), (b), (c), 0, 0, 0)

#define DBGS 1.0f

#define DBG_DUMP_OFF OFF_Q
#ifndef MULTI_LAUNCH
#define MULTI_LAUNCH 0
#endif

constexpr int T_TOK = 32768;
constexpr int NPHASE = 31;
constexpr float QSCALE = 0.125f * 1.4426950408889634f;

constexpr size_t OFF_WT_IN  = 0;
constexpr size_t OFF_WT_GLU = OFF_WT_IN + 10485760;
constexpr size_t OFF_WT_OUT = OFF_WT_GLU + 2097152;
constexpr size_t OFF_WT_F1  = OFF_WT_OUT + 8388608;
constexpr size_t OFF_WT_F2  = OFF_WT_F1 + 46137344;
constexpr size_t OFF_MOD    = OFF_WT_F2 + 23068672;
constexpr size_t OFF_BIAS1  = OFF_MOD + 786432;
constexpr size_t OFF_BIAS2  = OFF_BIAS1 + 163840;
constexpr size_t OFF_ROPE   = OFF_BIAS2 + 720896;
constexpr size_t OFF_SSMA   = OFF_ROPE + 8192;
constexpr size_t OFF_SSMBB  = OFF_SSMA + 262144;
constexpr size_t OFF_SSMCC  = OFF_SSMBB + 1048576;
constexpr size_t OFF_E      = OFF_SSMCC + 1048576;
constexpr size_t OFF_SSX    = OFF_E + 4194304;
constexpr size_t OFF_SSA    = OFF_SSX + 2097152;
constexpr size_t OFF_SSS    = OFF_SSA + 1048576;
constexpr size_t OFF_X      = OFF_SSS + 1048576;
constexpr size_t OFF_ACT    = OFF_X + 134217728;
constexpr size_t OFF_UNION  = OFF_ACT + 67108864;
constexpr size_t OFF_HID    = OFF_UNION;
constexpr size_t OFF_Q      = OFF_UNION;
constexpr size_t OFF_K      = OFF_Q + 33554432;
constexpr size_t OFF_VT     = OFF_K + 8388608;
constexpr size_t OFF_U2     = OFF_VT + 8388608;
constexpr size_t OFF_YG     = OFF_U2 + 33554432;
constexpr size_t OFF_OATT   = OFF_YG + 33554432;
constexpr size_t OFF_OSSM   = OFF_OATT + 33554432;
constexpr size_t WS_TOTAL   = OFF_UNION + 184549376;

struct Params {
  const float *x, *c, *w_ada, *b_ada, *norm1, *w_in, *q_norm, *k_norm, *lam_re, *lam_im, *log_dt,
      *b_re, *b_im, *c_re, *c_im, *ssm_d, *w_glu, *b_glu, *attn_out_norm, *ssm_out_norm, *w_out, *norm2,
      *w_ffn_in, *w_ffn_out, *final_norm;
  float* out;
  char* ws;
  int ph_lo, ph_hi;
};

DI unsigned pk(float a, float b) {
  f2v v = {a, b};
  bf2v r = __builtin_convertvector(v, bf2v);
  return __builtin_bit_cast(unsigned, r);
}
DI int tidx() { int t = __builtin_amdgcn_workitem_id_x(); asm volatile("" : "+v"(t)); return t; }
typedef const Params __attribute__((address_space(4)))* KParamPtr;
DI Params kparams() {
#if defined(__HIP_DEVICE_COMPILE__)
  KParamPtr q = (KParamPtr)__builtin_amdgcn_kernarg_segment_ptr();
  asm volatile("" : "+s"(q));
  return *q;
#else
  return Params{};
#endif
}
DI float bf2f(unsigned short h) { return __uint_as_float(((unsigned)h) << 16); }
DI void st_bf4(u16* dst, float a, float b, float c, float d) {
  uint2 v; v.x = pk(a, b); v.y = pk(c, d);
  *(uint2*)dst = v;
}
DI float4 ld_bf4(const u16* src) {
  uint2 v = *(const uint2*)src;
  float4 r;
  r.x = __uint_as_float(v.x << 16); r.y = __uint_as_float(v.x & 0xffff0000u);
  r.z = __uint_as_float(v.y << 16); r.w = __uint_as_float(v.y & 0xffff0000u);
  return r;
}
DI float wave_sum(float v) {
#pragma unroll
  for (int o = 32; o > 0; o >>= 1) v += __shfl_xor(v, o);
  return v;
}
DI int crow(int r, int hf) { return (r & 3) + 8 * (r >> 2) + 4 * hf; }
DI int f1perm(int n) {
  int j = (n < 2816) ? n : n - 2816;
  return (j >> 5) * 64 + (j & 31) + ((n < 2816) ? 0 : 32);
}

DI void transpose_tile(const float* __restrict__ src, int N, u16* __restrict__ dst, int K, int k0, int n0,
                       int permmode, const float* __restrict__ kscale, float* tl) {
  const int tid = tidx();
  __syncthreads();
#pragma unroll 4
  for (int i = 0; i < 16; i++) {
    int r = (tid >> 6) + 4 * i;
    float v = src[(size_t)(k0 + r) * N + n0 + (tid & 63)];
    if (kscale) v *= kscale[k0 + r];
    tl[r * 65 + (tid & 63)] = v;
  }
  __syncthreads();
#pragma unroll 4
  for (int i = 0; i < 8; i++) {
    int n = (tid >> 5) + 8 * i;
    int kp = tid & 31;
    float a = tl[(2 * kp) * 65 + n], b = tl[(2 * kp + 1) * 65 + n];
    int nn = n0 + n;
    int no = permmode ? f1perm(nn) : nn;
    *(unsigned*)(dst + (size_t)no * K + k0 + 2 * kp) = pk(a, b);
  }
}

DI void gemv8_item(const float* vec, int vstride, bool do_silu, const float* __restrict__ W, int N, int j0,
                   const float* bias, float* out, int ostride, int permmode, float* sm) {
  const int tid = tidx();
  float* vs = sm;
  float* red = sm + 8192;
  __syncthreads();
  for (int i = tid; i < 8192; i += 256) {
    int b = i >> 10, k = i & 1023;
    float v = vec[(size_t)b * vstride + k];
    if (do_silu) v = v / (1.f + expf(-v));
    vs[i] = v;
  }
  __syncthreads();
  const int kq = tid >> 6, jj = tid & 63;
  float acc[8];
#pragma unroll
  for (int b = 0; b < 8; b++) acc[b] = 0.f;
#pragma unroll 4
  for (int k = kq * 256; k < kq * 256 + 256; k++) {
    float w = W[(size_t)k * N + j0 + jj];
#pragma unroll
    for (int b = 0; b < 8; b++) acc[b] += vs[b * 1024 + k] * w;
  }
#pragma unroll
  for (int b = 0; b < 8; b++) red[(kq * 8 + b) * 64 + jj] = acc[b];
  __syncthreads();
  for (int o = tid; o < 512; o += 256) {
    int b = o >> 6, j = o & 63;
    float s = red[(0 * 8 + b) * 64 + j] + red[(8 + b) * 64 + j] + red[(16 + b) * 64 + j] + red[(24 + b) * 64 + j];
    int jg = j0 + j;
    if (bias) s += bias[jg];
    int jo = permmode ? f1perm(jg) : jg;
    out[(size_t)b * ostride + jo] = s;
  }
}

DI void ssm_param_item(const Params& p, int idx) {
  const int tid = tidx();
  const int pp = tid & 63, cq = tid >> 6;
  float* SSMA = (float*)(p.ws + OFF_SSMA);
  u16* BB = (u16*)(p.ws + OFF_SSMBB);
  u16* CC = (u16*)(p.ws + OFF_SSMCC);
  double lr = (double)p.lam_re[idx * 64 + pp];
  if (lr > -1e-4) lr = (double)(-1e-4f);
  double li = (double)p.lam_im[idx * 64 + pp];
  double dt = exp((double)p.log_dt[idx]);
  double mag = exp(lr * dt);
  double ar = mag * cos(li * dt), ai = mag * sin(li * dt);
  double den = lr * lr + li * li;
  double nre = ar - 1.0;
  double kre = (nre * lr + ai * li) / den;
  double kim = (ai * lr - nre * li) / den;
  if (cq == 0) {
    double magL = exp(lr * dt * 256.0);
    float4 v;
    v.x = (float)ar; v.y = (float)ai;
    v.z = (float)(magL * cos(li * dt * 256.0)); v.w = (float)(magL * sin(li * dt * 256.0));
    *(float4*)(SSMA + (size_t)(idx * 64 + pp) * 4) = v;
  }
#pragma unroll
  for (int cc = 0; cc < 4; cc++) {
    int c = cq * 4 + cc;
    double br = (double)p.b_re[(size_t)(idx * 64 + pp) * 16 + c];
    double bi = (double)p.b_im[(size_t)(idx * 64 + pp) * 16 + c];
    float bbr = (float)(kre * br - kim * bi);
    float bbi = (float)(kre * bi + kim * br);
    BB[(size_t)(idx * 128 + pp) * 16 + c] = (u16)(pk(bbr, 0.f) & 0xffffu);
    BB[(size_t)(idx * 128 + 64 + pp) * 16 + c] = (u16)(pk(bbi, 0.f) & 0xffffu);
    float cr = p.c_re[(size_t)(idx * 16 + c) * 64 + pp];
    float ci = p.c_im[(size_t)(idx * 16 + c) * 64 + pp];
    *(unsigned*)(CC + (size_t)(idx * 16 + c) * 128 + 2 * pp) = pk(cr, -ci);
  }
}

DI void phase0(char* smem) {
  const Params p = kparams();
  float* sm = (float*)smem;
  constexpr int N_TIN = 4 * 16 * 20, N_TGLU = 4 * 8 * 8, N_TOUT = 4 * 16 * 16, N_TF1 = 4 * 16 * 88, N_TF2 = 4 * 44 * 16;
  constexpr int N_MOD = 4 * 96, N_SSM = 256, N_ROPE = 1;
  constexpr int S0 = N_MOD, S1 = S0 + N_TIN, S2 = S1 + N_TGLU, S3 = S2 + N_TOUT, S4 = S3 + N_TF1, S5 = S4 + N_TF2,
                S6 = S5 + N_SSM, S7 = S6 + N_ROPE;
  for (int it = blockIdx.x; it < S7; it += gridDim.x) {
    if (it < S0) {
      int l = it / 96, jb = it % 96;
      gemv8_item(p.c, 1024, true, p.w_ada + (size_t)l * 1024 * 6144, 6144, jb * 64, p.b_ada + l * 6144,
                 (float*)(p.ws + OFF_MOD) + (size_t)l * 8 * 6144, 6144, 0, sm);
    } else if (it < S1) {
      int r = it - S0; int l = r / 320; r %= 320; int kt = r / 20, ntile = r % 20;
      transpose_tile(p.w_in + (size_t)l * 1024 * 1280, 1280, (u16*)(p.ws + OFF_WT_IN) + (size_t)l * 1280 * 1024, 1024,
                     kt * 64, ntile * 64, 0, nullptr, sm);
    } else if (it < S2) {
      int r = it - S1; int l = r / 64; r %= 64; int kt = r / 8, ntile = r % 8;
      transpose_tile(p.w_glu + (size_t)l * 512 * 512, 512, (u16*)(p.ws + OFF_WT_GLU) + (size_t)l * 512 * 512, 512,
                     kt * 64, ntile * 64, 0, nullptr, sm);
    } else if (it < S3) {
      int r = it - S2; int l = r / 256; r %= 256; int kt = r / 16, ntile = r % 16;
      const float* ks = (kt < 8) ? (p.attn_out_norm + l * 512) : (p.ssm_out_norm + l * 512 - 512);
      transpose_tile(p.w_out + (size_t)l * 1024 * 1024, 1024, (u16*)(p.ws + OFF_WT_OUT) + (size_t)l * 1024 * 1024, 1024,
                     kt * 64, ntile * 64, 0, ks, sm);
    } else if (it < S4) {
      int r = it - S3; int l = r / 1408; r %= 1408; int kt = r / 88, ntile = r % 88;
      transpose_tile(p.w_ffn_in + (size_t)l * 1024 * 5632, 5632, (u16*)(p.ws + OFF_WT_F1) + (size_t)l * 5632 * 1024, 1024,
                     kt * 64, ntile * 64, 1, nullptr, sm);
    } else if (it < S5) {
      int r = it - S4; int l = r / 704; r %= 704; int kt = r / 16, ntile = r % 16;
      transpose_tile(p.w_ffn_out + (size_t)l * 2816 * 1024, 1024, (u16*)(p.ws + OFF_WT_F2) + (size_t)l * 1024 * 2816, 2816,
                     kt * 64, ntile * 64, 0, nullptr, sm);
    } else if (it < S6) {
      ssm_param_item(p, it - S5);
    } else {
      float* rope = (float*)(p.ws + OFF_ROPE);
      for (int i = tidx(); i < 1024; i += 256) {
        int idx = i >> 4, f = i & 15;
        double ang = (double)idx * pow(10000.0, -(double)f / 16.0);
        rope[i] = (float)cos(ang);
        rope[1024 + i] = (float)sin(ang);
      }
    }
  }
}

DI void phase1(char* smem) {
  const Params p = kparams();
  float* sm = (float*)smem;
  const float* MOD = (const float*)(p.ws + OFF_MOD);
  constexpr int N_B1 = 4 * 20, N_B2 = 4 * 88, N_PREP = T_TOK / 4;
  for (int it = blockIdx.x; it < N_B1 + N_B2 + N_PREP; it += gridDim.x) {
    if (it < N_B1) {
      int l = it / 20, jb = it % 20;
      gemv8_item(MOD + (size_t)l * 8 * 6144 + 0, 6144, false, p.w_in + (size_t)l * 1024 * 1280, 1280, jb * 64, nullptr,
                 (float*)(p.ws + OFF_BIAS1) + (size_t)l * 8 * 1280, 1280, 0, sm);
    } else if (it < N_B1 + N_B2) {
      int r = it - N_B1; int l = r / 88, jb = r % 88;
      gemv8_item(MOD + (size_t)l * 8 * 6144 + 3072, 6144, false, p.w_ffn_in + (size_t)l * 1024 * 5632, 5632, jb * 64, nullptr,
                 (float*)(p.ws + OFF_BIAS2) + (size_t)l * 8 * 5632, 5632, 1, sm);
    } else {
      int r = it - N_B1 - N_B2;
      const int lane = tidx() & 63, wave = tidx() >> 6;
      int t = r * 4 + wave;
      int b = t >> 12;
      const float4* xr = (const float4*)(p.x + (size_t)t * 1024);
      float4 v[4];
      float ss = 0.f;
#pragma unroll
      for (int i = 0; i < 4; i++) {
        v[i] = xr[lane + 64 * i];
        ss += v[i].x * v[i].x + v[i].y * v[i].y + v[i].z * v[i].z + v[i].w * v[i].w;
      }
      ss = wave_sum(ss);
      float* SSX = (float*)(p.ws + OFF_SSX);
      if (lane < 16) SSX[(size_t)t * 16 + lane] = (lane == 0) ? ss : 0.f;
      u16* ACT = (u16*)(p.ws + OFF_ACT);
      const float* sc1 = MOD + (size_t)(0 * 8 + b) * 6144 + 1024;
#pragma unroll
      for (int i = 0; i < 4; i++) {
        int k = (lane + 64 * i) * 4;
        float4 g = *(const float4*)(p.norm1 + k);
        float4 s = *(const float4*)(sc1 + k);
        st_bf4(ACT + (size_t)t * 1024 + k, v[i].x * g.x * (1.f + s.x), v[i].y * g.y * (1.f + s.y),
               v[i].z * g.z * (1.f + s.z), v[i].w * g.w * (1.f + s.w));
      }
    }
  }
}

enum { EPI_IN = 0, EPI_GLU = 1, EPI_OUT = 2, EPI_F1 = 3, EPI_F2 = 4 };

DI float row_rinv16(const float* ssx, int t, float invn) {
  const float4* q = (const float4*)(ssx + (size_t)t * 16);
  float4 a = q[0], b = q[1], c = q[2], d = q[3];
  float s = ((a.x + a.y) + (a.z + a.w)) + ((b.x + b.y) + (b.z + b.w)) + ((c.x + c.y) + (c.z + c.w)) + ((d.x + d.y) + (d.z + d.w));
  return rsqrtf(s * invn + 1e-6f);
}
DI float row_rinv8(const float* ss8, int t, float invn) {
  const float4* q = (const float4*)(ss8 + (size_t)t * 8);
  float4 a = q[0], b = q[1];
  float s = ((a.x + a.y) + (a.z + a.w)) + ((b.x + b.y) + (b.z + b.w));
  return rsqrtf(s * invn + 1e-6f);
}

template <int EPI>
DI void gemm_tile(const Params& p, const int l, const int mt, const int nt, char* smem) {
  constexpr int K = (EPI == EPI_GLU) ? 512 : (EPI == EPI_F2 ? 2816 : 1024);
  constexpr int LDA = (EPI == EPI_GLU || EPI == EPI_OUT) ? 512 : (EPI == EPI_F2 ? 2816 : 1024);
  constexpr int KT = K / 64;
  u16* As = (u16*)smem;
  u16* Bs = As + 128 * 72;
  const int tid = tidx(), lane = tid & 63, wave = tid >> 6;
  const int wm = wave >> 1, wn = wave & 1;
  const int hf = lane >> 5, li = lane & 31;
  const int m0 = mt * 128, n0 = nt * 128;

  const u16* A0;
  const u16* A1 = nullptr;
  const u16* W;
  if (EPI == EPI_IN) { A0 = (const u16*)(p.ws + OFF_ACT); W = (const u16*)(p.ws + OFF_WT_IN) + (size_t)l * 1280 * 1024; }
  else if (EPI == EPI_GLU) { A0 = (const u16*)(p.ws + OFF_YG); W = (const u16*)(p.ws + OFF_WT_GLU) + (size_t)l * 512 * 512; }
  else if (EPI == EPI_OUT) { A0 = (const u16*)(p.ws + OFF_OATT); A1 = (const u16*)(p.ws + OFF_OSSM); W = (const u16*)(p.ws + OFF_WT_OUT) + (size_t)l * 1024 * 1024; }
  else if (EPI == EPI_F1) { A0 = (const u16*)(p.ws + OFF_ACT); W = (const u16*)(p.ws + OFF_WT_F1) + (size_t)l * 5632 * 1024; }
  else { A0 = (const u16*)(p.ws + OFF_HID); W = (const u16*)(p.ws + OFF_WT_F2) + (size_t)l * 1024 * 2816; }

  const int lrow = tid >> 3, lc8 = tid & 7;
  const u16* ag0 = A0 + (size_t)(m0 + lrow) * LDA + lc8 * 8;
  const u16* ag1 = (EPI == EPI_OUT) ? (A1 + (size_t)(m0 + lrow) * LDA + lc8 * 8) : nullptr;
  const u16* wg = W + (size_t)(n0 + lrow) * K + lc8 * 8;

  f32x16 acc[2][2];
#pragma unroll
  for (int i = 0; i < 2; i++)
#pragma unroll
    for (int j = 0; j < 2; j++)
#pragma unroll
      for (int r = 0; r < 16; r++) acc[i][j][r] = 0.f;

  uint4 ra0, ra1, ra2, ra3, rb0, rb1, rb2, rb3;
#define GEMM_GLOAD(kt_)                                                                          \
  {                                                                                              \
    const u16* ap;                                                                               \
    if (EPI == EPI_OUT) ap = ((kt_) < 8) ? (ag0 + (kt_) * 64) : (ag1 + ((kt_) - 8) * 64);        \
    else ap = ag0 + (kt_) * 64;                                                                  \
    const u16* wp = wg + (kt_) * 64;                                                             \
    ra0 = *(const uint4*)(ap);                                                                   \
    ra1 = *(const uint4*)(ap + (size_t)32 * LDA);                                                \
    ra2 = *(const uint4*)(ap + (size_t)64 * LDA);                                                \
    ra3 = *(const uint4*)(ap + (size_t)96 * LDA);                                                \
    rb0 = *(const uint4*)(wp);                                                                   \
    rb1 = *(const uint4*)(wp + (size_t)32 * K);                                                  \
    rb2 = *(const uint4*)(wp + (size_t)64 * K);                                                  \
    rb3 = *(const uint4*)(wp + (size_t)96 * K);                                                  \
  }
  GEMM_GLOAD(0);

  int tok[2];
  tok[0] = m0 + wm * 64 + li;
  tok[1] = tok[0] + 32;

  float midr[2] = {1.f, 1.f}, fin[2] = {1.f, 1.f};
  if (EPI == EPI_OUT) {
#pragma unroll
    for (int j = 0; j < 2; j++) {
      float ra_ = row_rinv8((const float*)(p.ws + OFF_SSA), tok[j], 1.f / 512.f);
      float rs_ = row_rinv8((const float*)(p.ws + OFF_SSS), tok[j], 1.f / 512.f);
      midr[j] = ra_ / rs_;
      fin[j] = rs_;
    }
  }

  for (int kt = 0; kt < KT; kt++) {
    __syncthreads();
    *(uint4*)(As + (lrow) * 72 + lc8 * 8) = ra0;
    *(uint4*)(As + (lrow + 32) * 72 + lc8 * 8) = ra1;
    *(uint4*)(As + (lrow + 64) * 72 + lc8 * 8) = ra2;
    *(uint4*)(As + (lrow + 96) * 72 + lc8 * 8) = ra3;
    *(uint4*)(Bs + (lrow) * 72 + lc8 * 8) = rb0;
    *(uint4*)(Bs + (lrow + 32) * 72 + lc8 * 8) = rb1;
    *(uint4*)(Bs + (lrow + 64) * 72 + lc8 * 8) = rb2;
    *(uint4*)(Bs + (lrow + 96) * 72 + lc8 * 8) = rb3;
    __syncthreads();
    if (kt + 1 < KT) GEMM_GLOAD(kt + 1);
    if (EPI == EPI_OUT) {
      if (kt == 8) {
#pragma unroll
        for (int i = 0; i < 2; i++)
#pragma unroll
          for (int j = 0; j < 2; j++)
#pragma unroll
            for (int r = 0; r < 16; r++) acc[i][j][r] *= midr[j];
      }
    }
#pragma unroll
    for (int s = 0; s < 4; s++) {
      bf16x8 wf[2], af[2];
#pragma unroll
      for (int i = 0; i < 2; i++) wf[i] = *(const bf16x8*)(Bs + (wn * 64 + i * 32 + li) * 72 + s * 16 + hf * 8);
#pragma unroll
      for (int j = 0; j < 2; j++) af[j] = *(const bf16x8*)(As + (wm * 64 + j * 32 + li) * 72 + s * 16 + hf * 8);
#pragma unroll
      for (int i = 0; i < 2; i++)
#pragma unroll
        for (int j = 0; j < 2; j++) acc[i][j] = MFMA(wf[i], af[j], acc[i][j]);
    }
  }

  const int b = m0 >> 12;
  const int nbase = n0 + wn * 64;
  const float* MOD = (const float*)(p.ws + OFF_MOD);

  if (EPI == EPI_IN) {
    const float* bias = (const float*)(p.ws + OFF_BIAS1) + (size_t)(l * 8 + b) * 1280;
    const float* SSX = (const float*)(p.ws + OFF_SSX);
    float rinv[2];
    rinv[0] = row_rinv16(SSX, tok[0], 1.f / 1024.f);
    rinv[1] = row_rinv16(SSX, tok[1], 1.f / 1024.f);
#pragma unroll
    for (int i = 0; i < 2; i++)
#pragma unroll
      for (int q4 = 0; q4 < 4; q4++) {
        float4 b4 = *(const float4*)(bias + nbase + i * 32 + 8 * q4 + 4 * hf);
#pragma unroll
        for (int j = 0; j < 2; j++) {
          acc[i][j][4 * q4 + 0] = acc[i][j][4 * q4 + 0] * rinv[j] + b4.x;
          acc[i][j][4 * q4 + 1] = acc[i][j][4 * q4 + 1] * rinv[j] + b4.y;
          acc[i][j][4 * q4 + 2] = acc[i][j][4 * q4 + 2] * rinv[j] + b4.z;
          acc[i][j][4 * q4 + 3] = acc[i][j][4 * q4 + 3] * rinv[j] + b4.w;
        }
      }
    if (nt < 5) {
#pragma unroll
      for (int j = 0; j < 2; j++) {
        const int t = tok[j], pos = t & 4095;
#pragma unroll
        for (int i = 0; i < 2; i++)
#pragma unroll
          for (int q4 = 0; q4 < 4; q4++) {
            const int d0 = i * 32 + 8 * q4 + 4 * hf;
            u16* dst = (nt < 4) ? ((u16*)(p.ws + OFF_Q) + (size_t)t * 512 + (nt * 2 + wn) * 64 + d0)
                                : ((u16*)(p.ws + OFF_K) + ((size_t)(b * 2 + wn) * 4096 + pos) * 64 + d0);
            st_bf4(dst, acc[i][j][4 * q4 + 0], acc[i][j][4 * q4 + 1], acc[i][j][4 * q4 + 2], acc[i][j][4 * q4 + 3]);
          }
      }
    } else if (nt == 5) {
      u16* VT = (u16*)(p.ws + OFF_VT);
#pragma unroll
      for (int j = 0; j < 2; j++) {
        const int pos = tok[j] & 4095;
#pragma unroll
        for (int i = 0; i < 2; i++)
#pragma unroll
          for (int r = 0; r < 16; r++) {
            int d = i * 32 + crow(r, hf);
            VT[((size_t)(b * 2 + wn) * 64 + d) * 4096 + pos] = (u16)(pk(acc[i][j][r], 0.f) & 0xffffu);
          }
      }
    } else {
      u16* U2 = (u16*)(p.ws + OFF_U2);
      const int ch0 = (nt - 6) * 128 + wn * 64;
#pragma unroll
      for (int j = 0; j < 2; j++) {
        const int pos = tok[j] & 4095;
#pragma unroll
        for (int i = 0; i < 2; i++)
#pragma unroll
          for (int q4 = 0; q4 < 4; q4++) {
            int ch = ch0 + i * 32 + 8 * q4 + 4 * hf;
            int g = ch >> 4, c0 = ch & 15;
            st_bf4(U2 + (((size_t)(b * 32 + g)) * 4096 + pos) * 16 + c0, acc[i][j][4 * q4 + 0], acc[i][j][4 * q4 + 1],
                   acc[i][j][4 * q4 + 2], acc[i][j][4 * q4 + 3]);
          }
      }
    }
  } else if (EPI == EPI_GLU) {
    const float* bg = p.b_glu + l * 512;
    const u16* YG = (const u16*)(p.ws + OFF_YG);
    u16* OSSM = (u16*)(p.ws + OFF_OSSM);
    float* SSS = (float*)(p.ws + OFF_SSS);
#pragma unroll
    for (int j = 0; j < 2; j++) {
      const int t = tok[j];
      float ss = 0.f;
#pragma unroll
      for (int i = 0; i < 2; i++)
#pragma unroll
        for (int q4 = 0; q4 < 4; q4++) {
          const int n = nbase + i * 32 + 8 * q4 + 4 * hf;
          float4 b4 = *(const float4*)(bg + n);
          float4 y = ld_bf4(YG + (size_t)t * 512 + n);
          float o0 = y.x / (1.f + __expf(-(acc[i][j][4 * q4 + 0] + b4.x)));
          float o1 = y.y / (1.f + __expf(-(acc[i][j][4 * q4 + 1] + b4.y)));
          float o2 = y.z / (1.f + __expf(-(acc[i][j][4 * q4 + 2] + b4.z)));
          float o3 = y.w / (1.f + __expf(-(acc[i][j][4 * q4 + 3] + b4.w)));
          ss += o0 * o0 + o1 * o1 + o2 * o2 + o3 * o3;
          st_bf4(OSSM + (size_t)t * 512 + n, o0, o1, o2, o3);
        }
      ss += __shfl_xor(ss, 32);
      if (hf == 0) SSS[(size_t)t * 8 + nt * 2 + wn] = ss;
    }
  } else if (EPI == EPI_OUT || EPI == EPI_F2) {
    const float* gate = MOD + (size_t)(l * 8 + b) * 6144 + (EPI == EPI_OUT ? 2048 : 5120);
    const bool has_next = (EPI == EPI_OUT) || (l < 3);
    const float* nrm = (EPI == EPI_OUT) ? (p.norm2 + l * 1024) : (p.norm1 + (l + 1) * 1024);
    const float* scn = (EPI == EPI_OUT) ? (MOD + (size_t)(l * 8 + b) * 6144 + 4096) : (MOD + (size_t)((l + 1) * 8 + b) * 6144 + 1024);
    const float* xin = (EPI == EPI_OUT && l == 0) ? p.x : (const float*)(p.ws + OFF_X);
    float* X = (float*)(p.ws + OFF_X);
    u16* ACT = (u16*)(p.ws + OFF_ACT);
    float* SSX = (float*)(p.ws + OFF_SSX);
#pragma unroll
    for (int j = 0; j < 2; j++) {
      const int t = tok[j];
      float ss = 0.f;
#pragma unroll
      for (int i = 0; i < 2; i++)
#pragma unroll
        for (int q4 = 0; q4 < 4; q4++) {
          const int n = nbase + i * 32 + 8 * q4 + 4 * hf;
          float4 g4 = *(const float4*)(gate + n);
          float4 xi = *(const float4*)(xin + (size_t)t * 1024 + n);
          float4 y;
          y.x = xi.x + g4.x * acc[i][j][4 * q4 + 0] * fin[j];
          y.y = xi.y + g4.y * acc[i][j][4 * q4 + 1] * fin[j];
          y.z = xi.z + g4.z * acc[i][j][4 * q4 + 2] * fin[j];
          y.w = xi.w + g4.w * acc[i][j][4 * q4 + 3] * fin[j];
          *(float4*)(X + (size_t)t * 1024 + n) = y;
          ss += y.x * y.x + y.y * y.y + y.z * y.z + y.w * y.w;
          if (has_next) {
            float4 nr = *(const float4*)(nrm + n);
            float4 sc = *(const float4*)(scn + n);
            st_bf4(ACT + (size_t)t * 1024 + n, y.x * nr.x * (1.f + sc.x), y.y * nr.y * (1.f + sc.y),
                   y.z * nr.z * (1.f + sc.z), y.w * nr.w * (1.f + sc.w));
          }
        }
      ss += __shfl_xor(ss, 32);
      if (hf == 0) SSX[(size_t)t * 16 + nt * 2 + wn] = ss;
    }
  } else {
    const float* bias = (const float*)(p.ws + OFF_BIAS2) + (size_t)(l * 8 + b) * 5632;
    const float* SSX = (const float*)(p.ws + OFF_SSX);
    u16* HID = (u16*)(p.ws + OFF_HID);
    const int jbase = nbase >> 1;
#pragma unroll
    for (int j = 0; j < 2; j++) {
      const int t = tok[j];
      const float rv = row_rinv16(SSX, t, 1.f / 1024.f);
#pragma unroll
      for (int q4 = 0; q4 < 4; q4++) {
        const int ng = nbase + 8 * q4 + 4 * hf;
        float4 bg4 = *(const float4*)(bias + ng);
        float4 bu4 = *(const float4*)(bias + ng + 32);
        float zg0 = acc[0][j][4 * q4 + 0] * rv + bg4.x, zu0 = acc[1][j][4 * q4 + 0] * rv + bu4.x;
        float zg1 = acc[0][j][4 * q4 + 1] * rv + bg4.y, zu1 = acc[1][j][4 * q4 + 1] * rv + bu4.y;
        float zg2 = acc[0][j][4 * q4 + 2] * rv + bg4.z, zu2 = acc[1][j][4 * q4 + 2] * rv + bu4.z;
        float zg3 = acc[0][j][4 * q4 + 3] * rv + bg4.w, zu3 = acc[1][j][4 * q4 + 3] * rv + bu4.w;
        float h0 = zg0 / (1.f + __expf(-zg0)) * zu0;
        float h1 = zg1 / (1.f + __expf(-zg1)) * zu1;
        float h2 = zg2 / (1.f + __expf(-zg2)) * zu2;
        float h3 = zg3 / (1.f + __expf(-zg3)) * zu3;
        st_bf4(HID + (size_t)t * 2816 + jbase + 8 * q4 + 4 * hf, h0, h1, h2, h3);
      }
    }
  }
}

template <int EPI>
DI void gemm_phase(int l, char* smem) {
  const Params p = kparams();
  constexpr int NT = (EPI == EPI_IN) ? 10 : (EPI == EPI_GLU ? 4 : (EPI == EPI_F1 ? 44 : 8));
  constexpr int MT = T_TOK / 128;
  for (int it = blockIdx.x; it < MT * NT; it += gridDim.x) {
    gemm_tile<EPI>(p, l, it / NT, it % NT, smem);
  }
}

DI void attn_item(const Params& p, int item, char* smem) {
  u16* Ks = (u16*)smem;
  u16* Vs = Ks + 64 * 72;
  const int tid = tidx(), lane = tid & 63, wave = tid >> 6;
  const int hf = lane >> 5, li = lane & 31;
  const int xcd = item & 7, local = item >> 3;
  const int pair = xcd * 2 + (local >> 7);
  const int within = local & 127;
  const int hq = within >> 5, qb = within & 31;
  const int b = pair >> 1, kvh = pair & 1, h = kvh * 4 + hq;
  const int t = b * 4096 + qb * 128 + wave * 32 + li;

  const u16* Q = (const u16*)(p.ws + OFF_Q);
  bf16x8 qf[4];
#pragma unroll
  for (int s = 0; s < 4; s++) qf[s] = *(const bf16x8*)(Q + (size_t)t * 512 + h * 64 + 16 * s + 8 * hf);

  f32x16 o0, o1;
#pragma unroll
  for (int r = 0; r < 16; r++) { o0[r] = 0.f; o1[r] = 0.f; }
  float m_run = -1e30f, l_run = 0.f;

  const int lrow = tid >> 3, lc8 = tid & 7;
  const u16* Kg = (const u16*)(p.ws + OFF_K) + (size_t)pair * 4096 * 64 + (size_t)lrow * 64 + lc8 * 8;
  const u16* Vg = (const u16*)(p.ws + OFF_VT) + (size_t)pair * 64 * 4096 + (size_t)lrow * 4096 + lc8 * 8;
  uint4 rk0, rk1, rv0, rv1;
#define ATT_GLOAD(kt_)                                                   \
  {                                                                      \
    rk0 = *(const uint4*)(Kg + (size_t)((kt_) * 64) * 64);               \
    rk1 = *(const uint4*)(Kg + (size_t)((kt_) * 64 + 32) * 64);          \
    rv0 = *(const uint4*)(Vg + (kt_) * 64);                              \
    rv1 = *(const uint4*)(Vg + (size_t)32 * 4096 + (kt_) * 64);          \
  }
  ATT_GLOAD(0);
  const int kap = (li & 0x13) | ((li & 4) << 1) | ((li & 8) >> 1);

  for (int kt = 0; kt < 64; kt++) {
    __syncthreads();
    *(uint4*)(Ks + (lrow) * 72 + lc8 * 8) = rk0;
    *(uint4*)(Ks + (lrow + 32) * 72 + lc8 * 8) = rk1;
    *(uint4*)(Vs + (lrow) * 72 + lc8 * 8) = rv0;
    *(uint4*)(Vs + (lrow + 32) * 72 + lc8 * 8) = rv1;
    __syncthreads();
    if (kt + 1 < 64) ATT_GLOAD(kt + 1);

    f32x16 s0, s1;
#pragma unroll
    for (int r = 0; r < 16; r++) { s0[r] = 0.f; s1[r] = 0.f; }
#pragma unroll
    for (int s = 0; s < 4; s++) {
      bf16x8 kf0 = *(const bf16x8*)(Ks + kap * 72 + 16 * s + 8 * hf);
      bf16x8 kf1 = *(const bf16x8*)(Ks + (32 + kap) * 72 + 16 * s + 8 * hf);
      s0 = MFMA(kf0, qf[s], s0);
      s1 = MFMA(kf1, qf[s], s1);
    }
    float mx = s0[0];
#pragma unroll
    for (int r = 1; r < 16; r++) mx = fmaxf(mx, s0[r]);
#pragma unroll
    for (int r = 0; r < 16; r++) mx = fmaxf(mx, s1[r]);
    mx = fmaxf(mx, __shfl_xor(mx, 32));
    const float mnew = fmaxf(m_run, mx);
    const float alpha = __builtin_amdgcn_exp2f(m_run - mnew);
    m_run = mnew;
    float ps = 0.f;
#pragma unroll
    for (int r = 0; r < 16; r++) { s0[r] = __builtin_amdgcn_exp2f(s0[r] - mnew); ps += s0[r]; }
#pragma unroll
    for (int r = 0; r < 16; r++) { s1[r] = __builtin_amdgcn_exp2f(s1[r] - mnew); ps += s1[r]; }
    l_run = l_run * alpha + ps;
#pragma unroll
    for (int r = 0; r < 16; r++) { o0[r] *= alpha; o1[r] *= alpha; }
#pragma unroll
    for (int sp = 0; sp < 2; sp++) {
      bf16x8 pb;
      {
        unsigned u0 = pk(s0[8 * sp + 0], s0[8 * sp + 1]), u1 = pk(s0[8 * sp + 2], s0[8 * sp + 3]);
        unsigned u2 = pk(s0[8 * sp + 4], s0[8 * sp + 5]), u3 = pk(s0[8 * sp + 6], s0[8 * sp + 7]);
        uint4 uu = make_uint4(u0, u1, u2, u3);
        pb = __builtin_bit_cast(bf16x8, uu);
      }
      bf16x8 vf0 = *(const bf16x8*)(Vs + li * 72 + 16 * sp + 8 * hf);
      bf16x8 vf1 = *(const bf16x8*)(Vs + (32 + li) * 72 + 16 * sp + 8 * hf);
      o0 = MFMA(vf0, pb, o0);
      o1 = MFMA(vf1, pb, o1);
    }
#pragma unroll
    for (int sp = 0; sp < 2; sp++) {
      bf16x8 pb;
      {
        unsigned u0 = pk(s1[8 * sp + 0], s1[8 * sp + 1]), u1 = pk(s1[8 * sp + 2], s1[8 * sp + 3]);
        unsigned u2 = pk(s1[8 * sp + 4], s1[8 * sp + 5]), u3 = pk(s1[8 * sp + 6], s1[8 * sp + 7]);
        uint4 uu = make_uint4(u0, u1, u2, u3);
        pb = __builtin_bit_cast(bf16x8, uu);
      }
      bf16x8 vf0 = *(const bf16x8*)(Vs + li * 72 + 32 + 16 * sp + 8 * hf);
      bf16x8 vf1 = *(const bf16x8*)(Vs + (32 + li) * 72 + 32 + 16 * sp + 8 * hf);
      o0 = MFMA(vf0, pb, o0);
      o1 = MFMA(vf1, pb, o1);
    }
  }
  const float ltot = l_run + __shfl_xor(l_run, 32);
  const float inv = 1.f / ltot;
  u16* OATT = (u16*)(p.ws + OFF_OATT);
  float ss = 0.f;
#pragma unroll
  for (int q4 = 0; q4 < 4; q4++) {
    float a0 = o0[4 * q4 + 0] * inv, a1 = o0[4 * q4 + 1] * inv, a2 = o0[4 * q4 + 2] * inv, a3 = o0[4 * q4 + 3] * inv;
    float c0 = o1[4 * q4 + 0] * inv, c1 = o1[4 * q4 + 1] * inv, c2 = o1[4 * q4 + 2] * inv, c3 = o1[4 * q4 + 3] * inv;
    ss += a0 * a0 + a1 * a1 + a2 * a2 + a3 * a3 + c0 * c0 + c1 * c1 + c2 * c2 + c3 * c3;
    st_bf4(OATT + (size_t)t * 512 + h * 64 + 8 * q4 + 4 * hf, a0, a1, a2, a3);
    st_bf4(OATT + (size_t)t * 512 + h * 64 + 32 + 8 * q4 + 4 * hf, c0, c1, c2, c3);
  }
  ss += __shfl_xor(ss, 32);
  if (hf == 0) ((float*)(p.ws + OFF_SSA))[(size_t)t * 8 + h] = ss;
}

DI bf16x8 ssm_ufrag(const u16* U2, int bp, int g, int tb, int li, int hf) {
  const int seq = (li >> 2) & 1, step = ((li >> 3) << 2) | (li & 3);
  return *(const bf16x8*)(U2 + (((size_t)((2 * bp + seq) * 32 + g)) * 4096 + tb + step) * 16 + 8 * hf);
}

DI void ssm1_item(const Params& p, int l, int item) {
  const int tid = tidx(), lane = tid & 63, wave = tid >> 6;
  const int hf = lane >> 5, li = lane & 31;
  const int w = item * 4 + wave;
  const int ch = w & 15, bp = (w >> 4) & 3, g = (w >> 6) & 31, dir = w >> 11;
  const int idx = (l * 2 + dir) * 32 + g;
  const u16* U2 = (const u16*)(p.ws + OFF_U2);
  const u16* BB = (const u16*)(p.ws + OFF_SSMBB) + (size_t)idx * 128 * 16;
  const float* SA = (const float*)(p.ws + OFF_SSMA) + (size_t)idx * 64 * 4;
  bf16x8 bbf[4];
#pragma unroll
  for (int j = 0; j < 4; j++) bbf[j] = *(const bf16x8*)(BB + (32 * j + li) * 16 + 8 * hf);
  const float4 a0 = *(const float4*)(SA + li * 4);
  const float4 a1 = *(const float4*)(SA + (li + 32) * 4);
  float h0r = 0.f, h0i = 0.f, h1r = 0.f, h1i = 0.f;
  f32x16 zero;
#pragma unroll
  for (int r = 0; r < 16; r++) zero[r] = 0.f;
  for (int it = 0; it < 16; it++) {
    const int tb = ch * 256 + (dir ? (15 - it) : it) * 16;
    bf16x8 uf = ssm_ufrag(U2, bp, g, tb, li, hf);
    f32x16 x0 = MFMA(uf, bbf[0], zero), x1 = MFMA(uf, bbf[1], zero), x2 = MFMA(uf, bbf[2], zero), x3 = MFMA(uf, bbf[3], zero);
    if (dir == 0) {
#pragma unroll
      for (int r = 0; r < 16; r++) {
        float nr = a0.x * h0r - a0.y * h0i + x0[r], ni = a0.x * h0i + a0.y * h0r + x2[r];
        h0r = nr; h0i = ni;
        float mr = a1.x * h1r - a1.y * h1i + x1[r], mi = a1.x * h1i + a1.y * h1r + x3[r];
        h1r = mr; h1i = mi;
      }
    } else {
#pragma unroll
      for (int r = 15; r >= 0; r--) {
        float nr = a0.x * h0r - a0.y * h0i + x0[r], ni = a0.x * h0i + a0.y * h0r + x2[r];
        h0r = nr; h0i = ni;
        float mr = a1.x * h1r - a1.y * h1i + x1[r], mi = a1.x * h1i + a1.y * h1r + x3[r];
        h1r = mr; h1i = mi;
      }
    }
  }
  float* E = (float*)(p.ws + OFF_E) + ((((size_t)(dir * 32 + g) * 8 + (2 * bp + hf)) * 16 + ch) * 64) * 2;
  *(float2*)(E + li * 2) = make_float2(h0r, h0i);
  *(float2*)(E + (li + 32) * 2) = make_float2(h1r, h1i);
}

DI void ssm2_item(const Params& p, int l, int item, char* smem) {
  const int tid = tidx(), lane = tid & 63, wave = tid >> 6;
  const int hf = lane >> 5, li = lane & 31;
  const int w = item * 4 + wave;
  const int ch = w & 15, bp = (w >> 4) & 3, g = w >> 6;
  u16* Hs = (u16*)smem + wave * (32 * 136);
  const u16* U2 = (const u16*)(p.ws + OFF_U2);
  float* YF = (float*)(p.ws + OFF_ACT);
  u16* YG = (u16*)(p.ws + OFF_YG);
  f32x16 zero;
#pragma unroll
  for (int r = 0; r < 16; r++) zero[r] = 0.f;
  const int oseq = li >> 4, ostep = li & 15;
  const int ob = 2 * bp + oseq;

  for (int dir = 0; dir < 2; dir++) {
    const int idx = (l * 2 + dir) * 32 + g;
    const u16* BB = (const u16*)(p.ws + OFF_SSMBB) + (size_t)idx * 128 * 16;
    const u16* CC = (const u16*)(p.ws + OFF_SSMCC) + (size_t)idx * 16 * 128;
    const float* SA = (const float*)(p.ws + OFF_SSMA) + (size_t)idx * 64 * 4;
    bf16x8 bbf[4], ccf[8];
#pragma unroll
    for (int j = 0; j < 4; j++) bbf[j] = *(const bf16x8*)(BB + (32 * j + li) * 16 + 8 * hf);
#pragma unroll
    for (int s = 0; s < 8; s++) {
      bf16x8 v = *(const bf16x8*)(CC + (li & 15) * 128 + 16 * s + 8 * hf);
      if (li >= 16) {
#pragma unroll
        for (int e = 0; e < 8; e++) v[e] = 0;
      }
      ccf[s] = v;
    }
    const float4 a0 = *(const float4*)(SA + li * 4);
    const float4 a1 = *(const float4*)(SA + (li + 32) * 4);
    float h0r = 0.f, h0i = 0.f, h1r = 0.f, h1i = 0.f;
    {
      const float* E = (const float*)(p.ws + OFF_E) + ((((size_t)(dir * 32 + g) * 8 + (2 * bp + hf)) * 16) * 64) * 2;
      if (dir == 0) {
        for (int i = 0; i < ch; i++) {
          float2 e0 = *(const float2*)(E + (size_t)i * 128 + li * 2);
          float2 e1 = *(const float2*)(E + (size_t)i * 128 + (li + 32) * 2);
          float nr = a0.z * h0r - a0.w * h0i + e0.x, ni = a0.z * h0i + a0.w * h0r + e0.y;
          h0r = nr; h0i = ni;
          float mr = a1.z * h1r - a1.w * h1i + e1.x, mi = a1.z * h1i + a1.w * h1r + e1.y;
          h1r = mr; h1i = mi;
        }
      } else {
        for (int i = 15; i > ch; i--) {
          float2 e0 = *(const float2*)(E + (size_t)i * 128 + li * 2);
          float2 e1 = *(const float2*)(E + (size_t)i * 128 + (li + 32) * 2);
          float nr = a0.z * h0r - a0.w * h0i + e0.x, ni = a0.z * h0i + a0.w * h0r + e0.y;
          h0r = nr; h0i = ni;
          float mr = a1.z * h1r - a1.w * h1i + e1.x, mi = a1.z * h1i + a1.w * h1r + e1.y;
          h1r = mr; h1i = mi;
        }
      }
    }
    for (int it = 0; it < 16; it++) {
      const int tb = ch * 256 + (dir ? (15 - it) : it) * 16;
      bf16x8 uf = ssm_ufrag(U2, bp, g, tb, li, hf);
      f32x16 x0 = MFMA(uf, bbf[0], zero), x1 = MFMA(uf, bbf[1], zero), x2 = MFMA(uf, bbf[2], zero), x3 = MFMA(uf, bbf[3], zero);
      __syncthreads();
      if (dir == 0) {
#pragma unroll
        for (int r = 0; r < 16; r++) {
          float nr = a0.x * h0r - a0.y * h0i + x0[r], ni = a0.x * h0i + a0.y * h0r + x2[r];
          h0r = nr; h0i = ni;
          float mr = a1.x * h1r - a1.y * h1i + x1[r], mi = a1.x * h1i + a1.y * h1r + x3[r];
          h1r = mr; h1i = mi;
          *(unsigned*)(Hs + (hf * 16 + r) * 136 + 2 * li) = pk(h0r, h0i);
          *(unsigned*)(Hs + (hf * 16 + r) * 136 + 2 * (li + 32)) = pk(h1r, h1i);
        }
      } else {
#pragma unroll
        for (int r = 15; r >= 0; r--) {
          float nr = a0.x * h0r - a0.y * h0i + x0[r], ni = a0.x * h0i + a0.y * h0r + x2[r];
          h0r = nr; h0i = ni;
          float mr = a1.x * h1r - a1.y * h1i + x1[r], mi = a1.x * h1i + a1.y * h1r + x3[r];
          h1r = mr; h1i = mi;
          *(unsigned*)(Hs + (hf * 16 + r) * 136 + 2 * li) = pk(h0r, h0i);
          *(unsigned*)(Hs + (hf * 16 + r) * 136 + 2 * (li + 32)) = pk(h1r, h1i);
        }
      }
      __syncthreads();
      f32x16 y = zero;
#pragma unroll
      for (int s = 0; s < 8; s++) {
        bf16x8 hfv = *(const bf16x8*)(Hs + li * 136 + 16 * s + 8 * hf);
        y = MFMA(ccf[s], hfv, y);
      }
      const int tt = tb + ostep;
      const size_t yoff = (((size_t)(ob * 32 + g)) * 4096 + tt) * 16;
      if (dir == 0) {
        *(float4*)(YF + yoff + 4 * hf) = make_float4(y[0], y[1], y[2], y[3]);
        *(float4*)(YF + yoff + 8 + 4 * hf) = make_float4(y[4], y[5], y[6], y[7]);
      } else {
        float4 f0 = *(const float4*)(YF + yoff + 4 * hf);
        float4 f1 = *(const float4*)(YF + yoff + 8 + 4 * hf);
        float4 u0 = ld_bf4(U2 + yoff + 4 * hf);
        float4 u1 = ld_bf4(U2 + yoff + 8 + 4 * hf);
        float4 d0 = *(const float4*)(p.ssm_d + l * 512 + g * 16 + 4 * hf);
        float4 d1 = *(const float4*)(p.ssm_d + l * 512 + g * 16 + 8 + 4 * hf);
        float v[8];
        v[0] = f0.x + y[0] + d0.x * u0.x; v[1] = f0.y + y[1] + d0.y * u0.y;
        v[2] = f0.z + y[2] + d0.z * u0.z; v[3] = f0.w + y[3] + d0.w * u0.w;
        v[4] = f1.x + y[4] + d1.x * u1.x; v[5] = f1.y + y[5] + d1.y * u1.y;
        v[6] = f1.z + y[6] + d1.z * u1.z; v[7] = f1.w + y[7] + d1.w * u1.w;
#pragma unroll
        for (int e = 0; e < 8; e++) {
          float xx = v[e];
          float z = 0.7978845608028654f * (xx + 0.044715f * xx * xx * xx);
          float th = 1.f - 2.f / (__expf(2.f * z) + 1.f);
          v[e] = 0.5f * xx * (1.f + th);
        }
        u16* yg = YG + ((size_t)(ob * 4096 + tt)) * 512 + g * 16;
        st_bf4(yg + 4 * hf, v[0], v[1], v[2], v[3]);
        st_bf4(yg + 8 + 4 * hf, v[4], v[5], v[6], v[7]);
      }
    }
    __syncthreads();
  }
}

DI void qkpost_phase(int l) {
  const Params p = kparams();
  const float* ROPE = (const float*)(p.ws + OFF_ROPE);
  const int nrows = T_TOK * 8 + T_TOK * 2;
  for (int r = blockIdx.x * 256 + tidx(); r < nrows; r += gridDim.x * 256) {
    const bool isq = r < T_TOK * 8;
    const int rk = r - T_TOK * 8;
    u16* row = isq ? ((u16*)(p.ws + OFF_Q) + (size_t)r * 64) : ((u16*)(p.ws + OFF_K) + (size_t)rk * 64);
    const int pos = isq ? ((r >> 3) & 4095) : (rk & 4095);
    const float* gn = isq ? (p.q_norm + l * 64) : (p.k_norm + l * 64);
    const float osc = isq ? QSCALE : 1.f;
    float v[64];
#pragma unroll
    for (int c = 0; c < 8; c++) {
      uint4 raw = ((const uint4*)row)[c];
      v[8 * c + 0] = __uint_as_float(raw.x << 16); v[8 * c + 1] = __uint_as_float(raw.x & 0xffff0000u);
      v[8 * c + 2] = __uint_as_float(raw.y << 16); v[8 * c + 3] = __uint_as_float(raw.y & 0xffff0000u);
      v[8 * c + 4] = __uint_as_float(raw.z << 16); v[8 * c + 5] = __uint_as_float(raw.z & 0xffff0000u);
      v[8 * c + 6] = __uint_as_float(raw.w << 16); v[8 * c + 7] = __uint_as_float(raw.w & 0xffff0000u);
    }
    float ss = 0.f;
#pragma unroll
    for (int e = 0; e < 64; e++) ss += v[e] * v[e];
    const float rn = rsqrtf(ss * (1.f / 64.f) + 1e-6f) * osc;
    const int irow = pos >> 6, icol = pos & 63;
#pragma unroll
    for (int c = 0; c < 8; c++) {
      float o[8];
#pragma unroll
      for (int e = 0; e < 4; e++) {
        const int pi = 4 * c + e;
        const int idx = (pi < 16) ? irow : icol;
        const float cs = ROPE[idx * 16 + (pi & 15)];
        const float sn = ROPE[1024 + idx * 16 + (pi & 15)];
        const float y0 = v[2 * pi] * rn * gn[2 * pi], y1 = v[2 * pi + 1] * rn * gn[2 * pi + 1];
        o[2 * e] = y0 * cs - y1 * sn;
        o[2 * e + 1] = y0 * sn + y1 * cs;
      }
      uint4 w;
      w.x = pk(o[0], o[1]); w.y = pk(o[2], o[3]); w.z = pk(o[4], o[5]); w.w = pk(o[6], o[7]);
      ((uint4*)row)[c] = w;
    }
  }
}

DI void attn_phase(char* smem) {
  const Params p = kparams();
  for (int it = blockIdx.x; it < 2048; it += gridDim.x) attn_item(p, it, smem);
}
DI void ssm1_phase(int l) {
  const Params p = kparams();
  for (int it = blockIdx.x; it < 1024; it += gridDim.x) ssm1_item(p, l, it);
}
DI void ssm2_phase(int l, char* smem) {
  const Params p = kparams();
  for (int it = blockIdx.x; it < 512; it += gridDim.x) ssm2_item(p, l, it, smem);
}

DI void final_phase() {
  const Params p = kparams();
  const float* X = (const float*)(p.ws + OFF_X);
  const float* SSX = (const float*)(p.ws + OFF_SSX);
  const int total = T_TOK * 256;
  for (int i = blockIdx.x * 256 + tidx(); i < total; i += gridDim.x * 256) {
    int t = i >> 8, n = (i & 255) * 4;
    float rv = row_rinv16(SSX, t, 1.f / 1024.f);
    float4 x = *(const float4*)(X + (size_t)t * 1024 + n);
    float4 g = *(const float4*)(p.final_norm + n);
    float4 o;
    o.x = x.x * rv * g.x * DBGS; o.y = x.y * rv * g.y * DBGS; o.z = x.z * rv * g.z * DBGS; o.w = x.w * rv * g.w * DBGS;
    *(float4*)(p.out + (size_t)t * 1024 + n) = o;
  }
}

#define GSYNC() do { __threadfence(); grid.sync(); __threadfence(); } while (0)
#ifndef ONLYK
#define ONLYK -1
#endif
#ifndef ENMASK
#define ENMASK 0x7ff
#endif
#define EN(n) ((ONLYK < 0 && ((ENMASK >> (n)) & 1)) || ONLYK == (n))
__global__ void __launch_bounds__(256, 2) mega(Params p_) {
  __shared__ __attribute__((aligned(16))) char smem[40960];
  cg::grid_group grid = cg::this_grid();
#ifdef DBG_COPY
  {
    const Params p = kparams();
    for (int i = blockIdx.x * 256 + tidx(); i < T_TOK * 1024; i += gridDim.x * 256) p.out[i] = p.x[i] * 1.5f;
    return;
  }
#endif
  int ph = p_.ph_lo;
  const int ph_hi = p_.ph_hi;
  if (ph == 0 && ph < ph_hi) {
    if (EN(0)) phase0(smem);
    ph++;
    if (ph < ph_hi) GSYNC();
  }
  if (ph == 1 && ph < ph_hi) {
    if (EN(1)) phase1(smem);
    ph++;
    if (ph < ph_hi) GSYNC();
  }
#ifdef DBG_CUT
  for (; ph < ph_hi && ph < DBG_CUT; ph++) {
    const int l = (ph - 2) / 7, k = (ph - 2) % 7;
    if (k == 0) { gemm_phase<EPI_IN>(l, smem); }
    else if (k == 1) { qkpost_phase(l); ssm1_phase(l); }
    else if (k == 2) { attn_phase(smem); ssm2_phase(l, smem); }
    else if (k == 3) { gemm_phase<EPI_GLU>(l, smem); }
    else if (k == 4) { gemm_phase<EPI_OUT>(l, smem); }
    else if (k == 5) { gemm_phase<EPI_F1>(l, smem); }
    else { gemm_phase<EPI_F2>(l, smem); }
    GSYNC();
  }
  {
    const Params p = kparams();
    const u16* src = (const u16*)(p.ws + DBG_DUMP_OFF);
    for (int i = blockIdx.x * 256 + tidx(); i < T_TOK * 1024; i += gridDim.x * 256) p.out[i] = bf2f(src[i]);
  }
  return;
#endif
  for (; ph < ph_hi && ph < NPHASE - 1; ph++) {
    const int l = (ph - 2) / 7, k = (ph - 2) % 7;
    if (k == 0) { if (EN(3)) gemm_phase<EPI_IN>(l, smem); }
    else if (k == 1) { if (EN(4)) { qkpost_phase(l); ssm1_phase(l); } }
    else if (k == 2) {
      if (EN(5)) attn_phase(smem);
      if (EN(6)) ssm2_phase(l, smem);
    }
    else if (k == 3) { if (EN(7)) gemm_phase<EPI_GLU>(l, smem); }
    else if (k == 4) { if (EN(8)) gemm_phase<EPI_OUT>(l, smem); }
    else if (k == 5) { if (EN(9)) gemm_phase<EPI_F1>(l, smem); }
    else { if (EN(10)) gemm_phase<EPI_F2>(l, smem); }
    if (ph + 1 < ph_hi) GSYNC();
  }
  if (ph == NPHASE - 1 && ph < ph_hi) {
    if (EN(2)) final_phase();
  }
}

extern "C" void kernel_launch(void* const* d_in, const int* in_sizes, int n_in, void* d_out, int out_size, void* d_ws,
                              size_t ws_size, hipStream_t stream) {
  static int grid_blocks = 0;
  if (!grid_blocks) {
    int dev = 0, cus = 0, per_cu = 0;
    hipGetDevice(&dev);
    hipDeviceGetAttribute(&cus, hipDeviceAttributeMultiprocessorCount, dev);
    hipOccupancyMaxActiveBlocksPerMultiprocessor(&per_cu, mega, 256, 0);
    if (per_cu < 1) per_cu = 1;
    if (per_cu > 2) per_cu = 2;
    grid_blocks = cus * per_cu;
    if (ws_size < WS_TOTAL) fprintf(stderr, "kernel_launch: workspace too small: %zu < %zu\n", ws_size, (size_t)WS_TOTAL);
  }
  if (ws_size < WS_TOTAL) return;
  Params p{};
  const float** pp = (const float**)&p;
  for (int i = 0; i < 25; i++) pp[i] = (const float*)d_in[i];
  p.out = (float*)d_out;
  p.ws = (char*)d_ws;
#ifdef DBG_MEMSET
  hipMemsetAsync(d_ws, 0, WS_TOTAL, stream);
#endif
#if MULTI_LAUNCH
  for (int ph = 0; ph < NPHASE; ph++) {
    p.ph_lo = ph; p.ph_hi = ph + 1;
    hipLaunchKernelGGL(mega, dim3(grid_blocks), dim3(256), 0, stream, p);
  }
#else
  p.ph_lo = 0; p.ph_hi = NPHASE;
  void* args[] = {&p};
  hipError_t e = hipLaunchCooperativeKernel((void*)mega, dim3(grid_blocks), dim3(256), args, 0, stream);
  if (e != hipSuccess) fprintf(stderr, "cooperative launch failed: %s (grid %d)\n", hipGetErrorString(e), grid_blocks);
#endif
}
```

```cpp
#include <hip/hip_runtime.h>
#include <hip/hip_cooperative_groups.h>
#include <cstdio>
namespace cg = cooperative_groups;

typedef __attribute__((ext_vector_type(8))) short bf16x8;
typedef __attribute__((ext_vector_type(16))) float f32x16;
typedef __attribute__((ext_vector_type(2))) __bf16 bf2v;
typedef __attribute__((ext_vector_type(2))) float f2v;
typedef unsigned short u16;

#define DI __device__ __forceinline__
#define MFMA(a, b, c) __builtin_amdgcn_mfma_f32_32x32x16_bf16((a), (b), (c), 0, 0, 0)

#define DBGS 1.0f

#define DBG_DUMP_OFF OFF_Q
#ifndef MULTI_LAUNCH
#define MULTI_LAUNCH 0
#endif

constexpr int T_TOK = 32768;
constexpr int NPHASE = 31;
constexpr float QSCALE = 0.125f * 1.4426950408889634f;

constexpr size_t OFF_WT_IN  = 0;
constexpr size_t OFF_WT_GLU = OFF_WT_IN + 10485760;
constexpr size_t OFF_WT_OUT = OFF_WT_GLU + 2097152;
constexpr size_t OFF_WT_F1  = OFF_WT_OUT + 8388608;
constexpr size_t OFF_WT_F2  = OFF_WT_F1 + 46137344;
constexpr size_t OFF_MOD    = OFF_WT_F2 + 23068672;
constexpr size_t OFF_BIAS1  = OFF_MOD + 786432;
constexpr size_t OFF_BIAS2  = OFF_BIAS1 + 163840;
constexpr size_t OFF_ROPE   = OFF_BIAS2 + 720896;
constexpr size_t OFF_SSMA   = OFF_ROPE + 8192;
constexpr size_t OFF_SSMBB  = OFF_SSMA + 262144;
constexpr size_t OFF_SSMCC  = OFF_SSMBB + 1048576;
constexpr size_t OFF_E      = OFF_SSMCC + 1048576;
constexpr size_t OFF_SSX    = OFF_E + 4194304;
constexpr size_t OFF_SSA    = OFF_SSX + 2097152;
constexpr size_t OFF_SSS    = OFF_SSA + 1048576;
constexpr size_t OFF_X      = OFF_SSS + 1048576;
constexpr size_t OFF_ACT    = OFF_X + 134217728;
constexpr size_t OFF_UNION  = OFF_ACT + 67108864;
constexpr size_t OFF_HID    = OFF_UNION;
constexpr size_t OFF_Q      = OFF_UNION;
constexpr size_t OFF_K      = OFF_Q + 33554432;
constexpr size_t OFF_VT     = OFF_K + 8388608;
constexpr size_t OFF_U2     = OFF_VT + 8388608;
constexpr size_t OFF_YG     = OFF_U2 + 33554432;
constexpr size_t OFF_OATT   = OFF_YG + 33554432;
constexpr size_t OFF_OSSM   = OFF_OATT + 33554432;
constexpr size_t OFF_BAR    = OFF_UNION + 184549376;
constexpr size_t WS_TOTAL   = OFF_BAR + 16384;

struct Params {
  const float *x, *c, *w_ada, *b_ada, *norm1, *w_in, *q_norm, *k_norm, *lam_re, *lam_im, *log_dt,
      *b_re, *b_im, *c_re, *c_im, *ssm_d, *w_glu, *b_glu, *attn_out_norm, *ssm_out_norm, *w_out, *norm2,
      *w_ffn_in, *w_ffn_out, *final_norm;
  float* out;
  char* ws;
  int ph_lo, ph_hi;
};

DI unsigned pk(float a, float b) {
  f2v v = {a, b};
  bf2v r = __builtin_convertvector(v, bf2v);
  return __builtin_bit_cast(unsigned, r);
}
DI int tidx() { int t = __builtin_amdgcn_workitem_id_x(); asm volatile("" : "+v"(t)); return t; }
typedef const Params __attribute__((address_space(4)))* KParamPtr;
DI Params kparams() {
#if defined(__HIP_DEVICE_COMPILE__)
  KParamPtr q = (KParamPtr)__builtin_amdgcn_kernarg_segment_ptr();
  asm volatile("" : "+s"(q));
  return *q;
#else
  return Params{};
#endif
}
DI float bf2f(unsigned short h) { return __uint_as_float(((unsigned)h) << 16); }
DI void st_bf4(u16* dst, float a, float b, float c, float d) {
  uint2 v; v.x = pk(a, b); v.y = pk(c, d);
  *(uint2*)dst = v;
}
DI float4 ld_bf4(const u16* src) {
  uint2 v = *(const uint2*)src;
  float4 r;
  r.x = __uint_as_float(v.x << 16); r.y = __uint_as_float(v.x & 0xffff0000u);
  r.z = __uint_as_float(v.y << 16); r.w = __uint_as_float(v.y & 0xffff0000u);
  return r;
}
DI float wave_sum(float v) {
#pragma unroll
  for (int o = 32; o > 0; o >>= 1) v += __shfl_xor(v, o);
  return v;
}
DI int crow(int r, int hf) { return (r & 3) + 8 * (r >> 2) + 4 * hf; }
DI int f1perm(int n) {
  int j = (n < 2816) ? n : n - 2816;
  return (j >> 5) * 64 + (j & 31) + ((n < 2816) ? 0 : 32);
}

DI void transpose_tile(const float* __restrict__ src, int N, u16* __restrict__ dst, int K, int k0, int n0,
                       int permmode, const float* __restrict__ kscale, float* tl) {
  const int tid = tidx();
  __syncthreads();
#pragma unroll 4
  for (int i = 0; i < 16; i++) {
    int r = (tid >> 6) + 4 * i;
    float v = src[(size_t)(k0 + r) * N + n0 + (tid & 63)];
    if (kscale) v *= kscale[k0 + r];
    tl[r * 65 + (tid & 63)] = v;
  }
  __syncthreads();
#pragma unroll 4
  for (int i = 0; i < 8; i++) {
    int n = (tid >> 5) + 8 * i;
    int kp = tid & 31;
    float a = tl[(2 * kp) * 65 + n], b = tl[(2 * kp + 1) * 65 + n];
    int nn = n0 + n;
    int no = permmode ? f1perm(nn) : nn;
    *(unsigned*)(dst + (size_t)no * K + k0 + 2 * kp) = pk(a, b);
  }
}

DI void gemv8_item(const float* vec, int vstride, bool do_silu, const float* __restrict__ W, int N, int j0,
                   const float* bias, float* out, int ostride, int permmode, float* sm) {
  const int tid = tidx();
  float* vs = sm;
  float* red = sm + 8192;
  __syncthreads();
  for (int i = tid; i < 8192; i += 256) {
    int b = i >> 10, k = i & 1023;
    float v = vec[(size_t)b * vstride + k];
    if (do_silu) v = v / (1.f + expf(-v));
    vs[i] = v;
  }
  __syncthreads();
  const int kq = tid >> 6, jj = tid & 63;
  float acc[8];
#pragma unroll
  for (int b = 0; b < 8; b++) acc[b] = 0.f;
#pragma unroll 4
  for (int k = kq * 256; k < kq * 256 + 256; k++) {
    float w = W[(size_t)k * N + j0 + jj];
#pragma unroll
    for (int b = 0; b < 8; b++) acc[b] += vs[b * 1024 + k] * w;
  }
#pragma unroll
  for (int b = 0; b < 8; b++) red[(kq * 8 + b) * 64 + jj] = acc[b];
  __syncthreads();
  for (int o = tid; o < 512; o += 256) {
    int b = o >> 6, j = o & 63;
    float s = red[(0 * 8 + b) * 64 + j] + red[(8 + b) * 64 + j] + red[(16 + b) * 64 + j] + red[(24 + b) * 64 + j];
    int jg = j0 + j;
    if (bias) s += bias[jg];
    int jo = permmode ? f1perm(jg) : jg;
    out[(size_t)b * ostride + jo] = s;
  }
}

DI void ssm_param_item(const Params& p, int idx) {
  const int tid = tidx();
  const int pp = tid & 63, cq = tid >> 6;
  float* SSMA = (float*)(p.ws + OFF_SSMA);
  u16* BB = (u16*)(p.ws + OFF_SSMBB);
  u16* CC = (u16*)(p.ws + OFF_SSMCC);
  double lr = (double)p.lam_re[idx * 64 + pp];
  if (lr > -1e-4) lr = (double)(-1e-4f);
  double li = (double)p.lam_im[idx * 64 + pp];
  double dt = exp((double)p.log_dt[idx]);
  double mag = exp(lr * dt);
  double ar = mag * cos(li * dt), ai = mag * sin(li * dt);
  double den = lr * lr + li * li;
  double nre = ar - 1.0;
  double kre = (nre * lr + ai * li) / den;
  double kim = (ai * lr - nre * li) / den;
  if (cq == 0) {
    double magL = exp(lr * dt * 256.0);
    float4 v;
    v.x = (float)ar; v.y = (float)ai;
    v.z = (float)(magL * cos(li * dt * 256.0)); v.w = (float)(magL * sin(li * dt * 256.0));
    *(float4*)(SSMA + (size_t)(idx * 64 + pp) * 4) = v;
  }
#pragma unroll
  for (int cc = 0; cc < 4; cc++) {
    int c = cq * 4 + cc;
    double br = (double)p.b_re[(size_t)(idx * 64 + pp) * 16 + c];
    double bi = (double)p.b_im[(size_t)(idx * 64 + pp) * 16 + c];
    float bbr = (float)(kre * br - kim * bi);
    float bbi = (float)(kre * bi + kim * br);
    BB[(size_t)(idx * 128 + pp) * 16 + c] = (u16)(pk(bbr, 0.f) & 0xffffu);
    BB[(size_t)(idx * 128 + 64 + pp) * 16 + c] = (u16)(pk(bbi, 0.f) & 0xffffu);
    float cr = p.c_re[(size_t)(idx * 16 + c) * 64 + pp];
    float ci = p.c_im[(size_t)(idx * 16 + c) * 64 + pp];
    *(unsigned*)(CC + (size_t)(idx * 16 + c) * 128 + 2 * pp) = pk(cr, -ci);
  }
}

DI void phase0(char* smem) {
  const Params p = kparams();
  float* sm = (float*)smem;
  constexpr int N_TIN = 4 * 16 * 20, N_TGLU = 4 * 8 * 8, N_TOUT = 4 * 16 * 16, N_TF1 = 4 * 16 * 88, N_TF2 = 4 * 44 * 16;
  constexpr int N_MOD = 4 * 96, N_SSM = 256, N_ROPE = 1;
  constexpr int S0 = N_MOD, S1 = S0 + N_TIN, S2 = S1 + N_TGLU, S3 = S2 + N_TOUT, S4 = S3 + N_TF1, S5 = S4 + N_TF2,
                S6 = S5 + N_SSM, S7 = S6 + N_ROPE;
  for (int it = blockIdx.x; it < S7; it += gridDim.x) {
    if (it < S0) {
      int l = it / 96, jb = it % 96;
      gemv8_item(p.c, 1024, true, p.w_ada + (size_t)l * 1024 * 6144, 6144, jb * 64, p.b_ada + l * 6144,
                 (float*)(p.ws + OFF_MOD) + (size_t)l * 8 * 6144, 6144, 0, sm);
    } else if (it < S1) {
      int r = it - S0; int l = r / 320; r %= 320; int kt = r / 20, ntile = r % 20;
      transpose_tile(p.w_in + (size_t)l * 1024 * 1280, 1280, (u16*)(p.ws + OFF_WT_IN) + (size_t)l * 1280 * 1024, 1024,
                     kt * 64, ntile * 64, 0, nullptr, sm);
    } else if (it < S2) {
      int r = it - S1; int l = r / 64; r %= 64; int kt = r / 8, ntile = r % 8;
      transpose_tile(p.w_glu + (size_t)l * 512 * 512, 512, (u16*)(p.ws + OFF_WT_GLU) + (size_t)l * 512 * 512, 512,
                     kt * 64, ntile * 64, 0, nullptr, sm);
    } else if (it < S3) {
      int r = it - S2; int l = r / 256; r %= 256; int kt = r / 16, ntile = r % 16;
      const float* ks = (kt < 8) ? (p.attn_out_norm + l * 512) : (p.ssm_out_norm + l * 512 - 512);
      transpose_tile(p.w_out + (size_t)l * 1024 * 1024, 1024, (u16*)(p.ws + OFF_WT_OUT) + (size_t)l * 1024 * 1024, 1024,
                     kt * 64, ntile * 64, 0, ks, sm);
    } else if (it < S4) {
      int r = it - S3; int l = r / 1408; r %= 1408; int kt = r / 88, ntile = r % 88;
      transpose_tile(p.w_ffn_in + (size_t)l * 1024 * 5632, 5632, (u16*)(p.ws + OFF_WT_F1) + (size_t)l * 5632 * 1024, 1024,
                     kt * 64, ntile * 64, 1, nullptr, sm);
    } else if (it < S5) {
      int r = it - S4; int l = r / 704; r %= 704; int kt = r / 16, ntile = r % 16;
      transpose_tile(p.w_ffn_out + (size_t)l * 2816 * 1024, 1024, (u16*)(p.ws + OFF_WT_F2) + (size_t)l * 1024 * 2816, 2816,
                     kt * 64, ntile * 64, 0, nullptr, sm);
    } else if (it < S6) {
      ssm_param_item(p, it - S5);
    } else {
      float* rope = (float*)(p.ws + OFF_ROPE);
      for (int i = tidx(); i < 1024; i += 256) {
        int idx = i >> 4, f = i & 15;
        double ang = (double)idx * pow(10000.0, -(double)f / 16.0);
        rope[i] = (float)cos(ang);
        rope[1024 + i] = (float)sin(ang);
      }
    }
  }
}

DI void phase1(char* smem) {
  const Params p = kparams();
  float* sm = (float*)smem;
  const float* MOD = (const float*)(p.ws + OFF_MOD);
  constexpr int N_B1 = 4 * 20, N_B2 = 4 * 88, N_PREP = T_TOK / 4;
  for (int it = blockIdx.x; it < N_B1 + N_B2 + N_PREP; it += gridDim.x) {
    if (it < N_B1) {
      int l = it / 20, jb = it % 20;
      gemv8_item(MOD + (size_t)l * 8 * 6144 + 0, 6144, false, p.w_in + (size_t)l * 1024 * 1280, 1280, jb * 64, nullptr,
                 (float*)(p.ws + OFF_BIAS1) + (size_t)l * 8 * 1280, 1280, 0, sm);
    } else if (it < N_B1 + N_B2) {
      int r = it - N_B1; int l = r / 88, jb = r % 88;
      gemv8_item(MOD + (size_t)l * 8 * 6144 + 3072, 6144, false, p.w_ffn_in + (size_t)l * 1024 * 5632, 5632, jb * 64, nullptr,
                 (float*)(p.ws + OFF_BIAS2) + (size_t)l * 8 * 5632, 5632, 1, sm);
    } else {
      int r = it - N_B1 - N_B2;
      const int lane = tidx() & 63, wave = tidx() >> 6;
      int t = r * 4 + wave;
      int b = t >> 12;
      const float4* xr = (const float4*)(p.x + (size_t)t * 1024);
      float4 v[4];
      float ss = 0.f;
#pragma unroll
      for (int i = 0; i < 4; i++) {
        v[i] = xr[lane + 64 * i];
        ss += v[i].x * v[i].x + v[i].y * v[i].y + v[i].z * v[i].z + v[i].w * v[i].w;
      }
      ss = wave_sum(ss);
      float* SSX = (float*)(p.ws + OFF_SSX);
      if (lane < 16) SSX[(size_t)t * 16 + lane] = (lane == 0) ? ss : 0.f;
      u16* ACT = (u16*)(p.ws + OFF_ACT);
      const float* sc1 = MOD + (size_t)(0 * 8 + b) * 6144 + 1024;
#pragma unroll
      for (int i = 0; i < 4; i++) {
        int k = (lane + 64 * i) * 4;
        float4 g = *(const float4*)(p.norm1 + k);
        float4 s = *(const float4*)(sc1 + k);
        st_bf4(ACT + (size_t)t * 1024 + k, v[i].x * g.x * (1.f + s.x), v[i].y * g.y * (1.f + s.y),
               v[i].z * g.z * (1.f + s.z), v[i].w * g.w * (1.f + s.w));
      }
    }
  }
}

enum { EPI_IN = 0, EPI_GLU = 1, EPI_OUT = 2, EPI_F1 = 3, EPI_F2 = 4 };

DI float row_rinv16(const float* ssx, int t, float invn) {
  const float4* q = (const float4*)(ssx + (size_t)t * 16);
  float4 a = q[0], b = q[1], c = q[2], d = q[3];
  float s = ((a.x + a.y) + (a.z + a.w)) + ((b.x + b.y) + (b.z + b.w)) + ((c.x + c.y) + (c.z + c.w)) + ((d.x + d.y) + (d.z + d.w));
  return rsqrtf(s * invn + 1e-6f);
}
DI float row_rinv8(const float* ss8, int t, float invn) {
  const float4* q = (const float4*)(ss8 + (size_t)t * 8);
  float4 a = q[0], b = q[1];
  float s = ((a.x + a.y) + (a.z + a.w)) + ((b.x + b.y) + (b.z + b.w));
  return rsqrtf(s * invn + 1e-6f);
}

template <int EPI>
DI void gemm_tile(const Params& p, const int l, const int mt, const int nt, char* smem) {
  constexpr int K = (EPI == EPI_GLU) ? 512 : (EPI == EPI_F2 ? 2816 : 1024);
  constexpr int LDA = (EPI == EPI_GLU || EPI == EPI_OUT) ? 512 : (EPI == EPI_F2 ? 2816 : 1024);
  constexpr int KT = K / 64;
  u16* As = (u16*)smem;
  u16* Bs = As + 128 * 72;
  const int tid = tidx(), lane = tid & 63, wave = tid >> 6;
  const int wm = wave >> 1, wn = wave & 1;
  const int hf = lane >> 5, li = lane & 31;
  const int m0 = mt * 128, n0 = nt * 128;

  const u16* A0;
  const u16* A1 = nullptr;
  const u16* W;
  if (EPI == EPI_IN) { A0 = (const u16*)(p.ws + OFF_ACT); W = (const u16*)(p.ws + OFF_WT_IN) + (size_t)l * 1280 * 1024; }
  else if (EPI == EPI_GLU) { A0 = (const u16*)(p.ws + OFF_YG); W = (const u16*)(p.ws + OFF_WT_GLU) + (size_t)l * 512 * 512; }
  else if (EPI == EPI_OUT) { A0 = (const u16*)(p.ws + OFF_OATT); A1 = (const u16*)(p.ws + OFF_OSSM); W = (const u16*)(p.ws + OFF_WT_OUT) + (size_t)l * 1024 * 1024; }
  else if (EPI == EPI_F1) { A0 = (const u16*)(p.ws + OFF_ACT); W = (const u16*)(p.ws + OFF_WT_F1) + (size_t)l * 5632 * 1024; }
  else { A0 = (const u16*)(p.ws + OFF_HID); W = (const u16*)(p.ws + OFF_WT_F2) + (size_t)l * 1024 * 2816; }

  const int lrow = tid >> 3, lc8 = tid & 7;
  const u16* ag0 = A0 + (size_t)(m0 + lrow) * LDA + lc8 * 8;
  const u16* ag1 = (EPI == EPI_OUT) ? (A1 + (size_t)(m0 + lrow) * LDA + lc8 * 8) : nullptr;
  const u16* wg = W + (size_t)(n0 + lrow) * K + lc8 * 8;

  f32x16 acc[2][2];
#pragma unroll
  for (int i = 0; i < 2; i++)
#pragma unroll
    for (int j = 0; j < 2; j++)
#pragma unroll
      for (int r = 0; r < 16; r++) acc[i][j][r] = 0.f;

  uint4 ra0, ra1, ra2, ra3, rb0, rb1, rb2, rb3;
#define GEMM_GLOAD(kt_)                                                                          \
  {                                                                                              \
    const u16* ap;                                                                               \
    if (EPI == EPI_OUT) ap = ((kt_) < 8) ? (ag0 + (kt_) * 64) : (ag1 + ((kt_) - 8) * 64);        \
    else ap = ag0 + (kt_) * 64;                                                                  \
    const u16* wp = wg + (kt_) * 64;                                                             \
    ra0 = *(const uint4*)(ap);                                                                   \
    ra1 = *(const uint4*)(ap + (size_t)32 * LDA);                                                \
    ra2 = *(const uint4*)(ap + (size_t)64 * LDA);                                                \
    ra3 = *(const uint4*)(ap + (size_t)96 * LDA);                                                \
    rb0 = *(const uint4*)(wp);                                                                   \
    rb1 = *(const uint4*)(wp + (size_t)32 * K);                                                  \
    rb2 = *(const uint4*)(wp + (size_t)64 * K);                                                  \
    rb3 = *(const uint4*)(wp + (size_t)96 * K);                                                  \
  }
  GEMM_GLOAD(0);

  int tok[2];
  tok[0] = m0 + wm * 64 + li;
  tok[1] = tok[0] + 32;

  float midr[2] = {1.f, 1.f}, fin[2] = {1.f, 1.f};
  if (EPI == EPI_OUT) {
#pragma unroll
    for (int j = 0; j < 2; j++) {
      float ra_ = row_rinv8((const float*)(p.ws + OFF_SSA), tok[j], 1.f / 512.f);
      float rs_ = row_rinv8((const float*)(p.ws + OFF_SSS), tok[j], 1.f / 512.f);
      midr[j] = ra_ / rs_;
      fin[j] = rs_;
    }
  }

  for (int kt = 0; kt < KT; kt++) {
    __syncthreads();
    *(uint4*)(As + (lrow) * 72 + lc8 * 8) = ra0;
    *(uint4*)(As + (lrow + 32) * 72 + lc8 * 8) = ra1;
    *(uint4*)(As + (lrow + 64) * 72 + lc8 * 8) = ra2;
    *(uint4*)(As + (lrow + 96) * 72 + lc8 * 8) = ra3;
    *(uint4*)(Bs + (lrow) * 72 + lc8 * 8) = rb0;
    *(uint4*)(Bs + (lrow + 32) * 72 + lc8 * 8) = rb1;
    *(uint4*)(Bs + (lrow + 64) * 72 + lc8 * 8) = rb2;
    *(uint4*)(Bs + (lrow + 96) * 72 + lc8 * 8) = rb3;
    __syncthreads();
    if (kt + 1 < KT) GEMM_GLOAD(kt + 1);
    if (EPI == EPI_OUT) {
      if (kt == 8) {
#pragma unroll
        for (int i = 0; i < 2; i++)
#pragma unroll
          for (int j = 0; j < 2; j++)
#pragma unroll
            for (int r = 0; r < 16; r++) acc[i][j][r] *= midr[j];
      }
    }
#pragma unroll
    for (int s = 0; s < 4; s++) {
      bf16x8 wf[2], af[2];
#pragma unroll
      for (int i = 0; i < 2; i++) wf[i] = *(const bf16x8*)(Bs + (wn * 64 + i * 32 + li) * 72 + s * 16 + hf * 8);
#pragma unroll
      for (int j = 0; j < 2; j++) af[j] = *(const bf16x8*)(As + (wm * 64 + j * 32 + li) * 72 + s * 16 + hf * 8);
#pragma unroll
      for (int i = 0; i < 2; i++)
#pragma unroll
        for (int j = 0; j < 2; j++) acc[i][j] = MFMA(wf[i], af[j], acc[i][j]);
    }
  }

  const int b = m0 >> 12;
  const int nbase = n0 + wn * 64;
  const float* MOD = (const float*)(p.ws + OFF_MOD);

  if (EPI == EPI_IN) {
    const float* bias = (const float*)(p.ws + OFF_BIAS1) + (size_t)(l * 8 + b) * 1280;
    const float* SSX = (const float*)(p.ws + OFF_SSX);
    float rinv[2];
    rinv[0] = row_rinv16(SSX, tok[0], 1.f / 1024.f);
    rinv[1] = row_rinv16(SSX, tok[1], 1.f / 1024.f);
#pragma unroll
    for (int i = 0; i < 2; i++)
#pragma unroll
      for (int q4 = 0; q4 < 4; q4++) {
        float4 b4 = *(const float4*)(bias + nbase + i * 32 + 8 * q4 + 4 * hf);
#pragma unroll
        for (int j = 0; j < 2; j++) {
          acc[i][j][4 * q4 + 0] = acc[i][j][4 * q4 + 0] * rinv[j] + b4.x;
          acc[i][j][4 * q4 + 1] = acc[i][j][4 * q4 + 1] * rinv[j] + b4.y;
          acc[i][j][4 * q4 + 2] = acc[i][j][4 * q4 + 2] * rinv[j] + b4.z;
          acc[i][j][4 * q4 + 3] = acc[i][j][4 * q4 + 3] * rinv[j] + b4.w;
        }
      }
    if (nt < 5) {
#pragma unroll
      for (int j = 0; j < 2; j++) {
        const int t = tok[j], pos = t & 4095;
#pragma unroll
        for (int i = 0; i < 2; i++)
#pragma unroll
          for (int q4 = 0; q4 < 4; q4++) {
            const int d0 = i * 32 + 8 * q4 + 4 * hf;
            u16* dst = (nt < 4) ? ((u16*)(p.ws + OFF_Q) + (size_t)t * 512 + (nt * 2 + wn) * 64 + d0)
                                : ((u16*)(p.ws + OFF_K) + ((size_t)(b * 2 + wn) * 4096 + pos) * 64 + d0);
            st_bf4(dst, acc[i][j][4 * q4 + 0], acc[i][j][4 * q4 + 1], acc[i][j][4 * q4 + 2], acc[i][j][4 * q4 + 3]);
          }
      }
    } else if (nt == 5) {
      u16* VT = (u16*)(p.ws + OFF_VT);
#pragma unroll
      for (int j = 0; j < 2; j++) {
        const int pos = tok[j] & 4095;
#pragma unroll
        for (int i = 0; i < 2; i++)
#pragma unroll
          for (int r = 0; r < 16; r++) {
            int d = i * 32 + crow(r, hf);
            VT[((size_t)(b * 2 + wn) * 64 + d) * 4096 + pos] = (u16)(pk(acc[i][j][r], 0.f) & 0xffffu);
          }
      }
    } else {
      u16* U2 = (u16*)(p.ws + OFF_U2);
      const int ch0 = (nt - 6) * 128 + wn * 64;
#pragma unroll
      for (int j = 0; j < 2; j++) {
        const int pos = tok[j] & 4095;
#pragma unroll
        for (int i = 0; i < 2; i++)
#pragma unroll
          for (int q4 = 0; q4 < 4; q4++) {
            int ch = ch0 + i * 32 + 8 * q4 + 4 * hf;
            int g = ch >> 4, c0 = ch & 15;
            st_bf4(U2 + (((size_t)(b * 32 + g)) * 4096 + pos) * 16 + c0, acc[i][j][4 * q4 + 0], acc[i][j][4 * q4 + 1],
                   acc[i][j][4 * q4 + 2], acc[i][j][4 * q4 + 3]);
          }
      }
    }
  } else if (EPI == EPI_GLU) {
    const float* bg = p.b_glu + l * 512;
    const u16* YG = (const u16*)(p.ws + OFF_YG);
    u16* OSSM = (u16*)(p.ws + OFF_OSSM);
    float* SSS = (float*)(p.ws + OFF_SSS);
#pragma unroll
    for (int j = 0; j < 2; j++) {
      const int t = tok[j];
      float ss = 0.f;
#pragma unroll
      for (int i = 0; i < 2; i++)
#pragma unroll
        for (int q4 = 0; q4 < 4; q4++) {
          const int n = nbase + i * 32 + 8 * q4 + 4 * hf;
          float4 b4 = *(const float4*)(bg + n);
          float4 y = ld_bf4(YG + (size_t)t * 512 + n);
          float o0 = y.x / (1.f + __expf(-(acc[i][j][4 * q4 + 0] + b4.x)));
          float o1 = y.y / (1.f + __expf(-(acc[i][j][4 * q4 + 1] + b4.y)));
          float o2 = y.z / (1.f + __expf(-(acc[i][j][4 * q4 + 2] + b4.z)));
          float o3 = y.w / (1.f + __expf(-(acc[i][j][4 * q4 + 3] + b4.w)));
          ss += o0 * o0 + o1 * o1 + o2 * o2 + o3 * o3;
          st_bf4(OSSM + (size_t)t * 512 + n, o0, o1, o2, o3);
        }
      ss += __shfl_xor(ss, 32);
      if (hf == 0) SSS[(size_t)t * 8 + nt * 2 + wn] = ss;
    }
  } else if (EPI == EPI_OUT || EPI == EPI_F2) {
    const float* gate = MOD + (size_t)(l * 8 + b) * 6144 + (EPI == EPI_OUT ? 2048 : 5120);
    const bool has_next = (EPI == EPI_OUT) || (l < 3);
    const float* nrm = (EPI == EPI_OUT) ? (p.norm2 + l * 1024) : (p.norm1 + (l + 1) * 1024);
    const float* scn = (EPI == EPI_OUT) ? (MOD + (size_t)(l * 8 + b) * 6144 + 4096) : (MOD + (size_t)((l + 1) * 8 + b) * 6144 + 1024);
    const float* xin = (EPI == EPI_OUT && l == 0) ? p.x : (const float*)(p.ws + OFF_X);
    float* X = (float*)(p.ws + OFF_X);
    u16* ACT = (u16*)(p.ws + OFF_ACT);
    float* SSX = (float*)(p.ws + OFF_SSX);
#pragma unroll
    for (int j = 0; j < 2; j++) {
      const int t = tok[j];
      float ss = 0.f;
#pragma unroll
      for (int i = 0; i < 2; i++)
#pragma unroll
        for (int q4 = 0; q4 < 4; q4++) {
          const int n = nbase + i * 32 + 8 * q4 + 4 * hf;
          float4 g4 = *(const float4*)(gate + n);
          float4 xi = *(const float4*)(xin + (size_t)t * 1024 + n);
          float4 y;
          y.x = xi.x + g4.x * acc[i][j][4 * q4 + 0] * fin[j];
          y.y = xi.y + g4.y * acc[i][j][4 * q4 + 1] * fin[j];
          y.z = xi.z + g4.z * acc[i][j][4 * q4 + 2] * fin[j];
          y.w = xi.w + g4.w * acc[i][j][4 * q4 + 3] * fin[j];
          *(float4*)(X + (size_t)t * 1024 + n) = y;
          ss += y.x * y.x + y.y * y.y + y.z * y.z + y.w * y.w;
          if (has_next) {
            float4 nr = *(const float4*)(nrm + n);
            float4 sc = *(const float4*)(scn + n);
            st_bf4(ACT + (size_t)t * 1024 + n, y.x * nr.x * (1.f + sc.x), y.y * nr.y * (1.f + sc.y),
                   y.z * nr.z * (1.f + sc.z), y.w * nr.w * (1.f + sc.w));
          }
        }
      ss += __shfl_xor(ss, 32);
      if (hf == 0) SSX[(size_t)t * 16 + nt * 2 + wn] = ss;
    }
  } else {
    const float* bias = (const float*)(p.ws + OFF_BIAS2) + (size_t)(l * 8 + b) * 5632;
    const float* SSX = (const float*)(p.ws + OFF_SSX);
    u16* HID = (u16*)(p.ws + OFF_HID);
    const int jbase = nbase >> 1;
#pragma unroll
    for (int j = 0; j < 2; j++) {
      const int t = tok[j];
      const float rv = row_rinv16(SSX, t, 1.f / 1024.f);
#pragma unroll
      for (int q4 = 0; q4 < 4; q4++) {
        const int ng = nbase + 8 * q4 + 4 * hf;
        float4 bg4 = *(const float4*)(bias + ng);
        float4 bu4 = *(const float4*)(bias + ng + 32);
        float zg0 = acc[0][j][4 * q4 + 0] * rv + bg4.x, zu0 = acc[1][j][4 * q4 + 0] * rv + bu4.x;
        float zg1 = acc[0][j][4 * q4 + 1] * rv + bg4.y, zu1 = acc[1][j][4 * q4 + 1] * rv + bu4.y;
        float zg2 = acc[0][j][4 * q4 + 2] * rv + bg4.z, zu2 = acc[1][j][4 * q4 + 2] * rv + bu4.z;
        float zg3 = acc[0][j][4 * q4 + 3] * rv + bg4.w, zu3 = acc[1][j][4 * q4 + 3] * rv + bu4.w;
        float h0 = zg0 / (1.f + __expf(-zg0)) * zu0;
        float h1 = zg1 / (1.f + __expf(-zg1)) * zu1;
        float h2 = zg2 / (1.f + __expf(-zg2)) * zu2;
        float h3 = zg3 / (1.f + __expf(-zg3)) * zu3;
        st_bf4(HID + (size_t)t * 2816 + jbase + 8 * q4 + 4 * hf, h0, h1, h2, h3);
      }
    }
  }
}

template <int EPI>
DI void gemm_phase(int l, char* smem) {
  const Params p = kparams();
  constexpr int NT = (EPI == EPI_IN) ? 10 : (EPI == EPI_GLU ? 4 : (EPI == EPI_F1 ? 44 : 8));
  const int g8 = gridDim.x >> 3;
  const int xg = blockIdx.x & 7, lb = blockIdx.x >> 3;
  for (int q = lb; q < 32 * NT; q += g8) {
    const int mg = q / (8 * NT);
    const int rem = q - mg * 8 * NT;
    gemm_tile<EPI>(p, l, xg * 32 + mg * 8 + (rem & 7), rem >> 3, smem);
  }
}

DI void attn_item(const Params& p, int item, char* smem) {
  u16* Ks = (u16*)smem;
  u16* Vs = Ks + 64 * 72;
  const int tid = tidx(), lane = tid & 63, wave = tid >> 6;
  const int hf = lane >> 5, li = lane & 31;
  const int xcd = item & 7, local = item >> 3;
  const int pair = xcd * 2 + (local >> 7);
  const int within = local & 127;
  const int hq = within >> 5, qb = within & 31;
  const int b = pair >> 1, kvh = pair & 1, h = kvh * 4 + hq;
  const int t = b * 4096 + qb * 128 + wave * 32 + li;

  const u16* Q = (const u16*)(p.ws + OFF_Q);
  bf16x8 qf[4];
#pragma unroll
  for (int s = 0; s < 4; s++) qf[s] = *(const bf16x8*)(Q + (size_t)t * 512 + h * 64 + 16 * s + 8 * hf);

  f32x16 o0, o1;
#pragma unroll
  for (int r = 0; r < 16; r++) { o0[r] = 0.f; o1[r] = 0.f; }
  float m_run = -1e30f, l_run = 0.f;

  const int lrow = tid >> 3, lc8 = tid & 7;
  const u16* Kg = (const u16*)(p.ws + OFF_K) + (size_t)pair * 4096 * 64 + (size_t)lrow * 64 + lc8 * 8;
  const u16* Vg = (const u16*)(p.ws + OFF_VT) + (size_t)pair * 64 * 4096 + (size_t)lrow * 4096 + lc8 * 8;
  uint4 rk0, rk1, rv0, rv1;
#define ATT_GLOAD(kt_)                                                   \
  {                                                                      \
    rk0 = *(const uint4*)(Kg + (size_t)((kt_) * 64) * 64);               \
    rk1 = *(const uint4*)(Kg + (size_t)((kt_) * 64 + 32) * 64);          \
    rv0 = *(const uint4*)(Vg + (kt_) * 64);                              \
    rv1 = *(const uint4*)(Vg + (size_t)32 * 4096 + (kt_) * 64);          \
  }
  ATT_GLOAD(0);
  const int kap = (li & 0x13) | ((li & 4) << 1) | ((li & 8) >> 1);

  for (int kt = 0; kt < 64; kt++) {
    __syncthreads();
    *(uint4*)(Ks + (lrow) * 72 + lc8 * 8) = rk0;
    *(uint4*)(Ks + (lrow + 32) * 72 + lc8 * 8) = rk1;
    *(uint4*)(Vs + (lrow) * 72 + lc8 * 8) = rv0;
    *(uint4*)(Vs + (lrow + 32) * 72 + lc8 * 8) = rv1;
    __syncthreads();
    if (kt + 1 < 64) ATT_GLOAD(kt + 1);

    f32x16 s0, s1;
#pragma unroll
    for (int r = 0; r < 16; r++) { s0[r] = 0.f; s1[r] = 0.f; }
#pragma unroll
    for (int s = 0; s < 4; s++) {
      bf16x8 kf0 = *(const bf16x8*)(Ks + kap * 72 + 16 * s + 8 * hf);
      bf16x8 kf1 = *(const bf16x8*)(Ks + (32 + kap) * 72 + 16 * s + 8 * hf);
      s0 = MFMA(kf0, qf[s], s0);
      s1 = MFMA(kf1, qf[s], s1);
    }
    float mx = s0[0];
#pragma unroll
    for (int r = 1; r < 16; r++) mx = fmaxf(mx, s0[r]);
#pragma unroll
    for (int r = 0; r < 16; r++) mx = fmaxf(mx, s1[r]);
    mx = fmaxf(mx, __shfl_xor(mx, 32));
    const float mnew = fmaxf(m_run, mx);
    const float alpha = __builtin_amdgcn_exp2f(m_run - mnew);
    m_run = mnew;
    float ps = 0.f;
#pragma unroll
    for (int r = 0; r < 16; r++) { s0[r] = __builtin_amdgcn_exp2f(s0[r] - mnew); ps += s0[r]; }
#pragma unroll
    for (int r = 0; r < 16; r++) { s1[r] = __builtin_amdgcn_exp2f(s1[r] - mnew); ps += s1[r]; }
    l_run = l_run * alpha + ps;
#pragma unroll
    for (int r = 0; r < 16; r++) { o0[r] *= alpha; o1[r] *= alpha; }
#pragma unroll
    for (int sp = 0; sp < 2; sp++) {
      bf16x8 pb;
      {
        unsigned u0 = pk(s0[8 * sp + 0], s0[8 * sp + 1]), u1 = pk(s0[8 * sp + 2], s0[8 * sp + 3]);
        unsigned u2 = pk(s0[8 * sp + 4], s0[8 * sp + 5]), u3 = pk(s0[8 * sp + 6], s0[8 * sp + 7]);
        uint4 uu = make_uint4(u0, u1, u2, u3);
        pb = __builtin_bit_cast(bf16x8, uu);
      }
      bf16x8 vf0 = *(const bf16x8*)(Vs + li * 72 + 16 * sp + 8 * hf);
      bf16x8 vf1 = *(const bf16x8*)(Vs + (32 + li) * 72 + 16 * sp + 8 * hf);
      o0 = MFMA(vf0, pb, o0);
      o1 = MFMA(vf1, pb, o1);
    }
#pragma unroll
    for (int sp = 0; sp < 2; sp++) {
      bf16x8 pb;
      {
        unsigned u0 = pk(s1[8 * sp + 0], s1[8 * sp + 1]), u1 = pk(s1[8 * sp + 2], s1[8 * sp + 3]);
        unsigned u2 = pk(s1[8 * sp + 4], s1[8 * sp + 5]), u3 = pk(s1[8 * sp + 6], s1[8 * sp + 7]);
        uint4 uu = make_uint4(u0, u1, u2, u3);
        pb = __builtin_bit_cast(bf16x8, uu);
      }
      bf16x8 vf0 = *(const bf16x8*)(Vs + li * 72 + 32 + 16 * sp + 8 * hf);
      bf16x8 vf1 = *(const bf16x8*)(Vs + (32 + li) * 72 + 32 + 16 * sp + 8 * hf);
      o0 = MFMA(vf0, pb, o0);
      o1 = MFMA(vf1, pb, o1);
    }
  }
  const float ltot = l_run + __shfl_xor(l_run, 32);
  const float inv = 1.f / ltot;
  u16* OATT = (u16*)(p.ws + OFF_OATT);
  float ss = 0.f;
#pragma unroll
  for (int q4 = 0; q4 < 4; q4++) {
    float a0 = o0[4 * q4 + 0] * inv, a1 = o0[4 * q4 + 1] * inv, a2 = o0[4 * q4 + 2] * inv, a3 = o0[4 * q4 + 3] * inv;
    float c0 = o1[4 * q4 + 0] * inv, c1 = o1[4 * q4 + 1] * inv, c2 = o1[4 * q4 + 2] * inv, c3 = o1[4 * q4 + 3] * inv;
    ss += a0 * a0 + a1 * a1 + a2 * a2 + a3 * a3 + c0 * c0 + c1 * c1 + c2 * c2 + c3 * c3;
    st_bf4(OATT + (size_t)t * 512 + h * 64 + 8 * q4 + 4 * hf, a0, a1, a2, a3);
    st_bf4(OATT + (size_t)t * 512 + h * 64 + 32 + 8 * q4 + 4 * hf, c0, c1, c2, c3);
  }
  ss += __shfl_xor(ss, 32);
  if (hf == 0) ((float*)(p.ws + OFF_SSA))[(size_t)t * 8 + h] = ss;
}

DI bf16x8 ssm_ufrag(const u16* U2, int bp, int g, int tb, int li, int hf) {
  const int seq = (li >> 2) & 1, step = ((li >> 3) << 2) | (li & 3);
  return *(const bf16x8*)(U2 + (((size_t)((2 * bp + seq) * 32 + g)) * 4096 + tb + step) * 16 + 8 * hf);
}

DI void ssm1_item(const Params& p, int l, int item) {
  const int tid = tidx(), lane = tid & 63, wave = tid >> 6;
  const int hf = lane >> 5, li = lane & 31;
  const int w = item * 4 + wave;
  const int ch = w & 15, bp = (w >> 4) & 3, g = (w >> 6) & 31, dir = w >> 11;
  const int idx = (l * 2 + dir) * 32 + g;
  const u16* U2 = (const u16*)(p.ws + OFF_U2);
  const u16* BB = (const u16*)(p.ws + OFF_SSMBB) + (size_t)idx * 128 * 16;
  const float* SA = (const float*)(p.ws + OFF_SSMA) + (size_t)idx * 64 * 4;
  bf16x8 bbf[4];
#pragma unroll
  for (int j = 0; j < 4; j++) bbf[j] = *(const bf16x8*)(BB + (32 * j + li) * 16 + 8 * hf);
  const float4 a0 = *(const float4*)(SA + li * 4);
  const float4 a1 = *(const float4*)(SA + (li + 32) * 4);
  float h0r = 0.f, h0i = 0.f, h1r = 0.f, h1i = 0.f;
  f32x16 zero;
#pragma unroll
  for (int r = 0; r < 16; r++) zero[r] = 0.f;
  for (int it = 0; it < 16; it++) {
    const int tb = ch * 256 + (dir ? (15 - it) : it) * 16;
    bf16x8 uf = ssm_ufrag(U2, bp, g, tb, li, hf);
    f32x16 x0 = MFMA(uf, bbf[0], zero), x1 = MFMA(uf, bbf[1], zero), x2 = MFMA(uf, bbf[2], zero), x3 = MFMA(uf, bbf[3], zero);
    if (dir == 0) {
#pragma unroll
      for (int r = 0; r < 16; r++) {
        float nr = a0.x * h0r - a0.y * h0i + x0[r], ni = a0.x * h0i + a0.y * h0r + x2[r];
        h0r = nr; h0i = ni;
        float mr = a1.x * h1r - a1.y * h1i + x1[r], mi = a1.x * h1i + a1.y * h1r + x3[r];
        h1r = mr; h1i = mi;
      }
    } else {
#pragma unroll
      for (int r = 15; r >= 0; r--) {
        float nr = a0.x * h0r - a0.y * h0i + x0[r], ni = a0.x * h0i + a0.y * h0r + x2[r];
        h0r = nr; h0i = ni;
        float mr = a1.x * h1r - a1.y * h1i + x1[r], mi = a1.x * h1i + a1.y * h1r + x3[r];
        h1r = mr; h1i = mi;
      }
    }
  }
  float* E = (float*)(p.ws + OFF_E) + ((((size_t)(dir * 32 + g) * 8 + (2 * bp + hf)) * 16 + ch) * 64) * 2;
  *(float2*)(E + li * 2) = make_float2(h0r, h0i);
  *(float2*)(E + (li + 32) * 2) = make_float2(h1r, h1i);
}

DI void ssm2_item(const Params& p, int l, int item, char* smem) {
  const int tid = tidx(), lane = tid & 63, wave = tid >> 6;
  const int hf = lane >> 5, li = lane & 31;
  const int w = item * 4 + wave;
  const int ch = w & 15, bp = (w >> 4) & 3, g = w >> 6;
  u16* Hs = (u16*)smem + wave * (32 * 136);
  const u16* U2 = (const u16*)(p.ws + OFF_U2);
  float* YF = (float*)(p.ws + OFF_ACT);
  u16* YG = (u16*)(p.ws + OFF_YG);
  f32x16 zero;
#pragma unroll
  for (int r = 0; r < 16; r++) zero[r] = 0.f;
  const int oseq = li >> 4, ostep = li & 15;
  const int ob = 2 * bp + oseq;

  for (int dir = 0; dir < 2; dir++) {
    const int idx = (l * 2 + dir) * 32 + g;
    const u16* BB = (const u16*)(p.ws + OFF_SSMBB) + (size_t)idx * 128 * 16;
    const u16* CC = (const u16*)(p.ws + OFF_SSMCC) + (size_t)idx * 16 * 128;
    const float* SA = (const float*)(p.ws + OFF_SSMA) + (size_t)idx * 64 * 4;
    bf16x8 bbf[4], ccf[8];
#pragma unroll
    for (int j = 0; j < 4; j++) bbf[j] = *(const bf16x8*)(BB + (32 * j + li) * 16 + 8 * hf);
#pragma unroll
    for (int s = 0; s < 8; s++) {
      bf16x8 v = *(const bf16x8*)(CC + (li & 15) * 128 + 16 * s + 8 * hf);
      if (li >= 16) {
#pragma unroll
        for (int e = 0; e < 8; e++) v[e] = 0;
      }
      ccf[s] = v;
    }
    const float4 a0 = *(const float4*)(SA + li * 4);
    const float4 a1 = *(const float4*)(SA + (li + 32) * 4);
    float h0r = 0.f, h0i = 0.f, h1r = 0.f, h1i = 0.f;
    {
      const float* E = (const float*)(p.ws + OFF_E) + ((((size_t)(dir * 32 + g) * 8 + (2 * bp + hf)) * 16) * 64) * 2;
      if (dir == 0) {
        for (int i = 0; i < ch; i++) {
          float2 e0 = *(const float2*)(E + (size_t)i * 128 + li * 2);
          float2 e1 = *(const float2*)(E + (size_t)i * 128 + (li + 32) * 2);
          float nr = a0.z * h0r - a0.w * h0i + e0.x, ni = a0.z * h0i + a0.w * h0r + e0.y;
          h0r = nr; h0i = ni;
          float mr = a1.z * h1r - a1.w * h1i + e1.x, mi = a1.z * h1i + a1.w * h1r + e1.y;
          h1r = mr; h1i = mi;
        }
      } else {
        for (int i = 15; i > ch; i--) {
          float2 e0 = *(const float2*)(E + (size_t)i * 128 + li * 2);
          float2 e1 = *(const float2*)(E + (size_t)i * 128 + (li + 32) * 2);
          float nr = a0.z * h0r - a0.w * h0i + e0.x, ni = a0.z * h0i + a0.w * h0r + e0.y;
          h0r = nr; h0i = ni;
          float mr = a1.z * h1r - a1.w * h1i + e1.x, mi = a1.z * h1i + a1.w * h1r + e1.y;
          h1r = mr; h1i = mi;
        }
      }
    }
    for (int it = 0; it < 16; it++) {
      const int tb = ch * 256 + (dir ? (15 - it) : it) * 16;
      bf16x8 uf = ssm_ufrag(U2, bp, g, tb, li, hf);
      f32x16 x0 = MFMA(uf, bbf[0], zero), x1 = MFMA(uf, bbf[1], zero), x2 = MFMA(uf, bbf[2], zero), x3 = MFMA(uf, bbf[3], zero);
      __syncthreads();
      if (dir == 0) {
#pragma unroll
        for (int r = 0; r < 16; r++) {
          float nr = a0.x * h0r - a0.y * h0i + x0[r], ni = a0.x * h0i + a0.y * h0r + x2[r];
          h0r = nr; h0i = ni;
          float mr = a1.x * h1r - a1.y * h1i + x1[r], mi = a1.x * h1i + a1.y * h1r + x3[r];
          h1r = mr; h1i = mi;
          *(unsigned*)(Hs + (hf * 16 + r) * 136 + 2 * li) = pk(h0r, h0i);
          *(unsigned*)(Hs + (hf * 16 + r) * 136 + 2 * (li + 32)) = pk(h1r, h1i);
        }
      } else {
#pragma unroll
        for (int r = 15; r >= 0; r--) {
          float nr = a0.x * h0r - a0.y * h0i + x0[r], ni = a0.x * h0i + a0.y * h0r + x2[r];
          h0r = nr; h0i = ni;
          float mr = a1.x * h1r - a1.y * h1i + x1[r], mi = a1.x * h1i + a1.y * h1r + x3[r];
          h1r = mr; h1i = mi;
          *(unsigned*)(Hs + (hf * 16 + r) * 136 + 2 * li) = pk(h0r, h0i);
          *(unsigned*)(Hs + (hf * 16 + r) * 136 + 2 * (li + 32)) = pk(h1r, h1i);
        }
      }
      __syncthreads();
      f32x16 y = zero;
#pragma unroll
      for (int s = 0; s < 8; s++) {
        bf16x8 hfv = *(const bf16x8*)(Hs + li * 136 + 16 * s + 8 * hf);
        y = MFMA(ccf[s], hfv, y);
      }
      const int tt = tb + ostep;
      const size_t yoff = (((size_t)(ob * 32 + g)) * 4096 + tt) * 16;
      if (dir == 0) {
        *(float4*)(YF + yoff + 4 * hf) = make_float4(y[0], y[1], y[2], y[3]);
        *(float4*)(YF + yoff + 8 + 4 * hf) = make_float4(y[4], y[5], y[6], y[7]);
      } else {
        float4 f0 = *(const float4*)(YF + yoff + 4 * hf);
        float4 f1 = *(const float4*)(YF + yoff + 8 + 4 * hf);
        float4 u0 = ld_bf4(U2 + yoff + 4 * hf);
        float4 u1 = ld_bf4(U2 + yoff + 8 + 4 * hf);
        float4 d0 = *(const float4*)(p.ssm_d + l * 512 + g * 16 + 4 * hf);
        float4 d1 = *(const float4*)(p.ssm_d + l * 512 + g * 16 + 8 + 4 * hf);
        float v[8];
        v[0] = f0.x + y[0] + d0.x * u0.x; v[1] = f0.y + y[1] + d0.y * u0.y;
        v[2] = f0.z + y[2] + d0.z * u0.z; v[3] = f0.w + y[3] + d0.w * u0.w;
        v[4] = f1.x + y[4] + d1.x * u1.x; v[5] = f1.y + y[5] + d1.y * u1.y;
        v[6] = f1.z + y[6] + d1.z * u1.z; v[7] = f1.w + y[7] + d1.w * u1.w;
#pragma unroll
        for (int e = 0; e < 8; e++) {
          float xx = v[e];
          float z = 0.7978845608028654f * (xx + 0.044715f * xx * xx * xx);
          float th = 1.f - 2.f / (__expf(2.f * z) + 1.f);
          v[e] = 0.5f * xx * (1.f + th);
        }
        u16* yg = YG + ((size_t)(ob * 4096 + tt)) * 512 + g * 16;
        st_bf4(yg + 4 * hf, v[0], v[1], v[2], v[3]);
        st_bf4(yg + 8 + 4 * hf, v[4], v[5], v[6], v[7]);
      }
    }
    __syncthreads();
  }
}

DI void qkpost_phase(int l) {
  const Params p = kparams();
  const float* ROPE = (const float*)(p.ws + OFF_ROPE);
  const int nrows = T_TOK * 8 + T_TOK * 2;
  for (int r = blockIdx.x * 256 + tidx(); r < nrows; r += gridDim.x * 256) {
    const bool isq = r < T_TOK * 8;
    const int rk = r - T_TOK * 8;
    u16* row = isq ? ((u16*)(p.ws + OFF_Q) + (size_t)r * 64) : ((u16*)(p.ws + OFF_K) + (size_t)rk * 64);
    const int pos = isq ? ((r >> 3) & 4095) : (rk & 4095);
    const float* gn = isq ? (p.q_norm + l * 64) : (p.k_norm + l * 64);
    const float osc = isq ? QSCALE : 1.f;
    float v[64];
#pragma unroll
    for (int c = 0; c < 8; c++) {
      uint4 raw = ((const uint4*)row)[c];
      v[8 * c + 0] = __uint_as_float(raw.x << 16); v[8 * c + 1] = __uint_as_float(raw.x & 0xffff0000u);
      v[8 * c + 2] = __uint_as_float(raw.y << 16); v[8 * c + 3] = __uint_as_float(raw.y & 0xffff0000u);
      v[8 * c + 4] = __uint_as_float(raw.z << 16); v[8 * c + 5] = __uint_as_float(raw.z & 0xffff0000u);
      v[8 * c + 6] = __uint_as_float(raw.w << 16); v[8 * c + 7] = __uint_as_float(raw.w & 0xffff0000u);
    }
    float ss = 0.f;
#pragma unroll
    for (int e = 0; e < 64; e++) ss += v[e] * v[e];
    const float rn = rsqrtf(ss * (1.f / 64.f) + 1e-6f) * osc;
    const int irow = pos >> 6, icol = pos & 63;
#pragma unroll
    for (int c = 0; c < 8; c++) {
      float o[8];
#pragma unroll
      for (int e = 0; e < 4; e++) {
        const int pi = 4 * c + e;
        const int idx = (pi < 16) ? irow : icol;
        const float cs = ROPE[idx * 16 + (pi & 15)];
        const float sn = ROPE[1024 + idx * 16 + (pi & 15)];
        const float y0 = v[2 * pi] * rn * gn[2 * pi], y1 = v[2 * pi + 1] * rn * gn[2 * pi + 1];
        o[2 * e] = y0 * cs - y1 * sn;
        o[2 * e + 1] = y0 * sn + y1 * cs;
      }
      uint4 w;
      w.x = pk(o[0], o[1]); w.y = pk(o[2], o[3]); w.z = pk(o[4], o[5]); w.w = pk(o[6], o[7]);
      ((uint4*)row)[c] = w;
    }
  }
}

DI void attn_phase(char* smem) {
  const Params p = kparams();
  for (int it = blockIdx.x; it < 2048; it += gridDim.x) attn_item(p, it, smem);
}
DI void ssm1_phase(int l) {
  const Params p = kparams();
  for (int it = blockIdx.x; it < 1024; it += gridDim.x) ssm1_item(p, l, it);
}
DI void ssm2_phase(int l, char* smem) {
  const Params p = kparams();
  for (int it = blockIdx.x; it < 512; it += gridDim.x) ssm2_item(p, l, it, smem);
}

DI void final_phase() {
  const Params p = kparams();
  const float* X = (const float*)(p.ws + OFF_X);
  const float* SSX = (const float*)(p.ws + OFF_SSX);
  const int total = T_TOK * 256;
  for (int i = blockIdx.x * 256 + tidx(); i < total; i += gridDim.x * 256) {
    int t = i >> 8, n = (i & 255) * 4;
    float rv = row_rinv16(SSX, t, 1.f / 1024.f);
    float4 x = *(const float4*)(X + (size_t)t * 1024 + n);
    float4 g = *(const float4*)(p.final_norm + n);
    float4 o;
    o.x = x.x * rv * g.x * DBGS; o.y = x.y * rv * g.y * DBGS; o.z = x.z * rv * g.z * DBGS; o.w = x.w * rv * g.w * DBGS;
    *(float4*)(p.out + (size_t)t * 1024 + n) = o;
  }
}

#define XB_TMO      128
#define XB_XCNT(j)  (256  + 64 * (j))
#define XB_XSUB(j)  (1280 + 64 * (j))
#define XB_XGEN(j)  (2304 + 64 * (j))
#define XB_TOP      3328
#define XB_TOPGEN   3392
#define XCD_BAR_WORDS 3456
#define XB_SPIN_CAP (1u << 18)
#define LAS __attribute__((address_space(3)))

__device__ __forceinline__ unsigned xb_ld(unsigned* p)              { return __hip_atomic_load(p, __ATOMIC_RELAXED, __HIP_MEMORY_SCOPE_AGENT); }
__device__ __forceinline__ unsigned xb_add(unsigned* p, unsigned v) { return __hip_atomic_fetch_add(p, v, __ATOMIC_RELAXED, __HIP_MEMORY_SCOPE_AGENT); }
__device__ __forceinline__ unsigned xb_xcc_id() { return (unsigned)__builtin_amdgcn_s_getreg((3 << 11) | 20) & 0xFu; }
#define XB_SPIN(cond, bar) do { unsigned _sp = 0; while (cond) { __builtin_amdgcn_s_sleep(1); \
    if ((++_sp & 255u) == 0u) { if (xb_ld(&(bar)[XB_TMO])) break; if (_sp > XB_SPIN_CAP) { atomicAdd(&(bar)[XB_TMO], 1u); break; } } } } while (0)

struct XcdBarrier {
    unsigned* bar; unsigned x;
    volatile LAS unsigned* st;
};

__device__ __forceinline__ XcdBarrier xcd_barrier_post(unsigned* bar, volatile LAS unsigned* st) {
    XcdBarrier b; b.bar = bar; b.x = xb_xcc_id(); b.st = st;
    if (threadIdx.x == 0) (void)xb_add(&bar[XB_XCNT(b.x)], 1u);
    return b;
}
__device__ __forceinline__ void xcd_barrier_complete(unsigned* bar, unsigned x, unsigned& nloc, unsigned& nx) {
    const unsigned G = gridDim.x * gridDim.y * gridDim.z;
    unsigned sum, cnt, mine, sp = 0u;
    for (;;) {
        sum = 0u; cnt = 0u; mine = 0u;
#pragma unroll
        for (unsigned j = 0; j < 16; ++j) { const unsigned c = xb_ld(&bar[XB_XCNT(j)]); sum += c; cnt += (c > 0u) ? 1u : 0u; mine = (j == x) ? c : mine; }
        if (sum == G) break;
        __builtin_amdgcn_s_sleep(1);
        if ((++sp & 255u) == 0u) { if (xb_ld(&bar[XB_TMO])) break; if (sp > XB_SPIN_CAP) { atomicAdd(&bar[XB_TMO], 1u); break; } }
    }
    nloc = mine > 0u ? mine : 1u; nx = cnt > 0u ? cnt : 1u;
}

__device__ __forceinline__ void xcd_barrier(const XcdBarrier& b) {
    asm volatile("s_waitcnt vmcnt(0)" ::: "memory");
    __syncthreads();
    if (threadIdx.x == 0) {
        unsigned* bar = b.bar;
        __builtin_amdgcn_s_waitcnt(0);
        unsigned nloc = b.st[0], nx = b.st[1];
        if (nloc == 0u) { xcd_barrier_complete(bar, b.x, nloc, nx); b.st[0] = nloc; b.st[1] = nx; }
        const unsigned old = xb_add(&bar[XB_XSUB(b.x)], 1u);
        const unsigned gen = old / nloc;
        if (old + 1u == (gen + 1u) * nloc) {
            __builtin_amdgcn_fence(__ATOMIC_RELEASE, "agent");
            asm volatile("s_waitcnt vmcnt(0)" ::: "memory");
            const unsigned og = xb_add(&bar[XB_TOP], 1u);
            const unsigned tg = og / nx;
            if (og + 1u == (tg + 1u) * nx) xb_add(&bar[XB_TOPGEN], 1u);
            else XB_SPIN(xb_ld(&bar[XB_TOPGEN]) == tg, bar);
            __builtin_amdgcn_fence(__ATOMIC_ACQUIRE, "agent");
            xb_add(&bar[XB_XGEN(b.x)], 1u);
            asm volatile("s_waitcnt vmcnt(0)" ::: "memory");
        } else {
            XB_SPIN(xb_ld(&bar[XB_XGEN(b.x)]) == gen, bar);
            __builtin_amdgcn_fence(__ATOMIC_ACQUIRE, "agent");
            asm volatile("s_waitcnt vmcnt(0)" ::: "memory");
        }
    }
    __syncthreads();
}
#define GSYNC() xcd_barrier(xbar)
#ifndef ONLYK
#define ONLYK -1
#endif
#ifndef ENMASK
#define ENMASK 0x7ff
#endif
#define EN(n) ((ONLYK < 0 && ((ENMASK >> (n)) & 1)) || ONLYK == (n))
__global__ void __launch_bounds__(256, 2) mega(Params p_) {
  __shared__ __attribute__((aligned(16))) char smem[40960];
  cg::grid_group grid = cg::this_grid();
  __shared__ __attribute__((aligned(16))) unsigned xb_words[4];
  if (tidx() < 4) xb_words[tidx()] = 0u;
  __syncthreads();
  if (p_.ph_lo < 0) grid.sync();
  const XcdBarrier xbar = xcd_barrier_post((unsigned*)(p_.ws + OFF_BAR), (volatile LAS unsigned*)xb_words);
#ifdef DBG_COPY
  {
    const Params p = kparams();
    for (int i = blockIdx.x * 256 + tidx(); i < T_TOK * 1024; i += gridDim.x * 256) p.out[i] = p.x[i] * 1.5f;
    return;
  }
#endif
  int ph = p_.ph_lo;
  const int ph_hi = p_.ph_hi;
  if (ph == 0 && ph < ph_hi) {
    if (EN(0)) phase0(smem);
    ph++;
    if (ph < ph_hi) GSYNC();
  }
  if (ph == 1 && ph < ph_hi) {
    if (EN(1)) phase1(smem);
    ph++;
    if (ph < ph_hi) GSYNC();
  }
#ifdef DBG_CUT
  for (; ph < ph_hi && ph < DBG_CUT; ph++) {
    const int l = (ph - 2) / 7, k = (ph - 2) % 7;
    if (k == 0) { gemm_phase<EPI_IN>(l, smem); }
    else if (k == 1) { qkpost_phase(l); ssm1_phase(l); }
    else if (k == 2) { attn_phase(smem); ssm2_phase(l, smem); }
    else if (k == 3) { gemm_phase<EPI_GLU>(l, smem); }
    else if (k == 4) { gemm_phase<EPI_OUT>(l, smem); }
    else if (k == 5) { gemm_phase<EPI_F1>(l, smem); }
    else { gemm_phase<EPI_F2>(l, smem); }
    GSYNC();
  }
  {
    const Params p = kparams();
    const u16* src = (const u16*)(p.ws + DBG_DUMP_OFF);
    for (int i = blockIdx.x * 256 + tidx(); i < T_TOK * 1024; i += gridDim.x * 256) p.out[i] = bf2f(src[i]);
  }
  return;
#endif
  for (; ph < ph_hi && ph < NPHASE - 1; ph++) {
    const int l = (ph - 2) / 7, k = (ph - 2) % 7;
    if (k == 0) { if (EN(3)) gemm_phase<EPI_IN>(l, smem); }
    else if (k == 1) { if (EN(4)) { qkpost_phase(l); ssm1_phase(l); } }
    else if (k == 2) {
      if (EN(5)) attn_phase(smem);
#ifdef PROBE_ATT2
      attn_phase(smem);
#endif
      if (EN(6)) ssm2_phase(l, smem);
    }
    else if (k == 3) { if (EN(7)) gemm_phase<EPI_GLU>(l, smem); }
    else if (k == 4) { if (EN(8)) gemm_phase<EPI_OUT>(l, smem); }
    else if (k == 5) { if (EN(9)) gemm_phase<EPI_F1>(l, smem);
#ifdef PROBE_F1X2
      gemm_phase<EPI_F1>(l, smem);
#endif
    }
    else { if (EN(10)) gemm_phase<EPI_F2>(l, smem); }
    if (ph + 1 < ph_hi) GSYNC();
  }
  if (ph == NPHASE - 1 && ph < ph_hi) {
    if (EN(2)) final_phase();
  }
}

extern "C" void kernel_launch(void* const* d_in, const int* in_sizes, int n_in, void* d_out, int out_size, void* d_ws,
                              size_t ws_size, hipStream_t stream) {
  static int grid_blocks = 0;
  if (!grid_blocks) {
    int dev = 0, cus = 0, per_cu = 0;
    hipGetDevice(&dev);
    hipDeviceGetAttribute(&cus, hipDeviceAttributeMultiprocessorCount, dev);
    hipOccupancyMaxActiveBlocksPerMultiprocessor(&per_cu, mega, 256, 0);
    if (per_cu < 1) per_cu = 1;
    if (per_cu > 2) per_cu = 2;
    grid_blocks = cus * per_cu;
    if (ws_size < WS_TOTAL) fprintf(stderr, "kernel_launch: workspace too small: %zu < %zu\n", ws_size, (size_t)WS_TOTAL);
  }
  if (ws_size < WS_TOTAL) return;
  Params p{};
  const float** pp = (const float**)&p;
  for (int i = 0; i < 25; i++) pp[i] = (const float*)d_in[i];
  p.out = (float*)d_out;
  p.ws = (char*)d_ws;
  hipMemsetAsync((char*)d_ws + OFF_BAR, 0, 16384, stream);
#ifdef DBG_MEMSET
  hipMemsetAsync(d_ws, 0, WS_TOTAL, stream);
#endif
#if MULTI_LAUNCH
  for (int ph = 0; ph < NPHASE; ph++) {
    p.ph_lo = ph; p.ph_hi = ph + 1;
    hipLaunchKernelGGL(mega, dim3(grid_blocks), dim3(256), 0, stream, p);
  }
#else
  p.ph_lo = 0; p.ph_hi = NPHASE;
  void* args[] = {&p};
  hipError_t e = hipLaunchCooperativeKernel((void*)mega, dim3(grid_blocks), dim3(256), args, 0, stream);
  if (e != hipSuccess) fprintf(stderr, "cooperative launch failed: %s (grid %d)\n", hipGetErrorString(e), grid_blocks);
#endif
}
```

```cpp
#include <hip/hip_runtime.h>
#include <hip/hip_cooperative_groups.h>
#include <cstdio>
namespace cg = cooperative_groups;

typedef __attribute__((ext_vector_type(8))) short bf16x8;
typedef __attribute__((ext_vector_type(16))) float f32x16;
typedef __attribute__((ext_vector_type(2))) __bf16 bf2v;
typedef __attribute__((ext_vector_type(2))) float f2v;
typedef unsigned short u16;

#define DI __device__ __forceinline__
#define MFMA(a, b, c) __builtin_amdgcn_mfma_f32_32x32x16_bf16((a), (b), (c), 0, 0, 0)

#define DBGS 1.0f

#define DBG_DUMP_OFF OFF_Q
#ifndef MULTI_LAUNCH
#define MULTI_LAUNCH 0
#endif

constexpr int T_TOK = 32768;
constexpr int NPHASE = 31;
constexpr float QSCALE = 0.125f * 1.4426950408889634f;

constexpr size_t OFF_WT_IN  = 0;
constexpr size_t OFF_WT_GLU = OFF_WT_IN + 10485760;
constexpr size_t OFF_WT_OUT = OFF_WT_GLU + 2097152;
constexpr size_t OFF_WT_F1  = OFF_WT_OUT + 8388608;
constexpr size_t OFF_WT_F2  = OFF_WT_F1 + 46137344;
constexpr size_t OFF_MOD    = OFF_WT_F2 + 23068672;
constexpr size_t OFF_BIAS1  = OFF_MOD + 786432;
constexpr size_t OFF_BIAS2  = OFF_BIAS1 + 163840;
constexpr size_t OFF_ROPE   = OFF_BIAS2 + 720896;
constexpr size_t OFF_SSMA   = OFF_ROPE + 8192;
constexpr size_t OFF_SSMBB  = OFF_SSMA + 262144;
constexpr size_t OFF_SSMCC  = OFF_SSMBB + 1048576;
constexpr size_t OFF_E      = OFF_SSMCC + 1048576;
constexpr size_t OFF_SSX    = OFF_E + 4194304;
constexpr size_t OFF_SSA    = OFF_SSX + 2097152;
constexpr size_t OFF_SSS    = OFF_SSA + 1048576;
constexpr size_t OFF_X      = OFF_SSS + 1048576;
constexpr size_t OFF_ACT    = OFF_X + 134217728;
constexpr size_t OFF_UNION  = OFF_ACT + 67108864;
constexpr size_t OFF_HID    = OFF_UNION;
constexpr size_t OFF_Q      = OFF_UNION;
constexpr size_t OFF_K      = OFF_Q + 33554432;
constexpr size_t OFF_VT     = OFF_K + 8388608;
constexpr size_t OFF_U2     = OFF_VT + 8388608;
constexpr size_t OFF_YG     = OFF_U2 + 33554432;
constexpr size_t OFF_OATT   = OFF_YG + 33554432;
constexpr size_t OFF_OSSM   = OFF_OATT + 33554432;
constexpr size_t OFF_BAR    = OFF_UNION + 184549376;
constexpr size_t WS_TOTAL   = OFF_BAR + 16384;

struct Params {
  const float *x, *c, *w_ada, *b_ada, *norm1, *w_in, *q_norm, *k_norm, *lam_re, *lam_im, *log_dt,
      *b_re, *b_im, *c_re, *c_im, *ssm_d, *w_glu, *b_glu, *attn_out_norm, *ssm_out_norm, *w_out, *norm2,
      *w_ffn_in, *w_ffn_out, *final_norm;
  float* out;
  char* ws;
  int ph_lo, ph_hi;
};

DI unsigned pk(float a, float b) {
  f2v v = {a, b};
  bf2v r = __builtin_convertvector(v, bf2v);
  return __builtin_bit_cast(unsigned, r);
}
DI int tidx() { int t = __builtin_amdgcn_workitem_id_x(); asm volatile("" : "+v"(t)); return t; }
typedef const Params __attribute__((address_space(4)))* KParamPtr;
DI Params kparams() {
#if defined(__HIP_DEVICE_COMPILE__)
  KParamPtr q = (KParamPtr)__builtin_amdgcn_kernarg_segment_ptr();
  asm volatile("" : "+s"(q));
  return *q;
#else
  return Params{};
#endif
}
DI float bf2f(unsigned short h) { return __uint_as_float(((unsigned)h) << 16); }
DI void st_bf4(u16* dst, float a, float b, float c, float d) {
  uint2 v; v.x = pk(a, b); v.y = pk(c, d);
  *(uint2*)dst = v;
}
DI float4 ld_bf4(const u16* src) {
  uint2 v = *(const uint2*)src;
  float4 r;
  r.x = __uint_as_float(v.x << 16); r.y = __uint_as_float(v.x & 0xffff0000u);
  r.z = __uint_as_float(v.y << 16); r.w = __uint_as_float(v.y & 0xffff0000u);
  return r;
}
DI float wave_sum(float v) {
#pragma unroll
  for (int o = 32; o > 0; o >>= 1) v += __shfl_xor(v, o);
  return v;
}
DI int crow(int r, int hf) { return (r & 3) + 8 * (r >> 2) + 4 * hf; }
DI int f1perm(int n) {
  int j = (n < 2816) ? n : n - 2816;
  return (j >> 5) * 64 + (j & 31) + ((n < 2816) ? 0 : 32);
}

DI void transpose_tile(const float* __restrict__ src, int N, u16* __restrict__ dst, int K, int k0, int n0,
                       int permmode, const float* __restrict__ kscale, float* tl) {
  const int tid = tidx();
  __syncthreads();
#pragma unroll 4
  for (int i = 0; i < 16; i++) {
    int r = (tid >> 6) + 4 * i;
    float v = src[(size_t)(k0 + r) * N + n0 + (tid & 63)];
    if (kscale) v *= kscale[k0 + r];
    tl[r * 65 + (tid & 63)] = v;
  }
  __syncthreads();
#pragma unroll 4
  for (int i = 0; i < 8; i++) {
    int n = (tid >> 5) + 8 * i;
    int kp = tid & 31;
    float a = tl[(2 * kp) * 65 + n], b = tl[(2 * kp + 1) * 65 + n];
    int nn = n0 + n;
    int no = permmode ? f1perm(nn) : nn;
    *(unsigned*)(dst + (size_t)no * K + k0 + 2 * kp) = pk(a, b);
  }
}

DI void gemv8_item(const float* vec, int vstride, bool do_silu, const float* __restrict__ W, int N, int j0,
                   const float* bias, float* out, int ostride, int permmode, float* sm) {
  const int tid = tidx();
  float* vs = sm;
  float* red = sm + 8192;
  __syncthreads();
  for (int i = tid; i < 8192; i += 256) {
    int b = i >> 10, k = i & 1023;
    float v = vec[(size_t)b * vstride + k];
    if (do_silu) v = v / (1.f + expf(-v));
    vs[i] = v;
  }
  __syncthreads();
  const int kq = tid >> 6, jj = tid & 63;
  float acc[8];
#pragma unroll
  for (int b = 0; b < 8; b++) acc[b] = 0.f;
#pragma unroll 4
  for (int k = kq * 256; k < kq * 256 + 256; k++) {
    float w = W[(size_t)k * N + j0 + jj];
#pragma unroll
    for (int b = 0; b < 8; b++) acc[b] += vs[b * 1024 + k] * w;
  }
#pragma unroll
  for (int b = 0; b < 8; b++) red[(kq * 8 + b) * 64 + jj] = acc[b];
  __syncthreads();
  for (int o = tid; o < 512; o += 256) {
    int b = o >> 6, j = o & 63;
    float s = red[(0 * 8 + b) * 64 + j] + red[(8 + b) * 64 + j] + red[(16 + b) * 64 + j] + red[(24 + b) * 64 + j];
    int jg = j0 + j;
    if (bias) s += bias[jg];
    int jo = permmode ? f1perm(jg) : jg;
    out[(size_t)b * ostride + jo] = s;
  }
}

DI void ssm_param_item(const Params& p, int idx) {
  const int tid = tidx();
  const int pp = tid & 63, cq = tid >> 6;
  float* SSMA = (float*)(p.ws + OFF_SSMA);
  u16* BB = (u16*)(p.ws + OFF_SSMBB);
  u16* CC = (u16*)(p.ws + OFF_SSMCC);
  double lr = (double)p.lam_re[idx * 64 + pp];
  if (lr > -1e-4) lr = (double)(-1e-4f);
  double li = (double)p.lam_im[idx * 64 + pp];
  double dt = exp((double)p.log_dt[idx]);
  double mag = exp(lr * dt);
  double ar = mag * cos(li * dt), ai = mag * sin(li * dt);
  double den = lr * lr + li * li;
  double nre = ar - 1.0;
  double kre = (nre * lr + ai * li) / den;
  double kim = (ai * lr - nre * li) / den;
  if (cq == 0) {
    double magL = exp(lr * dt * 256.0);
    float4 v;
    v.x = (float)ar; v.y = (float)ai;
    v.z = (float)(magL * cos(li * dt * 256.0)); v.w = (float)(magL * sin(li * dt * 256.0));
    *(float4*)(SSMA + (size_t)(idx * 64 + pp) * 4) = v;
  }
#pragma unroll
  for (int cc = 0; cc < 4; cc++) {
    int c = cq * 4 + cc;
    double br = (double)p.b_re[(size_t)(idx * 64 + pp) * 16 + c];
    double bi = (double)p.b_im[(size_t)(idx * 64 + pp) * 16 + c];
    float bbr = (float)(kre * br - kim * bi);
    float bbi = (float)(kre * bi + kim * br);
    BB[(size_t)(idx * 128 + pp) * 16 + c] = (u16)(pk(bbr, 0.f) & 0xffffu);
    BB[(size_t)(idx * 128 + 64 + pp) * 16 + c] = (u16)(pk(bbi, 0.f) & 0xffffu);
    float cr = p.c_re[(size_t)(idx * 16 + c) * 64 + pp];
    float ci = p.c_im[(size_t)(idx * 16 + c) * 64 + pp];
    *(unsigned*)(CC + (size_t)(idx * 16 + c) * 128 + 2 * pp) = pk(cr, -ci);
  }
}

DI void phase0(char* smem) {
  const Params p = kparams();
  float* sm = (float*)smem;
  constexpr int N_TIN = 4 * 16 * 20, N_TGLU = 4 * 8 * 8, N_TOUT = 4 * 16 * 16, N_TF1 = 4 * 16 * 88, N_TF2 = 4 * 44 * 16;
  constexpr int N_MOD = 4 * 96, N_SSM = 256, N_ROPE = 1;
  constexpr int S0 = N_MOD, S1 = S0 + N_TIN, S2 = S1 + N_TGLU, S3 = S2 + N_TOUT, S4 = S3 + N_TF1, S5 = S4 + N_TF2,
                S6 = S5 + N_SSM, S7 = S6 + N_ROPE;
  for (int it = blockIdx.x; it < S7; it += gridDim.x) {
    if (it < S0) {
      int l = it / 96, jb = it % 96;
      gemv8_item(p.c, 1024, true, p.w_ada + (size_t)l * 1024 * 6144, 6144, jb * 64, p.b_ada + l * 6144,
                 (float*)(p.ws + OFF_MOD) + (size_t)l * 8 * 6144, 6144, 0, sm);
    } else if (it < S1) {
      int r = it - S0; int l = r / 320; r %= 320; int kt = r / 20, ntile = r % 20;
      transpose_tile(p.w_in + (size_t)l * 1024 * 1280, 1280, (u16*)(p.ws + OFF_WT_IN) + (size_t)l * 1280 * 1024, 1024,
                     kt * 64, ntile * 64, 0, nullptr, sm);
    } else if (it < S2) {
      int r = it - S1; int l = r / 64; r %= 64; int kt = r / 8, ntile = r % 8;
      transpose_tile(p.w_glu + (size_t)l * 512 * 512, 512, (u16*)(p.ws + OFF_WT_GLU) + (size_t)l * 512 * 512, 512,
                     kt * 64, ntile * 64, 0, nullptr, sm);
    } else if (it < S3) {
      int r = it - S2; int l = r / 256; r %= 256; int kt = r / 16, ntile = r % 16;
      const float* ks = (kt < 8) ? (p.attn_out_norm + l * 512) : (p.ssm_out_norm + l * 512 - 512);
      transpose_tile(p.w_out + (size_t)l * 1024 * 1024, 1024, (u16*)(p.ws + OFF_WT_OUT) + (size_t)l * 1024 * 1024, 1024,
                     kt * 64, ntile * 64, 0, ks, sm);
    } else if (it < S4) {
      int r = it - S3; int l = r / 1408; r %= 1408; int kt = r / 88, ntile = r % 88;
      transpose_tile(p.w_ffn_in + (size_t)l * 1024 * 5632, 5632, (u16*)(p.ws + OFF_WT_F1) + (size_t)l * 5632 * 1024, 1024,
                     kt * 64, ntile * 64, 1, nullptr, sm);
    } else if (it < S5) {
      int r = it - S4; int l = r / 704; r %= 704; int kt = r / 16, ntile = r % 16;
      transpose_tile(p.w_ffn_out + (size_t)l * 2816 * 1024, 1024, (u16*)(p.ws + OFF_WT_F2) + (size_t)l * 1024 * 2816, 2816,
                     kt * 64, ntile * 64, 0, nullptr, sm);
    } else if (it < S6) {
      ssm_param_item(p, it - S5);
    } else {
      float* rope = (float*)(p.ws + OFF_ROPE);
      for (int i = tidx(); i < 1024; i += 256) {
        int idx = i >> 4, f = i & 15;
        double ang = (double)idx * pow(10000.0, -(double)f / 16.0);
        rope[i] = (float)cos(ang);
        rope[1024 + i] = (float)sin(ang);
      }
    }
  }
}

DI void phase1(char* smem) {
  const Params p = kparams();
  float* sm = (float*)smem;
  const float* MOD = (const float*)(p.ws + OFF_MOD);
  constexpr int N_B1 = 4 * 20, N_B2 = 4 * 88, N_PREP = T_TOK / 4;
  for (int it = blockIdx.x; it < N_B1 + N_B2 + N_PREP; it += gridDim.x) {
    if (it < N_B1) {
      int l = it / 20, jb = it % 20;
      gemv8_item(MOD + (size_t)l * 8 * 6144 + 0, 6144, false, p.w_in + (size_t)l * 1024 * 1280, 1280, jb * 64, nullptr,
                 (float*)(p.ws + OFF_BIAS1) + (size_t)l * 8 * 1280, 1280, 0, sm);
    } else if (it < N_B1 + N_B2) {
      int r = it - N_B1; int l = r / 88, jb = r % 88;
      gemv8_item(MOD + (size_t)l * 8 * 6144 + 3072, 6144, false, p.w_ffn_in + (size_t)l * 1024 * 5632, 5632, jb * 64, nullptr,
                 (float*)(p.ws + OFF_BIAS2) + (size_t)l * 8 * 5632, 5632, 1, sm);
    } else {
      int r = it - N_B1 - N_B2;
      const int lane = tidx() & 63, wave = tidx() >> 6;
      int t = r * 4 + wave;
      int b = t >> 12;
      const float4* xr = (const float4*)(p.x + (size_t)t * 1024);
      float4 v[4];
      float ss = 0.f;
#pragma unroll
      for (int i = 0; i < 4; i++) {
        v[i] = xr[lane + 64 * i];
        ss += v[i].x * v[i].x + v[i].y * v[i].y + v[i].z * v[i].z + v[i].w * v[i].w;
      }
      ss = wave_sum(ss);
      float* SSX = (float*)(p.ws + OFF_SSX);
      if (lane < 16) SSX[(size_t)t * 16 + lane] = (lane == 0) ? ss : 0.f;
      u16* ACT = (u16*)(p.ws + OFF_ACT);
      const float* sc1 = MOD + (size_t)(0 * 8 + b) * 6144 + 1024;
#pragma unroll
      for (int i = 0; i < 4; i++) {
        int k = (lane + 64 * i) * 4;
        float4 g = *(const float4*)(p.norm1 + k);
        float4 s = *(const float4*)(sc1 + k);
        st_bf4(ACT + (size_t)t * 1024 + k, v[i].x * g.x * (1.f + s.x), v[i].y * g.y * (1.f + s.y),
               v[i].z * g.z * (1.f + s.z), v[i].w * g.w * (1.f + s.w));
      }
    }
  }
}

enum { EPI_IN = 0, EPI_GLU = 1, EPI_OUT = 2, EPI_F1 = 3, EPI_F2 = 4 };

DI float row_rinv16(const float* ssx, int t, float invn) {
  const float4* q = (const float4*)(ssx + (size_t)t * 16);
  float4 a = q[0], b = q[1], c = q[2], d = q[3];
  float s = ((a.x + a.y) + (a.z + a.w)) + ((b.x + b.y) + (b.z + b.w)) + ((c.x + c.y) + (c.z + c.w)) + ((d.x + d.y) + (d.z + d.w));
  return rsqrtf(s * invn + 1e-6f);
}
DI float row_rinv8(const float* ss8, int t, float invn) {
  const float4* q = (const float4*)(ss8 + (size_t)t * 8);
  float4 a = q[0], b = q[1];
  float s = ((a.x + a.y) + (a.z + a.w)) + ((b.x + b.y) + (b.z + b.w));
  return rsqrtf(s * invn + 1e-6f);
}

template <int EPI>
DI void gemm_tile(const Params& p, const int l, const int mt, const int nt, char* smem) {
  constexpr int TJ = 4;
  constexpr int K = (EPI == EPI_GLU) ? 512 : (EPI == EPI_F2 ? 2816 : 1024);
  constexpr int LDA = (EPI == EPI_GLU || EPI == EPI_OUT) ? 512 : (EPI == EPI_F2 ? 2816 : 1024);
  constexpr int KT = K / 64;
  u16* As = (u16*)smem;
  u16* Bs = As + 256 * 72;
  const int tid = tidx(), lane = tid & 63, wave = tid >> 6;
  const int wm = wave >> 1, wn = wave & 1;
  const int hf = lane >> 5, li = lane & 31;
  const int m0 = mt * 256, n0 = nt * 128;

  const u16* A0;
  const u16* A1 = nullptr;
  const u16* W;
  if (EPI == EPI_IN) { A0 = (const u16*)(p.ws + OFF_ACT); W = (const u16*)(p.ws + OFF_WT_IN) + (size_t)l * 1280 * 1024; }
  else if (EPI == EPI_GLU) { A0 = (const u16*)(p.ws + OFF_YG); W = (const u16*)(p.ws + OFF_WT_GLU) + (size_t)l * 512 * 512; }
  else if (EPI == EPI_OUT) { A0 = (const u16*)(p.ws + OFF_OATT); A1 = (const u16*)(p.ws + OFF_OSSM); W = (const u16*)(p.ws + OFF_WT_OUT) + (size_t)l * 1024 * 1024; }
  else if (EPI == EPI_F1) { A0 = (const u16*)(p.ws + OFF_ACT); W = (const u16*)(p.ws + OFF_WT_F1) + (size_t)l * 5632 * 1024; }
  else { A0 = (const u16*)(p.ws + OFF_HID); W = (const u16*)(p.ws + OFF_WT_F2) + (size_t)l * 1024 * 2816; }

  const int lrow = tid >> 3, lc8 = tid & 7;
  const u16* ag0 = A0 + (size_t)(m0 + lrow) * LDA + lc8 * 8;
  const u16* ag1 = (EPI == EPI_OUT) ? (A1 + (size_t)(m0 + lrow) * LDA + lc8 * 8) : nullptr;
  const u16* wg = W + (size_t)(n0 + lrow) * K + lc8 * 8;

  f32x16 acc[2][TJ];
#pragma unroll
  for (int i = 0; i < 2; i++)
#pragma unroll
    for (int j = 0; j < TJ; j++)
#pragma unroll
      for (int r = 0; r < 16; r++) acc[i][j][r] = 0.f;

  uint4 ra0, ra1, ra2, ra3, ra4, ra5, ra6, ra7, rb0, rb1, rb2, rb3;
#define GEMM_GLOAD(kt_)                                                                          \
  {                                                                                              \
    const u16* ap;                                                                               \
    if (EPI == EPI_OUT) ap = ((kt_) < 8) ? (ag0 + (kt_) * 64) : (ag1 + ((kt_) - 8) * 64);        \
    else ap = ag0 + (kt_) * 64;                                                                  \
    const u16* wp = wg + (kt_) * 64;                                                             \
    ra0 = *(const uint4*)(ap);                                                                   \
    ra1 = *(const uint4*)(ap + (size_t)32 * LDA);                                                \
    ra2 = *(const uint4*)(ap + (size_t)64 * LDA);                                                \
    ra3 = *(const uint4*)(ap + (size_t)96 * LDA);                                                \
    ra4 = *(const uint4*)(ap + (size_t)128 * LDA);                                               \
    ra5 = *(const uint4*)(ap + (size_t)160 * LDA);                                               \
    ra6 = *(const uint4*)(ap + (size_t)192 * LDA);                                               \
    ra7 = *(const uint4*)(ap + (size_t)224 * LDA);                                               \
    rb0 = *(const uint4*)(wp);                                                                   \
    rb1 = *(const uint4*)(wp + (size_t)32 * K);                                                  \
    rb2 = *(const uint4*)(wp + (size_t)64 * K);                                                  \
    rb3 = *(const uint4*)(wp + (size_t)96 * K);                                                  \
  }
  GEMM_GLOAD(0);

  int tok[TJ];
#pragma unroll
  for (int j = 0; j < TJ; j++) tok[j] = m0 + wm * 128 + j * 32 + li;

#pragma unroll 1
  for (int kt = 0; kt < KT; kt++) {
    __syncthreads();
    *(uint4*)(As + (lrow) * 72 + lc8 * 8) = ra0;
    *(uint4*)(As + (lrow + 32) * 72 + lc8 * 8) = ra1;
    *(uint4*)(As + (lrow + 64) * 72 + lc8 * 8) = ra2;
    *(uint4*)(As + (lrow + 96) * 72 + lc8 * 8) = ra3;
    *(uint4*)(As + (lrow + 128) * 72 + lc8 * 8) = ra4;
    *(uint4*)(As + (lrow + 160) * 72 + lc8 * 8) = ra5;
    *(uint4*)(As + (lrow + 192) * 72 + lc8 * 8) = ra6;
    *(uint4*)(As + (lrow + 224) * 72 + lc8 * 8) = ra7;
    *(uint4*)(Bs + (lrow) * 72 + lc8 * 8) = rb0;
    *(uint4*)(Bs + (lrow + 32) * 72 + lc8 * 8) = rb1;
    *(uint4*)(Bs + (lrow + 64) * 72 + lc8 * 8) = rb2;
    *(uint4*)(Bs + (lrow + 96) * 72 + lc8 * 8) = rb3;
    __syncthreads();
    if (kt + 1 < KT) GEMM_GLOAD(kt + 1);
    if (EPI == EPI_OUT) {
      if (kt == 8) {
#pragma unroll
        for (int j = 0; j < TJ; j++) {
          const float ra_ = row_rinv8((const float*)(p.ws + OFF_SSA), tok[j], 1.f / 512.f);
          const float rs_ = row_rinv8((const float*)(p.ws + OFF_SSS), tok[j], 1.f / 512.f);
          const float mr = ra_ / rs_;
#pragma unroll
          for (int i = 0; i < 2; i++)
#pragma unroll
            for (int r = 0; r < 16; r++) acc[i][j][r] *= mr;
        }
      }
    }
#pragma unroll
    for (int s = 0; s < 4; s++) {
      bf16x8 wf[2], af[TJ];
#pragma unroll
      for (int i = 0; i < 2; i++) wf[i] = *(const bf16x8*)(Bs + (wn * 64 + i * 32 + li) * 72 + s * 16 + hf * 8);
#pragma unroll
      for (int j = 0; j < TJ; j++) af[j] = *(const bf16x8*)(As + (wm * 128 + j * 32 + li) * 72 + s * 16 + hf * 8);
#pragma unroll
      for (int i = 0; i < 2; i++)
#pragma unroll
        for (int j = 0; j < TJ; j++) acc[i][j] = MFMA(wf[i], af[j], acc[i][j]);
    }
  }

  const int b = m0 >> 12;
  const int nbase = n0 + wn * 64;
  const float* MOD = (const float*)(p.ws + OFF_MOD);

  if (EPI == EPI_IN) {
    const float* bias = (const float*)(p.ws + OFF_BIAS1) + (size_t)(l * 8 + b) * 1280;
    const float* SSX = (const float*)(p.ws + OFF_SSX);
    float rinv[TJ];
#pragma unroll
    for (int j = 0; j < TJ; j++) rinv[j] = row_rinv16(SSX, tok[j], 1.f / 1024.f);
#pragma unroll
    for (int i = 0; i < 2; i++)
#pragma unroll
      for (int q4 = 0; q4 < 4; q4++) {
        float4 b4 = *(const float4*)(bias + nbase + i * 32 + 8 * q4 + 4 * hf);
#pragma unroll
        for (int j = 0; j < TJ; j++) {
          acc[i][j][4 * q4 + 0] = acc[i][j][4 * q4 + 0] * rinv[j] + b4.x;
          acc[i][j][4 * q4 + 1] = acc[i][j][4 * q4 + 1] * rinv[j] + b4.y;
          acc[i][j][4 * q4 + 2] = acc[i][j][4 * q4 + 2] * rinv[j] + b4.z;
          acc[i][j][4 * q4 + 3] = acc[i][j][4 * q4 + 3] * rinv[j] + b4.w;
        }
      }
    if (nt < 5) {
#pragma unroll
      for (int j = 0; j < TJ; j++) {
        const int t = tok[j], pos = t & 4095;
#pragma unroll
        for (int i = 0; i < 2; i++)
#pragma unroll
          for (int q4 = 0; q4 < 4; q4++) {
            const int d0 = i * 32 + 8 * q4 + 4 * hf;
            u16* dst = (nt < 4) ? ((u16*)(p.ws + OFF_Q) + (size_t)t * 512 + (nt * 2 + wn) * 64 + d0)
                                : ((u16*)(p.ws + OFF_K) + ((size_t)(b * 2 + wn) * 4096 + pos) * 64 + d0);
            st_bf4(dst, acc[i][j][4 * q4 + 0], acc[i][j][4 * q4 + 1], acc[i][j][4 * q4 + 2], acc[i][j][4 * q4 + 3]);
          }
      }
    } else if (nt == 5) {
      u16* VT = (u16*)(p.ws + OFF_VT);
#pragma unroll
      for (int j = 0; j < TJ; j++) {
        const int pos = tok[j] & 4095;
#pragma unroll
        for (int i = 0; i < 2; i++)
#pragma unroll
          for (int r = 0; r < 16; r++) {
            int d = i * 32 + crow(r, hf);
            VT[((size_t)(b * 2 + wn) * 64 + d) * 4096 + pos] = (u16)(pk(acc[i][j][r], 0.f) & 0xffffu);
          }
      }
    } else {
      u16* U2 = (u16*)(p.ws + OFF_U2);
      const int ch0 = (nt - 6) * 128 + wn * 64;
#pragma unroll
      for (int j = 0; j < TJ; j++) {
        const int pos = tok[j] & 4095;
#pragma unroll
        for (int i = 0; i < 2; i++)
#pragma unroll
          for (int q4 = 0; q4 < 4; q4++) {
            int ch = ch0 + i * 32 + 8 * q4 + 4 * hf;
            int g = ch >> 4, c0 = ch & 15;
            st_bf4(U2 + (((size_t)(b * 32 + g)) * 4096 + pos) * 16 + c0, acc[i][j][4 * q4 + 0], acc[i][j][4 * q4 + 1],
                   acc[i][j][4 * q4 + 2], acc[i][j][4 * q4 + 3]);
          }
      }
    }
  } else if (EPI == EPI_GLU) {
    const float* bg = p.b_glu + l * 512;
    const u16* YG = (const u16*)(p.ws + OFF_YG);
    u16* OSSM = (u16*)(p.ws + OFF_OSSM);
    float* SSS = (float*)(p.ws + OFF_SSS);
#pragma unroll
    for (int j = 0; j < TJ; j++) {
      const int t = tok[j];
      float ss = 0.f;
#pragma unroll
      for (int i = 0; i < 2; i++)
#pragma unroll
        for (int q4 = 0; q4 < 4; q4++) {
          const int n = nbase + i * 32 + 8 * q4 + 4 * hf;
          float4 b4 = *(const float4*)(bg + n);
          float4 y = ld_bf4(YG + (size_t)t * 512 + n);
          float o0 = y.x / (1.f + __expf(-(acc[i][j][4 * q4 + 0] + b4.x)));
          float o1 = y.y / (1.f + __expf(-(acc[i][j][4 * q4 + 1] + b4.y)));
          float o2 = y.z / (1.f + __expf(-(acc[i][j][4 * q4 + 2] + b4.z)));
          float o3 = y.w / (1.f + __expf(-(acc[i][j][4 * q4 + 3] + b4.w)));
          ss += o0 * o0 + o1 * o1 + o2 * o2 + o3 * o3;
          st_bf4(OSSM + (size_t)t * 512 + n, o0, o1, o2, o3);
        }
      ss += __shfl_xor(ss, 32);
      if (hf == 0) SSS[(size_t)t * 8 + nt * 2 + wn] = ss;
    }
  } else if (EPI == EPI_OUT || EPI == EPI_F2) {
    const float* gate = MOD + (size_t)(l * 8 + b) * 6144 + (EPI == EPI_OUT ? 2048 : 5120);
    const bool has_next = (EPI == EPI_OUT) || (l < 3);
    const float* nrm = (EPI == EPI_OUT) ? (p.norm2 + l * 1024) : (p.norm1 + (l + 1) * 1024);
    const float* scn = (EPI == EPI_OUT) ? (MOD + (size_t)(l * 8 + b) * 6144 + 4096) : (MOD + (size_t)((l + 1) * 8 + b) * 6144 + 1024);
    const float* xin = (EPI == EPI_OUT && l == 0) ? p.x : (const float*)(p.ws + OFF_X);
    float* X = (float*)(p.ws + OFF_X);
    u16* ACT = (u16*)(p.ws + OFF_ACT);
    float* SSX = (float*)(p.ws + OFF_SSX);
#pragma unroll
    for (int j = 0; j < TJ; j++) {
      const int t = tok[j];
      const float finj = (EPI == EPI_OUT) ? row_rinv8((const float*)(p.ws + OFF_SSS), t, 1.f / 512.f) : 1.f;
      float ss = 0.f;
#pragma unroll
      for (int i = 0; i < 2; i++)
#pragma unroll
        for (int q4 = 0; q4 < 4; q4++) {
          const int n = nbase + i * 32 + 8 * q4 + 4 * hf;
          float4 g4 = *(const float4*)(gate + n);
          float4 xi = *(const float4*)(xin + (size_t)t * 1024 + n);
          float4 y;
          y.x = xi.x + g4.x * acc[i][j][4 * q4 + 0] * finj;
          y.y = xi.y + g4.y * acc[i][j][4 * q4 + 1] * finj;
          y.z = xi.z + g4.z * acc[i][j][4 * q4 + 2] * finj;
          y.w = xi.w + g4.w * acc[i][j][4 * q4 + 3] * finj;
          *(float4*)(X + (size_t)t * 1024 + n) = y;
          ss += y.x * y.x + y.y * y.y + y.z * y.z + y.w * y.w;
          if (has_next) {
            float4 nr = *(const float4*)(nrm + n);
            float4 sc = *(const float4*)(scn + n);
            st_bf4(ACT + (size_t)t * 1024 + n, y.x * nr.x * (1.f + sc.x), y.y * nr.y * (1.f + sc.y),
                   y.z * nr.z * (1.f + sc.z), y.w * nr.w * (1.f + sc.w));
          }
        }
      ss += __shfl_xor(ss, 32);
      if (hf == 0) SSX[(size_t)t * 16 + nt * 2 + wn] = ss;
    }
  } else {
    const float* bias = (const float*)(p.ws + OFF_BIAS2) + (size_t)(l * 8 + b) * 5632;
    const float* SSX = (const float*)(p.ws + OFF_SSX);
    u16* HID = (u16*)(p.ws + OFF_HID);
    const int jbase = nbase >> 1;
#pragma unroll
    for (int j = 0; j < TJ; j++) {
      const int t = tok[j];
      const float rv = row_rinv16(SSX, t, 1.f / 1024.f);
#pragma unroll
      for (int q4 = 0; q4 < 4; q4++) {
        const int ng = nbase + 8 * q4 + 4 * hf;
        float4 bg4 = *(const float4*)(bias + ng);
        float4 bu4 = *(const float4*)(bias + ng + 32);
        float zg0 = acc[0][j][4 * q4 + 0] * rv + bg4.x, zu0 = acc[1][j][4 * q4 + 0] * rv + bu4.x;
        float zg1 = acc[0][j][4 * q4 + 1] * rv + bg4.y, zu1 = acc[1][j][4 * q4 + 1] * rv + bu4.y;
        float zg2 = acc[0][j][4 * q4 + 2] * rv + bg4.z, zu2 = acc[1][j][4 * q4 + 2] * rv + bu4.z;
        float zg3 = acc[0][j][4 * q4 + 3] * rv + bg4.w, zu3 = acc[1][j][4 * q4 + 3] * rv + bu4.w;
        float h0 = zg0 / (1.f + __expf(-zg0)) * zu0;
        float h1 = zg1 / (1.f + __expf(-zg1)) * zu1;
        float h2 = zg2 / (1.f + __expf(-zg2)) * zu2;
        float h3 = zg3 / (1.f + __expf(-zg3)) * zu3;
        st_bf4(HID + (size_t)t * 2816 + jbase + 8 * q4 + 4 * hf, h0, h1, h2, h3);
      }
    }
  }
}

template <int EPI>
DI void gemm_phase(int l, char* smem) {
  const Params p = kparams();
  constexpr int NT = (EPI == EPI_IN) ? 10 : (EPI == EPI_GLU ? 4 : (EPI == EPI_F1 ? 44 : 8));
  const int g8 = gridDim.x >> 3;
  const int xg = blockIdx.x & 7, lb = blockIdx.x >> 3;
  for (int q = lb; q < 16 * NT; q += g8) {
    const int mg = q / (8 * NT);
    const int rem = q - mg * 8 * NT;
    gemm_tile<EPI>(p, l, xg * 16 + mg * 8 + (rem & 7), rem >> 3, smem);
  }
}

DI void attn_item(const Params& p, int item, char* smem) {
  u16* Ks = (u16*)smem;
  u16* Vs = Ks + 64 * 72;
  const int tid = tidx(), lane = tid & 63, wave = tid >> 6;
  const int hf = lane >> 5, li = lane & 31;
  const int xcd = item & 7, local = item >> 3;
  const int pair = xcd * 2 + (local >> 7);
  const int within = local & 127;
  const int hq = within >> 5, qb = within & 31;
  const int b = pair >> 1, kvh = pair & 1, h = kvh * 4 + hq;
  const int t = b * 4096 + qb * 128 + wave * 32 + li;

  const u16* Q = (const u16*)(p.ws + OFF_Q);
  bf16x8 qf[4];
#pragma unroll
  for (int s = 0; s < 4; s++) qf[s] = *(const bf16x8*)(Q + (size_t)t * 512 + h * 64 + 16 * s + 8 * hf);

  f32x16 o0, o1;
#pragma unroll
  for (int r = 0; r < 16; r++) { o0[r] = 0.f; o1[r] = 0.f; }
  float m_run = -1e30f, l_run = 0.f;

  const int lrow = tid >> 3, lc8 = tid & 7;
  const u16* Kg = (const u16*)(p.ws + OFF_K) + (size_t)pair * 4096 * 64 + (size_t)lrow * 64 + lc8 * 8;
  const u16* Vg = (const u16*)(p.ws + OFF_VT) + (size_t)pair * 64 * 4096 + (size_t)lrow * 4096 + lc8 * 8;
  uint4 rk0, rk1, rv0, rv1;
#define ATT_GLOAD(kt_)                                                   \
  {                                                                      \
    rk0 = *(const uint4*)(Kg + (size_t)((kt_) * 64) * 64);               \
    rk1 = *(const uint4*)(Kg + (size_t)((kt_) * 64 + 32) * 64);          \
    rv0 = *(const uint4*)(Vg + (kt_) * 64);                              \
    rv1 = *(const uint4*)(Vg + (size_t)32 * 4096 + (kt_) * 64);          \
  }
  ATT_GLOAD(0);
  const int kap = (li & 0x13) | ((li & 4) << 1) | ((li & 8) >> 1);

  for (int kt = 0; kt < 64; kt++) {
    __syncthreads();
    *(uint4*)(Ks + (lrow) * 72 + lc8 * 8) = rk0;
    *(uint4*)(Ks + (lrow + 32) * 72 + lc8 * 8) = rk1;
    *(uint4*)(Vs + (lrow) * 72 + lc8 * 8) = rv0;
    *(uint4*)(Vs + (lrow + 32) * 72 + lc8 * 8) = rv1;
    __syncthreads();
    if (kt + 1 < 64) ATT_GLOAD(kt + 1);

    f32x16 s0, s1;
#pragma unroll
    for (int r = 0; r < 16; r++) { s0[r] = 0.f; s1[r] = 0.f; }
#pragma unroll
    for (int s = 0; s < 4; s++) {
      bf16x8 kf0 = *(const bf16x8*)(Ks + kap * 72 + 16 * s + 8 * hf);
      bf16x8 kf1 = *(const bf16x8*)(Ks + (32 + kap) * 72 + 16 * s + 8 * hf);
      s0 = MFMA(kf0, qf[s], s0);
      s1 = MFMA(kf1, qf[s], s1);
    }
    float mx = s0[0];
#pragma unroll
    for (int r = 1; r < 16; r++) mx = fmaxf(mx, s0[r]);
#pragma unroll
    for (int r = 0; r < 16; r++) mx = fmaxf(mx, s1[r]);
    mx = fmaxf(mx, __shfl_xor(mx, 32));
    const float mnew = fmaxf(m_run, mx);
    const float alpha = __builtin_amdgcn_exp2f(m_run - mnew);
    m_run = mnew;
    float ps = 0.f;
#pragma unroll
    for (int r = 0; r < 16; r++) { s0[r] = __builtin_amdgcn_exp2f(s0[r] - mnew); ps += s0[r]; }
#pragma unroll
    for (int r = 0; r < 16; r++) { s1[r] = __builtin_amdgcn_exp2f(s1[r] - mnew); ps += s1[r]; }
    l_run = l_run * alpha + ps;
#pragma unroll
    for (int r = 0; r < 16; r++) { o0[r] *= alpha; o1[r] *= alpha; }
#pragma unroll
    for (int sp = 0; sp < 2; sp++) {
      bf16x8 pb;
      {
        unsigned u0 = pk(s0[8 * sp + 0], s0[8 * sp + 1]), u1 = pk(s0[8 * sp + 2], s0[8 * sp + 3]);
        unsigned u2 = pk(s0[8 * sp + 4], s0[8 * sp + 5]), u3 = pk(s0[8 * sp + 6], s0[8 * sp + 7]);
        uint4 uu = make_uint4(u0, u1, u2, u3);
        pb = __builtin_bit_cast(bf16x8, uu);
      }
      bf16x8 vf0 = *(const bf16x8*)(Vs + li * 72 + 16 * sp + 8 * hf);
      bf16x8 vf1 = *(const bf16x8*)(Vs + (32 + li) * 72 + 16 * sp + 8 * hf);
      o0 = MFMA(vf0, pb, o0);
      o1 = MFMA(vf1, pb, o1);
    }
#pragma unroll
    for (int sp = 0; sp < 2; sp++) {
      bf16x8 pb;
      {
        unsigned u0 = pk(s1[8 * sp + 0], s1[8 * sp + 1]), u1 = pk(s1[8 * sp + 2], s1[8 * sp + 3]);
        unsigned u2 = pk(s1[8 * sp + 4], s1[8 * sp + 5]), u3 = pk(s1[8 * sp + 6], s1[8 * sp + 7]);
        uint4 uu = make_uint4(u0, u1, u2, u3);
        pb = __builtin_bit_cast(bf16x8, uu);
      }
      bf16x8 vf0 = *(const bf16x8*)(Vs + li * 72 + 32 + 16 * sp + 8 * hf);
      bf16x8 vf1 = *(const bf16x8*)(Vs + (32 + li) * 72 + 32 + 16 * sp + 8 * hf);
      o0 = MFMA(vf0, pb, o0);
      o1 = MFMA(vf1, pb, o1);
    }
  }
  const float ltot = l_run + __shfl_xor(l_run, 32);
  const float inv = 1.f / ltot;
  u16* OATT = (u16*)(p.ws + OFF_OATT);
  float ss = 0.f;
#pragma unroll
  for (int q4 = 0; q4 < 4; q4++) {
    float a0 = o0[4 * q4 + 0] * inv, a1 = o0[4 * q4 + 1] * inv, a2 = o0[4 * q4 + 2] * inv, a3 = o0[4 * q4 + 3] * inv;
    float c0 = o1[4 * q4 + 0] * inv, c1 = o1[4 * q4 + 1] * inv, c2 = o1[4 * q4 + 2] * inv, c3 = o1[4 * q4 + 3] * inv;
    ss += a0 * a0 + a1 * a1 + a2 * a2 + a3 * a3 + c0 * c0 + c1 * c1 + c2 * c2 + c3 * c3;
    st_bf4(OATT + (size_t)t * 512 + h * 64 + 8 * q4 + 4 * hf, a0, a1, a2, a3);
    st_bf4(OATT + (size_t)t * 512 + h * 64 + 32 + 8 * q4 + 4 * hf, c0, c1, c2, c3);
  }
  ss += __shfl_xor(ss, 32);
  if (hf == 0) ((float*)(p.ws + OFF_SSA))[(size_t)t * 8 + h] = ss;
}

DI bf16x8 ssm_ufrag(const u16* U2, int bp, int g, int tb, int li, int hf) {
  const int seq = (li >> 2) & 1, step = ((li >> 3) << 2) | (li & 3);
  return *(const bf16x8*)(U2 + (((size_t)((2 * bp + seq) * 32 + g)) * 4096 + tb + step) * 16 + 8 * hf);
}

DI void ssm_scan16(const f32x16& x0, const f32x16& x1, const f32x16& x2, const f32x16& x3, const float4 a0, const float4 a1,
                   float& h0r, float& h0i, float& h1r, float& h1i, const int dir) {
  if (dir == 0) {
#pragma unroll
    for (int r = 0; r < 16; r++) {
      float nr = a0.x * h0r - a0.y * h0i + x0[r], ni = a0.x * h0i + a0.y * h0r + x2[r];
      h0r = nr; h0i = ni;
      float mr = a1.x * h1r - a1.y * h1i + x1[r], mi = a1.x * h1i + a1.y * h1r + x3[r];
      h1r = mr; h1i = mi;
    }
  } else {
#pragma unroll
    for (int r = 15; r >= 0; r--) {
      float nr = a0.x * h0r - a0.y * h0i + x0[r], ni = a0.x * h0i + a0.y * h0r + x2[r];
      h0r = nr; h0i = ni;
      float mr = a1.x * h1r - a1.y * h1i + x1[r], mi = a1.x * h1i + a1.y * h1r + x3[r];
      h1r = mr; h1i = mi;
    }
  }
}

DI void ssm1_item(const Params& p, int l, int item) {
  const int tid = tidx(), lane = tid & 63, wave = __builtin_amdgcn_readfirstlane(tid >> 6);
  const int hf = lane >> 5, li = lane & 31;
  const int w = item * 4 + wave;
  const int ch = w & 15, bp = (w >> 4) & 3, g = (w >> 6) & 31, dir = w >> 11;
  const int idx = (l * 2 + dir) * 32 + g;
  const u16* U2 = (const u16*)(p.ws + OFF_U2);
  const u16* BB = (const u16*)(p.ws + OFF_SSMBB) + (size_t)idx * 128 * 16;
  const float* SA = (const float*)(p.ws + OFF_SSMA) + (size_t)idx * 64 * 4;
  bf16x8 bbf[4];
#pragma unroll
  for (int j = 0; j < 4; j++) bbf[j] = *(const bf16x8*)(BB + (32 * j + li) * 16 + 8 * hf);
  const float4 a0 = *(const float4*)(SA + li * 4);
  const float4 a1 = *(const float4*)(SA + (li + 32) * 4);
  float h0r = 0.f, h0i = 0.f, h1r = 0.f, h1i = 0.f;
  f32x16 zero;
#pragma unroll
  for (int r = 0; r < 16; r++) zero[r] = 0.f;
#define SSM_TB(it_) (ch * 256 + (dir ? (15 - (it_)) : (it_)) * 16)
  bf16x8 q0 = ssm_ufrag(U2, bp, g, SSM_TB(0), li, hf), q1 = ssm_ufrag(U2, bp, g, SSM_TB(1), li, hf);
  bf16x8 q2 = ssm_ufrag(U2, bp, g, SSM_TB(2), li, hf), q3 = ssm_ufrag(U2, bp, g, SSM_TB(3), li, hf);
#pragma unroll 1
  for (int it = 0; it < 16; it++) {
    const bf16x8 uf = q0;
    q0 = q1; q1 = q2; q2 = q3;
    const int itn = (it + 4 < 16) ? (it + 4) : 15;
    q3 = ssm_ufrag(U2, bp, g, SSM_TB(itn), li, hf);
    f32x16 x0 = MFMA(uf, bbf[0], zero), x1 = MFMA(uf, bbf[1], zero), x2 = MFMA(uf, bbf[2], zero), x3 = MFMA(uf, bbf[3], zero);
    ssm_scan16(x0, x1, x2, x3, a0, a1, h0r, h0i, h1r, h1i, dir);
  }
  float* E = (float*)(p.ws + OFF_E) + ((((size_t)(dir * 32 + g) * 8 + (2 * bp + hf)) * 16 + ch) * 64) * 2;
  *(float2*)(E + li * 2) = make_float2(h0r, h0i);
  *(float2*)(E + (li + 32) * 2) = make_float2(h1r, h1i);
}

DI void ssm2_item(const Params& p, int l, int item, char* smem) {
  const int tid = tidx(), lane = tid & 63, wave = __builtin_amdgcn_readfirstlane(tid >> 6);
  const int hf = lane >> 5, li = lane & 31;
  const int w = item * 4 + wave;
  const int ch = w & 15, bp = (w >> 4) & 3, g = w >> 6;
  u16* Hs = (u16*)smem + wave * (32 * 136);
  const u16* U2 = (const u16*)(p.ws + OFF_U2);
  float* YF = (float*)(p.ws + OFF_ACT);
  u16* YG = (u16*)(p.ws + OFF_YG);
  f32x16 zero;
#pragma unroll
  for (int r = 0; r < 16; r++) zero[r] = 0.f;
  const int oseq = li >> 4, ostep = li & 15;
  const int ob = 2 * bp + oseq;

  for (int dir = 0; dir < 2; dir++) {
    const int idx = (l * 2 + dir) * 32 + g;
    const u16* BB = (const u16*)(p.ws + OFF_SSMBB) + (size_t)idx * 128 * 16;
    const u16* CC = (const u16*)(p.ws + OFF_SSMCC) + (size_t)idx * 16 * 128;
    const float* SA = (const float*)(p.ws + OFF_SSMA) + (size_t)idx * 64 * 4;
    bf16x8 bbf[4], ccf[8];
#pragma unroll
    for (int j = 0; j < 4; j++) bbf[j] = *(const bf16x8*)(BB + (32 * j + li) * 16 + 8 * hf);
#pragma unroll
    for (int s = 0; s < 8; s++) {
      bf16x8 v = *(const bf16x8*)(CC + (li & 15) * 128 + 16 * s + 8 * hf);
      if (li >= 16) {
#pragma unroll
        for (int e = 0; e < 8; e++) v[e] = 0;
      }
      ccf[s] = v;
    }
    const float4 a0 = *(const float4*)(SA + li * 4);
    const float4 a1 = *(const float4*)(SA + (li + 32) * 4);
    float h0r = 0.f, h0i = 0.f, h1r = 0.f, h1i = 0.f;
    {
      const float* E = (const float*)(p.ws + OFF_E) + ((((size_t)(dir * 32 + g) * 8 + (2 * bp + hf)) * 16) * 64) * 2;
      const int n = dir ? (15 - ch) : ch;
      for (int i0 = 0; i0 < n; i0 += 4) {
        float2 e0[4], e1[4];
#pragma unroll
        for (int u = 0; u < 4; u++) {
          int ii = i0 + u; if (ii > n - 1) ii = n - 1;
          const int ci = dir ? (15 - ii) : ii;
          e0[u] = *(const float2*)(E + (size_t)ci * 128 + li * 2);
          e1[u] = *(const float2*)(E + (size_t)ci * 128 + (li + 32) * 2);
        }
#pragma unroll
        for (int u = 0; u < 4; u++) {
          if (i0 + u < n) {
            float nr = a0.z * h0r - a0.w * h0i + e0[u].x, ni = a0.z * h0i + a0.w * h0r + e0[u].y;
            h0r = nr; h0i = ni;
            float mr = a1.z * h1r - a1.w * h1i + e1[u].x, mi = a1.z * h1i + a1.w * h1r + e1[u].y;
            h1r = mr; h1i = mi;
          }
        }
      }
    }
    bf16x8 ufn = ssm_ufrag(U2, bp, g, ch * 256 + (dir ? 15 : 0) * 16, li, hf);
    for (int it = 0; it < 16; it++) {
      const int tb = ch * 256 + (dir ? (15 - it) : it) * 16;
      const bf16x8 uf = ufn;
      f32x16 x0 = MFMA(uf, bbf[0], zero), x1 = MFMA(uf, bbf[1], zero), x2 = MFMA(uf, bbf[2], zero), x3 = MFMA(uf, bbf[3], zero);
      if (it + 1 < 16) ufn = ssm_ufrag(U2, bp, g, ch * 256 + (dir ? (14 - it) : (it + 1)) * 16, li, hf);
      const int tt = tb + ostep;
      const size_t yoff = (((size_t)(ob * 32 + g)) * 4096 + tt) * 16;
      float4 f0 = make_float4(0.f, 0.f, 0.f, 0.f), f1 = f0, u0 = f0, u1 = f0;
      if (dir) {
        f0 = *(const float4*)(YF + yoff + 4 * hf);
        f1 = *(const float4*)(YF + yoff + 8 + 4 * hf);
        u0 = ld_bf4(U2 + yoff + 4 * hf);
        u1 = ld_bf4(U2 + yoff + 8 + 4 * hf);
      }
      __syncthreads();
      if (dir == 0) {
#pragma unroll
        for (int r = 0; r < 16; r++) {
          float nr = a0.x * h0r - a0.y * h0i + x0[r], ni = a0.x * h0i + a0.y * h0r + x2[r];
          h0r = nr; h0i = ni;
          float mr = a1.x * h1r - a1.y * h1i + x1[r], mi = a1.x * h1i + a1.y * h1r + x3[r];
          h1r = mr; h1i = mi;
          *(unsigned*)(Hs + (hf * 16 + r) * 136 + 2 * li) = pk(h0r, h0i);
          *(unsigned*)(Hs + (hf * 16 + r) * 136 + 2 * (li + 32)) = pk(h1r, h1i);
        }
      } else {
#pragma unroll
        for (int r = 15; r >= 0; r--) {
          float nr = a0.x * h0r - a0.y * h0i + x0[r], ni = a0.x * h0i + a0.y * h0r + x2[r];
          h0r = nr; h0i = ni;
          float mr = a1.x * h1r - a1.y * h1i + x1[r], mi = a1.x * h1i + a1.y * h1r + x3[r];
          h1r = mr; h1i = mi;
          *(unsigned*)(Hs + (hf * 16 + r) * 136 + 2 * li) = pk(h0r, h0i);
          *(unsigned*)(Hs + (hf * 16 + r) * 136 + 2 * (li + 32)) = pk(h1r, h1i);
        }
      }
      __syncthreads();
      f32x16 y = zero;
#pragma unroll
      for (int s = 0; s < 8; s++) {
        bf16x8 hfv = *(const bf16x8*)(Hs + li * 136 + 16 * s + 8 * hf);
        y = MFMA(ccf[s], hfv, y);
      }
      if (dir == 0) {
        *(float4*)(YF + yoff + 4 * hf) = make_float4(y[0], y[1], y[2], y[3]);
        *(float4*)(YF + yoff + 8 + 4 * hf) = make_float4(y[4], y[5], y[6], y[7]);
      } else {
        float4 d0 = *(const float4*)(p.ssm_d + l * 512 + g * 16 + 4 * hf);
        float4 d1 = *(const float4*)(p.ssm_d + l * 512 + g * 16 + 8 + 4 * hf);
        float v[8];
        v[0] = f0.x + y[0] + d0.x * u0.x; v[1] = f0.y + y[1] + d0.y * u0.y;
        v[2] = f0.z + y[2] + d0.z * u0.z; v[3] = f0.w + y[3] + d0.w * u0.w;
        v[4] = f1.x + y[4] + d1.x * u1.x; v[5] = f1.y + y[5] + d1.y * u1.y;
        v[6] = f1.z + y[6] + d1.z * u1.z; v[7] = f1.w + y[7] + d1.w * u1.w;
#pragma unroll
        for (int e = 0; e < 8; e++) {
          float xx = v[e];
          float z = 0.7978845608028654f * (xx + 0.044715f * xx * xx * xx);
          float th = 1.f - 2.f / (__expf(2.f * z) + 1.f);
          v[e] = 0.5f * xx * (1.f + th);
        }
        u16* yg = YG + ((size_t)(ob * 4096 + tt)) * 512 + g * 16;
        st_bf4(yg + 4 * hf, v[0], v[1], v[2], v[3]);
        st_bf4(yg + 8 + 4 * hf, v[4], v[5], v[6], v[7]);
      }
    }
    __syncthreads();
  }
}

DI void qkpost_phase(int l) {
  const Params p = kparams();
  const float* ROPE = (const float*)(p.ws + OFF_ROPE);
  const int nrows = T_TOK * 8 + T_TOK * 2;
  for (int r = blockIdx.x * 256 + tidx(); r < nrows; r += gridDim.x * 256) {
    const bool isq = r < T_TOK * 8;
    const int rk = r - T_TOK * 8;
    u16* row = isq ? ((u16*)(p.ws + OFF_Q) + (size_t)r * 64) : ((u16*)(p.ws + OFF_K) + (size_t)rk * 64);
    const int pos = isq ? ((r >> 3) & 4095) : (rk & 4095);
    const float* gn = isq ? (p.q_norm + l * 64) : (p.k_norm + l * 64);
    const float osc = isq ? QSCALE : 1.f;
    float v[64];
#pragma unroll
    for (int c = 0; c < 8; c++) {
      uint4 raw = ((const uint4*)row)[c];
      v[8 * c + 0] = __uint_as_float(raw.x << 16); v[8 * c + 1] = __uint_as_float(raw.x & 0xffff0000u);
      v[8 * c + 2] = __uint_as_float(raw.y << 16); v[8 * c + 3] = __uint_as_float(raw.y & 0xffff0000u);
      v[8 * c + 4] = __uint_as_float(raw.z << 16); v[8 * c + 5] = __uint_as_float(raw.z & 0xffff0000u);
      v[8 * c + 6] = __uint_as_float(raw.w << 16); v[8 * c + 7] = __uint_as_float(raw.w & 0xffff0000u);
    }
    float ss = 0.f;
#pragma unroll
    for (int e = 0; e < 64; e++) ss += v[e] * v[e];
    const float rn = rsqrtf(ss * (1.f / 64.f) + 1e-6f) * osc;
    const int irow = pos >> 6, icol = pos & 63;
#pragma unroll
    for (int c = 0; c < 8; c++) {
      float o[8];
#pragma unroll
      for (int e = 0; e < 4; e++) {
        const int pi = 4 * c + e;
        const int idx = (pi < 16) ? irow : icol;
        const float cs = ROPE[idx * 16 + (pi & 15)];
        const float sn = ROPE[1024 + idx * 16 + (pi & 15)];
        const float y0 = v[2 * pi] * rn * gn[2 * pi], y1 = v[2 * pi + 1] * rn * gn[2 * pi + 1];
        o[2 * e] = y0 * cs - y1 * sn;
        o[2 * e + 1] = y0 * sn + y1 * cs;
      }
      uint4 w;
      w.x = pk(o[0], o[1]); w.y = pk(o[2], o[3]); w.z = pk(o[4], o[5]); w.w = pk(o[6], o[7]);
      ((uint4*)row)[c] = w;
    }
  }
}

DI void attn_phase(char* smem) {
  const Params p = kparams();
  for (int it = blockIdx.x; it < 2048; it += gridDim.x) attn_item(p, it, smem);
}
DI void ssm1_phase(int l) {
  const Params p = kparams();
  for (int it = blockIdx.x; it < 1024; it += gridDim.x) ssm1_item(p, l, it);
}
DI void ssm2_phase(int l, char* smem) {
  const Params p = kparams();
  for (int it = blockIdx.x; it < 512; it += gridDim.x) ssm2_item(p, l, it, smem);
}

DI void final_phase() {
  const Params p = kparams();
  const float* X = (const float*)(p.ws + OFF_X);
  const float* SSX = (const float*)(p.ws + OFF_SSX);
  const int total = T_TOK * 256;
  for (int i = blockIdx.x * 256 + tidx(); i < total; i += gridDim.x * 256) {
    int t = i >> 8, n = (i & 255) * 4;
    float rv = row_rinv16(SSX, t, 1.f / 1024.f);
    float4 x = *(const float4*)(X + (size_t)t * 1024 + n);
    float4 g = *(const float4*)(p.final_norm + n);
    float4 o;
    o.x = x.x * rv * g.x * DBGS; o.y = x.y * rv * g.y * DBGS; o.z = x.z * rv * g.z * DBGS; o.w = x.w * rv * g.w * DBGS;
    *(float4*)(p.out + (size_t)t * 1024 + n) = o;
  }
}

#define XB_TMO      128
#define XB_XCNT(j)  (256  + 64 * (j))
#define XB_XSUB(j)  (1280 + 64 * (j))
#define XB_XGEN(j)  (2304 + 64 * (j))
#define XB_TOP      3328
#define XB_TOPGEN   3392
#define XCD_BAR_WORDS 3456
#define XB_SPIN_CAP (1u << 18)
#define LAS __attribute__((address_space(3)))

__device__ __forceinline__ unsigned xb_ld(unsigned* p)              { return __hip_atomic_load(p, __ATOMIC_RELAXED, __HIP_MEMORY_SCOPE_AGENT); }
__device__ __forceinline__ unsigned xb_add(unsigned* p, unsigned v) { return __hip_atomic_fetch_add(p, v, __ATOMIC_RELAXED, __HIP_MEMORY_SCOPE_AGENT); }
__device__ __forceinline__ unsigned xb_xcc_id() { return (unsigned)__builtin_amdgcn_s_getreg((3 << 11) | 20) & 0xFu; }
#define XB_SPIN(cond, bar) do { unsigned _sp = 0; while (cond) { __builtin_amdgcn_s_sleep(1); \
    if ((++_sp & 255u) == 0u) { if (xb_ld(&(bar)[XB_TMO])) break; if (_sp > XB_SPIN_CAP) { atomicAdd(&(bar)[XB_TMO], 1u); break; } } } } while (0)

struct XcdBarrier {
    unsigned* bar; unsigned x;
    volatile LAS unsigned* st;
};

__device__ __forceinline__ XcdBarrier xcd_barrier_post(unsigned* bar, volatile LAS unsigned* st) {
    XcdBarrier b; b.bar = bar; b.x = xb_xcc_id(); b.st = st;
    if (threadIdx.x == 0) (void)xb_add(&bar[XB_XCNT(b.x)], 1u);
    return b;
}
__device__ __forceinline__ void xcd_barrier_complete(unsigned* bar, unsigned x, unsigned& nloc, unsigned& nx) {
    const unsigned G = gridDim.x * gridDim.y * gridDim.z;
    unsigned sum, cnt, mine, sp = 0u;
    for (;;) {
        sum = 0u; cnt = 0u; mine = 0u;
#pragma unroll
        for (unsigned j = 0; j < 16; ++j) { const unsigned c = xb_ld(&bar[XB_XCNT(j)]); sum += c; cnt += (c > 0u) ? 1u : 0u; mine = (j == x) ? c : mine; }
        if (sum == G) break;
        __builtin_amdgcn_s_sleep(1);
        if ((++sp & 255u) == 0u) { if (xb_ld(&bar[XB_TMO])) break; if (sp > XB_SPIN_CAP) { atomicAdd(&bar[XB_TMO], 1u); break; } }
    }
    nloc = mine > 0u ? mine : 1u; nx = cnt > 0u ? cnt : 1u;
}

__device__ __forceinline__ void xcd_barrier(const XcdBarrier& b) {
    asm volatile("s_waitcnt vmcnt(0)" ::: "memory");
    __syncthreads();
    if (threadIdx.x == 0) {
        unsigned* bar = b.bar;
        __builtin_amdgcn_s_waitcnt(0);
        unsigned nloc = b.st[0], nx = b.st[1];
        if (nloc == 0u) { xcd_barrier_complete(bar, b.x, nloc, nx); b.st[0] = nloc; b.st[1] = nx; }
        const unsigned old = xb_add(&bar[XB_XSUB(b.x)], 1u);
        const unsigned gen = old / nloc;
        if (old + 1u == (gen + 1u) * nloc) {
            __builtin_amdgcn_fence(__ATOMIC_RELEASE, "agent");
            asm volatile("s_waitcnt vmcnt(0)" ::: "memory");
            const unsigned og = xb_add(&bar[XB_TOP], 1u);
            const unsigned tg = og / nx;
            if (og + 1u == (tg + 1u) * nx) xb_add(&bar[XB_TOPGEN], 1u);
            else XB_SPIN(xb_ld(&bar[XB_TOPGEN]) == tg, bar);
            __builtin_amdgcn_fence(__ATOMIC_ACQUIRE, "agent");
            xb_add(&bar[XB_XGEN(b.x)], 1u);
            asm volatile("s_waitcnt vmcnt(0)" ::: "memory");
        } else {
            XB_SPIN(xb_ld(&bar[XB_XGEN(b.x)]) == gen, bar);
            __builtin_amdgcn_fence(__ATOMIC_ACQUIRE, "agent");
            asm volatile("s_waitcnt vmcnt(0)" ::: "memory");
        }
    }
    __syncthreads();
}
#define GSYNC() xcd_barrier(xbar)
#ifndef ONLYK
#define ONLYK -1
#endif
#ifndef ENMASK
#define ENMASK 0x7ff
#endif
#define EN(n) ((ONLYK < 0 && ((ENMASK >> (n)) & 1)) || ONLYK == (n))
__global__ void __launch_bounds__(256, 2) mega(Params p_) {
  __shared__ __attribute__((aligned(16))) char smem[55296];
  cg::grid_group grid = cg::this_grid();
  __shared__ __attribute__((aligned(16))) unsigned xb_words[4];
  if (tidx() < 4) xb_words[tidx()] = 0u;
  __syncthreads();
  if (p_.ph_lo < 0) grid.sync();
  const XcdBarrier xbar = xcd_barrier_post((unsigned*)(p_.ws + OFF_BAR), (volatile LAS unsigned*)xb_words);
#ifdef DBG_COPY
  {
    const Params p = kparams();
    for (int i = blockIdx.x * 256 + tidx(); i < T_TOK * 1024; i += gridDim.x * 256) p.out[i] = p.x[i] * 1.5f;
    return;
  }
#endif
  int ph = p_.ph_lo;
  const int ph_hi = p_.ph_hi;
  if (ph == 0 && ph < ph_hi) {
    if (EN(0)) phase0(smem);
    ph++;
    if (ph < ph_hi) GSYNC();
  }
  if (ph == 1 && ph < ph_hi) {
    if (EN(1)) phase1(smem);
    ph++;
    if (ph < ph_hi) GSYNC();
  }
#ifdef DBG_CUT
  for (; ph < ph_hi && ph < DBG_CUT; ph++) {
    const int l = (ph - 2) / 7, k = (ph - 2) % 7;
    if (k == 0) { gemm_phase<EPI_IN>(l, smem); }
    else if (k == 1) { qkpost_phase(l); ssm1_phase(l); }
    else if (k == 2) { attn_phase(smem); ssm2_phase(l, smem); }
    else if (k == 3) { gemm_phase<EPI_GLU>(l, smem); }
    else if (k == 4) { gemm_phase<EPI_OUT>(l, smem); }
    else if (k == 5) { gemm_phase<EPI_F1>(l, smem); }
    else { gemm_phase<EPI_F2>(l, smem); }
    GSYNC();
  }
  {
    const Params p = kparams();
    const u16* src = (const u16*)(p.ws + DBG_DUMP_OFF);
    for (int i = blockIdx.x * 256 + tidx(); i < T_TOK * 1024; i += gridDim.x * 256) p.out[i] = bf2f(src[i]);
  }
  return;
#endif
  for (; ph < ph_hi && ph < NPHASE - 1; ph++) {
    const int l = (ph - 2) / 7, k = (ph - 2) % 7;
    if (k == 0) { if (EN(3)) gemm_phase<EPI_IN>(l, smem); }
    else if (k == 1) { if (EN(4)) { qkpost_phase(l); ssm1_phase(l);
#ifdef PROBE_SSM2X
      ssm1_phase(l);
#endif
    } }
    else if (k == 2) {
      const int first = (blockIdx.x >> 3) & 1;
      for (int s2 = 0; s2 < 2; s2++) {
        if ((s2 ^ first) == 0) { if (EN(5)) attn_phase(smem); }
        else { if (EN(6)) ssm2_phase(l, smem); }
      }
    }
    else if (k == 3) { if (EN(7)) gemm_phase<EPI_GLU>(l, smem); }
    else if (k == 4) { if (EN(8)) gemm_phase<EPI_OUT>(l, smem); }
    else if (k == 5) { if (EN(9)) gemm_phase<EPI_F1>(l, smem);
#ifdef PROBE_F1X2
      gemm_phase<EPI_F1>(l, smem);
#endif
    }
    else { if (EN(10)) gemm_phase<EPI_F2>(l, smem); }
    if (ph + 1 < ph_hi) GSYNC();
  }
  if (ph == NPHASE - 1 && ph < ph_hi) {
    if (EN(2)) final_phase();
  }
}

extern "C" void kernel_launch(void* const* d_in, const int* in_sizes, int n_in, void* d_out, int out_size, void* d_ws,
                              size_t ws_size, hipStream_t stream) {
  static int grid_blocks = 0;
  if (!grid_blocks) {
    int dev = 0, cus = 0, per_cu = 0;
    hipGetDevice(&dev);
    hipDeviceGetAttribute(&cus, hipDeviceAttributeMultiprocessorCount, dev);
    hipOccupancyMaxActiveBlocksPerMultiprocessor(&per_cu, mega, 256, 0);
    if (per_cu < 1) per_cu = 1;
    if (per_cu > 2) per_cu = 2;
    grid_blocks = cus * per_cu;
    if (ws_size < WS_TOTAL) fprintf(stderr, "kernel_launch: workspace too small: %zu < %zu\n", ws_size, (size_t)WS_TOTAL);
  }
  if (ws_size < WS_TOTAL) return;
  Params p{};
  const float** pp = (const float**)&p;
  for (int i = 0; i < 25; i++) pp[i] = (const float*)d_in[i];
  p.out = (float*)d_out;
  p.ws = (char*)d_ws;
  hipMemsetAsync((char*)d_ws + OFF_BAR, 0, 16384, stream);
#ifdef DBG_MEMSET
  hipMemsetAsync(d_ws, 0, WS_TOTAL, stream);
#endif
#if MULTI_LAUNCH
  for (int ph = 0; ph < NPHASE; ph++) {
    p.ph_lo = ph; p.ph_hi = ph + 1;
    hipLaunchKernelGGL(mega, dim3(grid_blocks), dim3(256), 0, stream, p);
  }
#else
  p.ph_lo = 0; p.ph_hi = NPHASE;
  void* args[] = {&p};
  hipError_t e = hipLaunchCooperativeKernel((void*)mega, dim3(grid_blocks), dim3(256), args, 0, stream);
  if (e != hipSuccess) fprintf(stderr, "cooperative launch failed: %s (grid %d)\n", hipGetErrorString(e), grid_blocks);
#endif
}
```

```cpp
#include <hip/hip_runtime.h>
#include <hip/hip_cooperative_groups.h>
#include <cstdio>
namespace cg = cooperative_groups;

typedef __attribute__((ext_vector_type(8))) short bf16x8;
typedef __attribute__((ext_vector_type(16))) float f32x16;
typedef __attribute__((ext_vector_type(2))) __bf16 bf2v;
typedef __attribute__((ext_vector_type(2))) float f2v;
typedef unsigned short u16;

#define DI __device__ __forceinline__
#define MFMA(a, b, c) __builtin_amdgcn_mfma_f32_32x32x16_bf16((a), (b), (c), 0, 0, 0)

#define DBGS 1.0f


#define DBG_DUMP_OFF OFF_Q
#ifndef MULTI_LAUNCH
#define MULTI_LAUNCH 0
#endif

constexpr int T_TOK = 32768;
constexpr int NPHASE = 31;
constexpr float QSCALE = 0.125f * 1.4426950408889634f;

constexpr size_t OFF_WT_IN  = 0;
constexpr size_t OFF_WT_GLU = OFF_WT_IN + 10485760;
constexpr size_t OFF_WT_OUT = OFF_WT_GLU + 2097152;
constexpr size_t OFF_WT_F1  = OFF_WT_OUT + 8388608;
constexpr size_t OFF_WT_F2  = OFF_WT_F1 + 46137344;
constexpr size_t OFF_MOD    = OFF_WT_F2 + 23068672;
constexpr size_t OFF_BIAS1  = OFF_MOD + 786432;
constexpr size_t OFF_BIAS2  = OFF_BIAS1 + 163840;
constexpr size_t OFF_ROPE   = OFF_BIAS2 + 720896;
constexpr size_t OFF_SSMA   = OFF_ROPE + 8192;
constexpr size_t OFF_SSMBB  = OFF_SSMA + 262144;
constexpr size_t OFF_SSMCC  = OFF_SSMBB + 1048576;
constexpr size_t OFF_E      = OFF_SSMCC + 1048576;
constexpr size_t OFF_SSX    = OFF_E + 4194304;
constexpr size_t OFF_SSA    = OFF_SSX + 2097152;
constexpr size_t OFF_SSS    = OFF_SSA + 1048576;
constexpr size_t OFF_X      = OFF_SSS + 1048576;
constexpr size_t OFF_ACT    = OFF_X + 134217728;
constexpr size_t OFF_UNION  = OFF_ACT + 67108864;
constexpr size_t OFF_HID    = OFF_UNION;
constexpr size_t OFF_Q      = OFF_UNION;
constexpr size_t OFF_K      = OFF_Q + 33554432;
constexpr size_t OFF_VT     = OFF_K + 8388608;
constexpr size_t OFF_U2     = OFF_VT + 8388608;
constexpr size_t OFF_YG     = OFF_U2 + 33554432;
constexpr size_t OFF_OATT   = OFF_YG + 33554432;
constexpr size_t OFF_OSSM   = OFF_OATT + 33554432;
constexpr size_t OFF_BAR    = OFF_UNION + 184549376;
constexpr size_t WS_TOTAL   = OFF_BAR + 16384;

struct Params {
  const float *x, *c, *w_ada, *b_ada, *norm1, *w_in, *q_norm, *k_norm, *lam_re, *lam_im, *log_dt,
      *b_re, *b_im, *c_re, *c_im, *ssm_d, *w_glu, *b_glu, *attn_out_norm, *ssm_out_norm, *w_out, *norm2,
      *w_ffn_in, *w_ffn_out, *final_norm;
  float* out;
  char* ws;
  int ph_lo, ph_hi;
};

DI unsigned pk(float a, float b) {
  f2v v = {a, b};
  bf2v r = __builtin_convertvector(v, bf2v);
  return __builtin_bit_cast(unsigned, r);
}
DI int tidx() { int t = __builtin_amdgcn_workitem_id_x(); asm volatile("" : "+v"(t)); return t; }
typedef const Params __attribute__((address_space(4)))* KParamPtr;
DI Params kparams() {
#if defined(__HIP_DEVICE_COMPILE__)
  KParamPtr q = (KParamPtr)__builtin_amdgcn_kernarg_segment_ptr();
  asm volatile("" : "+s"(q));
  return *q;
#else
  return Params{};
#endif
}
DI int vtid() { return tidx() & 255; }
DI int vhalf() { return tidx() >> 8; }
DI float bf2f(unsigned short h) { return __uint_as_float(((unsigned)h) << 16); }
DI void st_bf4(u16* dst, float a, float b, float c, float d) {
  uint2 v; v.x = pk(a, b); v.y = pk(c, d);
  *(uint2*)dst = v;
}
DI float4 ld_bf4(const u16* src) {
  uint2 v = *(const uint2*)src;
  float4 r;
  r.x = __uint_as_float(v.x << 16); r.y = __uint_as_float(v.x & 0xffff0000u);
  r.z = __uint_as_float(v.y << 16); r.w = __uint_as_float(v.y & 0xffff0000u);
  return r;
}
DI float wave_sum(float v) {
#pragma unroll
  for (int o = 32; o > 0; o >>= 1) v += __shfl_xor(v, o);
  return v;
}
DI size_t tl_idx(int t, int n) { return ((size_t)(n >> 6) * T_TOK + t) * 64 + (n & 63); }
DI int crow(int r, int hf) { return (r & 3) + 8 * (r >> 2) + 4 * hf; }
DI int f1perm(int n) {
  int j = (n < 2816) ? n : n - 2816;
  return (j >> 5) * 64 + (j & 31) + ((n < 2816) ? 0 : 32);
}

DI void transpose_tile(const float* __restrict__ src, int N, u16* __restrict__ dst, int K, int k0, int n0,
                       int permmode, const float* __restrict__ kscale, float* tl) {
  const int tid = vtid();
  __syncthreads();
#pragma unroll 4
  for (int i = 0; i < 16; i++) {
    int r = (tid >> 6) + 4 * i;
    float v = src[(size_t)(k0 + r) * N + n0 + (tid & 63)];
    if (kscale) v *= kscale[k0 + r];
    tl[r * 65 + (tid & 63)] = v;
  }
  __syncthreads();
#pragma unroll 4
  for (int i = 0; i < 8; i++) {
    int n = (tid >> 5) + 8 * i;
    int kp = tid & 31;
    float a = tl[(2 * kp) * 65 + n], b = tl[(2 * kp + 1) * 65 + n];
    int nn = n0 + n;
    int no = permmode ? f1perm(nn) : nn;
    *(unsigned*)(dst + ((size_t)(k0 >> 6) * N + no) * 64 + 2 * kp) = pk(a, b);
  }
}

DI void gemv8_item(const float* vec, int vstride, bool do_silu, const float* __restrict__ W, int N, int j0,
                   const float* bias, float* out, int ostride, int permmode, float* sm) {
  const int tid = vtid();
  float* vs = sm;
  float* red = sm + 8192;
  __syncthreads();
  for (int i = tid; i < 8192; i += 256) {
    int b = i >> 10, k = i & 1023;
    float v = vec[(size_t)b * vstride + k];
    if (do_silu) v = v / (1.f + expf(-v));
    vs[i] = v;
  }
  __syncthreads();
  const int kq = tid >> 6, jj = tid & 63;
  float acc[8];
#pragma unroll
  for (int b = 0; b < 8; b++) acc[b] = 0.f;
#pragma unroll 4
  for (int k = kq * 256; k < kq * 256 + 256; k++) {
    float w = W[(size_t)k * N + j0 + jj];
#pragma unroll
    for (int b = 0; b < 8; b++) acc[b] += vs[b * 1024 + k] * w;
  }
#pragma unroll
  for (int b = 0; b < 8; b++) red[(kq * 8 + b) * 64 + jj] = acc[b];
  __syncthreads();
  for (int o = tid; o < 512; o += 256) {
    int b = o >> 6, j = o & 63;
    float s = red[(0 * 8 + b) * 64 + j] + red[(8 + b) * 64 + j] + red[(16 + b) * 64 + j] + red[(24 + b) * 64 + j];
    int jg = j0 + j;
    if (bias) s += bias[jg];
    int jo = permmode ? f1perm(jg) : jg;
    out[(size_t)b * ostride + jo] = s;
  }
}

DI void ssm_param_item(const Params& p, int idx) {
  const int tid = vtid();
  const int pp = tid & 63, cq = tid >> 6;
  float* SSMA = (float*)(p.ws + OFF_SSMA);
  u16* BB = (u16*)(p.ws + OFF_SSMBB);
  u16* CC = (u16*)(p.ws + OFF_SSMCC);
  double lr = (double)p.lam_re[idx * 64 + pp];
  if (lr > -1e-4) lr = (double)(-1e-4f);
  double li = (double)p.lam_im[idx * 64 + pp];
  double dt = exp((double)p.log_dt[idx]);
  double mag = exp(lr * dt);
  double ar = mag * cos(li * dt), ai = mag * sin(li * dt);
  double den = lr * lr + li * li;
  double nre = ar - 1.0;
  double kre = (nre * lr + ai * li) / den;
  double kim = (ai * lr - nre * li) / den;
  if (cq == 0) {
    double magL = exp(lr * dt * 256.0);
    float4 v;
    v.x = (float)ar; v.y = (float)ai;
    v.z = (float)(magL * cos(li * dt * 256.0)); v.w = (float)(magL * sin(li * dt * 256.0));
    *(float4*)(SSMA + (size_t)(idx * 64 + pp) * 4) = v;
  }
#pragma unroll
  for (int cc = 0; cc < 4; cc++) {
    int c = cq * 4 + cc;
    double br = (double)p.b_re[(size_t)(idx * 64 + pp) * 16 + c];
    double bi = (double)p.b_im[(size_t)(idx * 64 + pp) * 16 + c];
    float bbr = (float)(kre * br - kim * bi);
    float bbi = (float)(kre * bi + kim * br);
    BB[(size_t)(idx * 128 + pp) * 16 + c] = (u16)(pk(bbr, 0.f) & 0xffffu);
    BB[(size_t)(idx * 128 + 64 + pp) * 16 + c] = (u16)(pk(bbi, 0.f) & 0xffffu);
    float cr = p.c_re[(size_t)(idx * 16 + c) * 64 + pp];
    float ci = p.c_im[(size_t)(idx * 16 + c) * 64 + pp];
    *(unsigned*)(CC + (size_t)(idx * 16 + c) * 128 + 2 * pp) = pk(cr, -ci);
  }
}

DI void phase0(char* smem) {
  const Params p = kparams();
  float* sm = (float*)(smem + vhalf() * 40960);
  constexpr int N_TIN = 4 * 16 * 20, N_TGLU = 4 * 8 * 8, N_TOUT = 4 * 16 * 16, N_TF1 = 4 * 16 * 88, N_TF2 = 4 * 44 * 16;
  constexpr int N_MOD = 4 * 96, N_SSM = 256, N_ROPE = 1;
  constexpr int S0 = N_MOD, S1 = S0 + N_TIN, S2 = S1 + N_TGLU, S3 = S2 + N_TOUT, S4 = S3 + N_TF1, S5 = S4 + N_TF2,
                S6 = S5 + N_SSM, S7 = S6 + N_ROPE;
  for (int it = blockIdx.x * 2 + vhalf(); it < S7 + 1; it += gridDim.x * 2) {
    if (it < S0) {
      int l = it / 96, jb = it % 96;
      gemv8_item(p.c, 1024, true, p.w_ada + (size_t)l * 1024 * 6144, 6144, jb * 64, p.b_ada + l * 6144,
                 (float*)(p.ws + OFF_MOD) + (size_t)l * 8 * 6144, 6144, 0, sm);
    } else if (it < S1) {
      int r = it - S0; int l = r / 320; r %= 320; int kt = r / 20, ntile = r % 20;
      transpose_tile(p.w_in + (size_t)l * 1024 * 1280, 1280, (u16*)(p.ws + OFF_WT_IN) + (size_t)l * 1280 * 1024, 1024,
                     kt * 64, ntile * 64, 0, nullptr, sm);
    } else if (it < S2) {
      int r = it - S1; int l = r / 64; r %= 64; int kt = r / 8, ntile = r % 8;
      transpose_tile(p.w_glu + (size_t)l * 512 * 512, 512, (u16*)(p.ws + OFF_WT_GLU) + (size_t)l * 512 * 512, 512,
                     kt * 64, ntile * 64, 0, nullptr, sm);
    } else if (it < S3) {
      int r = it - S2; int l = r / 256; r %= 256; int kt = r / 16, ntile = r % 16;
      const float* ks = (kt < 8) ? (p.attn_out_norm + l * 512) : (p.ssm_out_norm + l * 512 - 512);
      transpose_tile(p.w_out + (size_t)l * 1024 * 1024, 1024, (u16*)(p.ws + OFF_WT_OUT) + (size_t)l * 1024 * 1024, 1024,
                     kt * 64, ntile * 64, 0, ks, sm);
    } else if (it < S4) {
      int r = it - S3; int l = r / 1408; r %= 1408; int kt = r / 88, ntile = r % 88;
      transpose_tile(p.w_ffn_in + (size_t)l * 1024 * 5632, 5632, (u16*)(p.ws + OFF_WT_F1) + (size_t)l * 5632 * 1024, 1024,
                     kt * 64, ntile * 64, 1, nullptr, sm);
    } else if (it < S5) {
      int r = it - S4; int l = r / 704; r %= 704; int kt = r / 16, ntile = r % 16;
      transpose_tile(p.w_ffn_out + (size_t)l * 2816 * 1024, 1024, (u16*)(p.ws + OFF_WT_F2) + (size_t)l * 1024 * 2816, 2816,
                     kt * 64, ntile * 64, 0, nullptr, sm);
    } else if (it < S6) {
      ssm_param_item(p, it - S5);
    } else {
      float* rope = (float*)(p.ws + OFF_ROPE);
      for (int i = vtid(); i < 1024; i += 256) {
        int idx = i >> 4, f = i & 15;
        double ang = (double)idx * pow(10000.0, -(double)f / 16.0);
        rope[i] = (float)cos(ang);
        rope[1024 + i] = (float)sin(ang);
      }
    }
  }
}

DI void phase1(char* smem) {
  const Params p = kparams();
  float* sm = (float*)(smem + vhalf() * 40960);
  const float* MOD = (const float*)(p.ws + OFF_MOD);
  constexpr int N_B1 = 4 * 20, N_B2 = 4 * 88, N_PREP = T_TOK / 4;
  for (int it = blockIdx.x * 2 + vhalf(); it < N_B1 + N_B2 + N_PREP; it += gridDim.x * 2) {
    if (it < N_B1) {
      int l = it / 20, jb = it % 20;
      gemv8_item(MOD + (size_t)l * 8 * 6144 + 0, 6144, false, p.w_in + (size_t)l * 1024 * 1280, 1280, jb * 64, nullptr,
                 (float*)(p.ws + OFF_BIAS1) + (size_t)l * 8 * 1280, 1280, 0, sm);
    } else if (it < N_B1 + N_B2) {
      int r = it - N_B1; int l = r / 88, jb = r % 88;
      gemv8_item(MOD + (size_t)l * 8 * 6144 + 3072, 6144, false, p.w_ffn_in + (size_t)l * 1024 * 5632, 5632, jb * 64, nullptr,
                 (float*)(p.ws + OFF_BIAS2) + (size_t)l * 8 * 5632, 5632, 1, sm);
    } else {
      int r = it - N_B1 - N_B2;
      const int lane = vtid() & 63, wave = vtid() >> 6;
      int t = r * 4 + wave;
      int b = t >> 12;
      const float4* xr = (const float4*)(p.x + (size_t)t * 1024);
      float4 v[4];
      float ss = 0.f;
#pragma unroll
      for (int i = 0; i < 4; i++) {
        v[i] = xr[lane + 64 * i];
        ss += v[i].x * v[i].x + v[i].y * v[i].y + v[i].z * v[i].z + v[i].w * v[i].w;
      }
      ss = wave_sum(ss);
      float* SSX = (float*)(p.ws + OFF_SSX);
      if (lane < 16) SSX[(size_t)t * 16 + lane] = (lane == 0) ? ss : 0.f;
      u16* ACT = (u16*)(p.ws + OFF_ACT);
      const float* sc1 = MOD + (size_t)(0 * 8 + b) * 6144 + 1024;
#pragma unroll
      for (int i = 0; i < 4; i++) {
        int k = (lane + 64 * i) * 4;
        float4 g = *(const float4*)(p.norm1 + k);
        float4 s = *(const float4*)(sc1 + k);
        st_bf4(ACT + tl_idx(t, k), v[i].x * g.x * (1.f + s.x), v[i].y * g.y * (1.f + s.y),
               v[i].z * g.z * (1.f + s.z), v[i].w * g.w * (1.f + s.w));
      }
    }
  }
}

enum { EPI_IN = 0, EPI_GLU = 1, EPI_OUT = 2, EPI_F1 = 3, EPI_F2 = 4 };

DI float row_rinv16(const float* ssx, int t, float invn) {
  const float4* q = (const float4*)(ssx + (size_t)t * 16);
  float4 a = q[0], b = q[1], c = q[2], d = q[3];
  float s = ((a.x + a.y) + (a.z + a.w)) + ((b.x + b.y) + (b.z + b.w)) + ((c.x + c.y) + (c.z + c.w)) + ((d.x + d.y) + (d.z + d.w));
  return rsqrtf(s * invn + 1e-6f);
}
DI float row_rinv8(const float* ss8, int t, float invn) {
  const float4* q = (const float4*)(ss8 + (size_t)t * 8);
  float4 a = q[0], b = q[1];
  float s = ((a.x + a.y) + (a.z + a.w)) + ((b.x + b.y) + (b.z + b.w));
  return rsqrtf(s * invn + 1e-6f);
}

template <int EPI>
DI void gemm_tile(const Params& p, const int l, const int mt, const int nt, char* smem, uint4& ra0, uint4& ra1, uint4& ra2, uint4& ra3,
               uint4& rb0, uint4& rb1, uint4& rb2, uint4& rb3, const bool first, const bool has_next, const int mt_next, const int nt_next, const bool dry = false) {
  constexpr int TJ = 4;
  constexpr int K = (EPI == EPI_GLU) ? 512 : (EPI == EPI_F2 ? 2816 : 1024);
  constexpr int LDA = (EPI == EPI_GLU || EPI == EPI_OUT) ? 512 : (EPI == EPI_F2 ? 2816 : 1024);
  constexpr int KT = K / 64;
  u16* As = (u16*)smem;
  u16* Bs = As + 256 * 72;
  const int tid = tidx(), lane = tid & 63, wave = tid >> 6;
  const int wm = wave >> 2, wn = wave & 3;
  const int hf = lane >> 5, li = lane & 31;
  const int m0 = mt * 256, n0 = nt * 256;

  const u16* A0;
  const u16* A1 = nullptr;
  const u16* W;
  if (EPI == EPI_IN) { A0 = (const u16*)(p.ws + OFF_ACT); W = (const u16*)(p.ws + OFF_WT_IN) + (size_t)l * 1280 * 1024; }
  else if (EPI == EPI_GLU) { A0 = (const u16*)(p.ws + OFF_YG); W = (const u16*)(p.ws + OFF_WT_GLU) + (size_t)l * 512 * 512; }
  else if (EPI == EPI_OUT) { A0 = (const u16*)(p.ws + OFF_OATT); A1 = (const u16*)(p.ws + OFF_OSSM); W = (const u16*)(p.ws + OFF_WT_OUT) + (size_t)l * 1024 * 1024; }
  else if (EPI == EPI_F1) { A0 = (const u16*)(p.ws + OFF_ACT); W = (const u16*)(p.ws + OFF_WT_F1) + (size_t)l * 5632 * 1024; }
  else { A0 = (const u16*)(p.ws + OFF_HID); W = (const u16*)(p.ws + OFF_WT_F2) + (size_t)l * 1024 * 2816; }

  const int lrow = tid >> 3, lc8 = tid & 7;
  constexpr int NW = (EPI == EPI_IN) ? 1280 : (EPI == EPI_GLU ? 512 : (EPI == EPI_F1 ? 5632 : 1024));
  constexpr size_t AKT = (size_t)T_TOK * 64, WKT = (size_t)NW * 64;
  const u16* ag0 = A0 + (size_t)(m0 + lrow) * 64 + lc8 * 8;
  const u16* ag1 = (EPI == EPI_OUT) ? (A1 + (size_t)(m0 + lrow) * 64 + lc8 * 8) : nullptr;
  const u16* wg = W + (size_t)(n0 + lrow) * 64 + lc8 * 8;

  f32x16 acc[2][TJ];
#pragma unroll
  for (int i = 0; i < 2; i++)
#pragma unroll
    for (int j = 0; j < TJ; j++)
#pragma unroll
      for (int r = 0; r < 16; r++) acc[i][j][r] = 0.f;

#define GEMM_GLOAD_R(kt_, A0_, A1_, A2_, A3_, B0_, B1_, B2_, B3_)                                 \
  {                                                                                              \
    const u16* ap;                                                                               \
    if (EPI == EPI_OUT) ap = ((kt_) < 8) ? (ag0 + (kt_) * AKT) : (ag1 + ((kt_) - 8) * AKT);      \
    else ap = ag0 + (kt_) * AKT;                                                                 \
    const u16* wp = wg + (kt_) * WKT;                                                            \
    A0_ = *(const uint4*)(ap);                                                                   \
    A1_ = *(const uint4*)(ap + 64 * 64);                                                         \
    A2_ = *(const uint4*)(ap + 128 * 64);                                                        \
    A3_ = *(const uint4*)(ap + 192 * 64);                                                        \
    B0_ = *(const uint4*)(wp);                                                                   \
    B1_ = *(const uint4*)(wp + 64 * 64);                                                         \
    B2_ = *(const uint4*)(wp + 128 * 64);                                                        \
    B3_ = *(const uint4*)(wp + 192 * 64);                                                        \
  }
#define GEMM_LSTORE_R(boff_, A0_, A1_, A2_, A3_, B0_, B1_, B2_, B3_) \
  {                                                                \
    u16* a_ = As + (boff_) + lrow * 72 + lc8 * 8;                  \
    u16* b_ = Bs + (boff_) + lrow * 72 + lc8 * 8;                  \
    *(uint4*)(a_) = A0_;                                           \
    *(uint4*)(a_ + 64 * 72) = A1_;                                 \
    *(uint4*)(a_ + 128 * 72) = A2_;                                \
    *(uint4*)(a_ + 192 * 72) = A3_;                                \
    *(uint4*)(b_) = B0_;                                           \
    *(uint4*)(b_ + 64 * 72) = B1_;                                 \
    *(uint4*)(b_ + 128 * 72) = B2_;                                \
    *(uint4*)(b_ + 192 * 72) = B3_;                                \
  }
#define GEMM_COMPUTE(cur_, DOST_, oth_, A0_, A1_, A2_, A3_, B0_, B1_, B2_, B3_)                                          \
  {                                                                                                                     \
    u16* a_ = As + (oth_) + lrow * 72 + lc8 * 8;                                                                        \
    u16* b_ = Bs + (oth_) + lrow * 72 + lc8 * 8;                                                                        \
    _Pragma("unroll") for (int s = 0; s < 4; s++) {                                                                     \
      bf16x8 wf[2], af[TJ];                                                                                             \
      _Pragma("unroll") for (int i = 0; i < 2; i++)                                                                     \
        wf[i] = *(const bf16x8*)(Bs + (cur_) + (wn * 64 + i * 32 + li) * 72 + s * 16 + hf * 8);                         \
      _Pragma("unroll") for (int j = 0; j < TJ; j++)                                                                    \
        af[j] = *(const bf16x8*)(As + (cur_) + (wm * 128 + j * 32 + li) * 72 + s * 16 + hf * 8);                        \
      _Pragma("unroll") for (int i = 0; i < 2; i++)                                                                     \
        _Pragma("unroll") for (int j = 0; j < TJ; j++) acc[i][j] = MFMA(wf[i], af[j], acc[i][j]);                       \
        \
      if (DOST_) {                                                                                                      \
        if (s == 0) { *(uint4*)(a_) = A0_; *(uint4*)(a_ + 64 * 72) = A1_; }                                             \
        if (s == 1) { *(uint4*)(a_ + 128 * 72) = A2_; *(uint4*)(a_ + 192 * 72) = A3_; }                                 \
        if (s == 2) { *(uint4*)(b_) = B0_; *(uint4*)(b_ + 64 * 72) = B1_; }                                             \
        if (s == 3) { *(uint4*)(b_ + 128 * 72) = B2_; *(uint4*)(b_ + 192 * 72) = B3_; }                                 \
      }                                                                                                                 \
    }                                                                                                                   \
  }
  constexpr int BUF = 2 * 256 * 72;
  uint4 sa0, sa1, sa2, sa3, sb0, sb1, sb2, sb3;
  if (first) GEMM_GLOAD_R(0, ra0, ra1, ra2, ra3, rb0, rb1, rb2, rb3);
  GEMM_GLOAD_R(1, sa0, sa1, sa2, sa3, sb0, sb1, sb2, sb3);
  int tok[TJ];
#pragma unroll
  for (int j = 0; j < TJ; j++) tok[j] = m0 + wm * 128 + j * 32 + li;

  __syncthreads();
  GEMM_LSTORE_R(0, ra0, ra1, ra2, ra3, rb0, rb1, rb2, rb3);
  GEMM_GLOAD_R(2, ra0, ra1, ra2, ra3, rb0, rb1, rb2, rb3);
  __syncthreads();
#pragma unroll 1
  for (int kt = 0; kt < KT; kt += 2) {
    if (EPI == EPI_OUT) {
      if (kt == 8) {
#pragma unroll
        for (int j = 0; j < TJ; j++) {
          const float ra_ = row_rinv8((const float*)(p.ws + OFF_SSA), tok[j], 1.f / 512.f);
          const float rs_ = row_rinv8((const float*)(p.ws + OFF_SSS), tok[j], 1.f / 512.f);
          const float mr = ra_ / rs_;
#pragma unroll
          for (int i = 0; i < 2; i++)
#pragma unroll
            for (int r = 0; r < 16; r++) acc[i][j][r] *= mr;
        }
      }
    }
    GEMM_COMPUTE(0, true, BUF, sa0, sa1, sa2, sa3, sb0, sb1, sb2, sb3);
    if (kt + 3 < KT) GEMM_GLOAD_R(kt + 3, sa0, sa1, sa2, sa3, sb0, sb1, sb2, sb3);
    __syncthreads();
    GEMM_COMPUTE(BUF, (kt + 2 < KT), 0, ra0, ra1, ra2, ra3, rb0, rb1, rb2, rb3);
    if (kt + 4 < KT) GEMM_GLOAD_R(kt + 4, ra0, ra1, ra2, ra3, rb0, rb1, rb2, rb3);
    __syncthreads();
  }
  if (has_next) {
    const u16* ap = A0 + (size_t)(mt_next * 256 + lrow) * 64 + lc8 * 8;
    const u16* wp = W + (size_t)(nt_next * 256 + lrow) * 64 + lc8 * 8;
    ra0 = *(const uint4*)(ap);
    ra1 = *(const uint4*)(ap + 64 * 64);
    ra2 = *(const uint4*)(ap + 128 * 64);
    ra3 = *(const uint4*)(ap + 192 * 64);
    rb0 = *(const uint4*)(wp);
    rb1 = *(const uint4*)(wp + 64 * 64);
    rb2 = *(const uint4*)(wp + 128 * 64);
    rb3 = *(const uint4*)(wp + 192 * 64);
  }

  if (dry) return;
  const int b = m0 >> 12;
  const int nbase = n0 + wn * 64;
  const float* MOD = (const float*)(p.ws + OFF_MOD);

  if (EPI == EPI_IN) {
    const float* bias = (const float*)(p.ws + OFF_BIAS1) + (size_t)(l * 8 + b) * 1280;
    const float* SSX = (const float*)(p.ws + OFF_SSX);
    float rinv[TJ];
#pragma unroll
    for (int j = 0; j < TJ; j++) rinv[j] = row_rinv16(SSX, tok[j], 1.f / 1024.f);
#pragma unroll
    for (int i = 0; i < 2; i++)
#pragma unroll
      for (int q4 = 0; q4 < 4; q4++) {
        float4 b4 = *(const float4*)(bias + nbase + i * 32 + 8 * q4 + 4 * hf);
#pragma unroll
        for (int j = 0; j < TJ; j++) {
          acc[i][j][4 * q4 + 0] = acc[i][j][4 * q4 + 0] * rinv[j] + b4.x;
          acc[i][j][4 * q4 + 1] = acc[i][j][4 * q4 + 1] * rinv[j] + b4.y;
          acc[i][j][4 * q4 + 2] = acc[i][j][4 * q4 + 2] * rinv[j] + b4.z;
          acc[i][j][4 * q4 + 3] = acc[i][j][4 * q4 + 3] * rinv[j] + b4.w;
        }
      }
    if (nbase < 640) {
#pragma unroll
      for (int j = 0; j < TJ; j++) {
        const int t = tok[j], pos = t & 4095;
#pragma unroll
        for (int i = 0; i < 2; i++)
#pragma unroll
          for (int q4 = 0; q4 < 4; q4++) {
            const int d0 = i * 32 + 8 * q4 + 4 * hf;
            u16* dst = (nbase < 512) ? ((u16*)(p.ws + OFF_Q) + (size_t)t * 512 + nbase + d0)
                                     : ((u16*)(p.ws + OFF_K) + ((size_t)(b * 2 + ((nbase - 512) >> 6)) * 4096 + pos) * 64 + d0);
            st_bf4(dst, acc[i][j][4 * q4 + 0], acc[i][j][4 * q4 + 1], acc[i][j][4 * q4 + 2], acc[i][j][4 * q4 + 3]);
          }
      }
    } else if (nbase < 768) {
      u16* VT = (u16*)(p.ws + OFF_VT);
      const int vh = (nbase - 640) >> 6;
#pragma unroll
      for (int j = 0; j < TJ; j++) {
        const int pos = tok[j] & 4095;
#pragma unroll
        for (int i = 0; i < 2; i++)
#pragma unroll
          for (int r = 0; r < 16; r++) {
            int d = i * 32 + crow(r, hf);
            VT[((size_t)(b * 2 + vh) * 64 + d) * 4096 + pos] = (u16)(pk(acc[i][j][r], 0.f) & 0xffffu);
          }
      }
    } else {
      u16* U2 = (u16*)(p.ws + OFF_U2);
      const int ch0 = nbase - 768;
#pragma unroll
      for (int j = 0; j < TJ; j++) {
        const int pos = tok[j] & 4095;
#pragma unroll
        for (int i = 0; i < 2; i++)
#pragma unroll
          for (int q4 = 0; q4 < 4; q4++) {
            int ch = ch0 + i * 32 + 8 * q4 + 4 * hf;
            int g = ch >> 4, c0 = ch & 15;
            st_bf4(U2 + (((size_t)(b * 32 + g)) * 4096 + pos) * 16 + c0, acc[i][j][4 * q4 + 0], acc[i][j][4 * q4 + 1],
                   acc[i][j][4 * q4 + 2], acc[i][j][4 * q4 + 3]);
          }
      }
    }
  } else if (EPI == EPI_GLU) {
    const float* bg = p.b_glu + l * 512;
    const u16* YG = (const u16*)(p.ws + OFF_YG);
    u16* OSSM = (u16*)(p.ws + OFF_OSSM);
    float* SSS = (float*)(p.ws + OFF_SSS);
#pragma unroll
    for (int j = 0; j < TJ; j++) {
      const int t = tok[j];
      float ss = 0.f;
#pragma unroll
      for (int i = 0; i < 2; i++)
#pragma unroll
        for (int q4 = 0; q4 < 4; q4++) {
          const int n = nbase + i * 32 + 8 * q4 + 4 * hf;
          float4 b4 = *(const float4*)(bg + n);
          float4 y = ld_bf4(YG + tl_idx(t, n));
          float o0 = y.x / (1.f + __expf(-(acc[i][j][4 * q4 + 0] + b4.x)));
          float o1 = y.y / (1.f + __expf(-(acc[i][j][4 * q4 + 1] + b4.y)));
          float o2 = y.z / (1.f + __expf(-(acc[i][j][4 * q4 + 2] + b4.z)));
          float o3 = y.w / (1.f + __expf(-(acc[i][j][4 * q4 + 3] + b4.w)));
          ss += o0 * o0 + o1 * o1 + o2 * o2 + o3 * o3;
          st_bf4(OSSM + tl_idx(t, n), o0, o1, o2, o3);
        }
      ss += __shfl_xor(ss, 32);
      if (hf == 0) SSS[(size_t)t * 8 + (nbase >> 6)] = ss;
    }
  } else if (EPI == EPI_OUT || EPI == EPI_F2) {
    const float* gate = MOD + (size_t)(l * 8 + b) * 6144 + (EPI == EPI_OUT ? 2048 : 5120);
    const bool has_next = (EPI == EPI_OUT) || (l < 3);
    const float* nrm = (EPI == EPI_OUT) ? (p.norm2 + l * 1024) : (p.norm1 + (l + 1) * 1024);
    const float* scn = (EPI == EPI_OUT) ? (MOD + (size_t)(l * 8 + b) * 6144 + 4096) : (MOD + (size_t)((l + 1) * 8 + b) * 6144 + 1024);
    const float* xin = (EPI == EPI_OUT && l == 0) ? p.x : (const float*)(p.ws + OFF_X);
    float* X = (float*)(p.ws + OFF_X);
    u16* ACT = (u16*)(p.ws + OFF_ACT);
    float* SSX = (float*)(p.ws + OFF_SSX);
    float* stg = (float*)smem + wave * (32 * 68);
    const int rr = lane >> 4, c4 = (lane & 15) * 4;
    const int n = nbase + c4;
    const float4 g4 = *(const float4*)(gate + n);
    float4 nsc = make_float4(0.f, 0.f, 0.f, 0.f);
    if (has_next) {
      const float4 nr = *(const float4*)(nrm + n);
      const float4 sc = *(const float4*)(scn + n);
      nsc = make_float4(nr.x * (1.f + sc.x), nr.y * (1.f + sc.y), nr.z * (1.f + sc.z), nr.w * (1.f + sc.w));
    }
#pragma unroll
    for (int j = 0; j < TJ; j++) {
#pragma unroll
      for (int i = 0; i < 2; i++)
#pragma unroll
        for (int q4 = 0; q4 < 4; q4++)
          *(float4*)(stg + li * 68 + i * 32 + 8 * q4 + 4 * hf) =
              make_float4(acc[i][j][4 * q4 + 0], acc[i][j][4 * q4 + 1], acc[i][j][4 * q4 + 2], acc[i][j][4 * q4 + 3]);
      asm volatile("s_waitcnt lgkmcnt(0)" ::: "memory");
#pragma unroll
      for (int it = 0; it < 8; it++) {
        const int row = rr + 4 * it;
        const int t = m0 + wm * 128 + j * 32 + row;
        const float4 a = *(const float4*)(stg + row * 68 + c4);
        const float finj = (EPI == EPI_OUT) ? row_rinv8((const float*)(p.ws + OFF_SSS), t, 1.f / 512.f) : 1.f;
        const float4 xi = *(const float4*)(xin + (size_t)t * 1024 + n);
        float4 y;
        y.x = xi.x + g4.x * a.x * finj;
        y.y = xi.y + g4.y * a.y * finj;
        y.z = xi.z + g4.z * a.z * finj;
        y.w = xi.w + g4.w * a.w * finj;
        *(float4*)(X + (size_t)t * 1024 + n) = y;
        float ss = y.x * y.x + y.y * y.y + y.z * y.z + y.w * y.w;
        ss += __shfl_xor(ss, 1); ss += __shfl_xor(ss, 2); ss += __shfl_xor(ss, 4); ss += __shfl_xor(ss, 8);
        if ((lane & 15) == 0) SSX[(size_t)t * 16 + (nbase >> 6)] = ss;
        if (has_next) st_bf4(ACT + tl_idx(t, n), y.x * nsc.x, y.y * nsc.y, y.z * nsc.z, y.w * nsc.w);
      }
      asm volatile("s_waitcnt lgkmcnt(0)" ::: "memory");
    }
  } else {
    const float* bias = (const float*)(p.ws + OFF_BIAS2) + (size_t)(l * 8 + b) * 5632;
    const float* SSX = (const float*)(p.ws + OFF_SSX);
    u16* HID = (u16*)(p.ws + OFF_HID);
    const int jbase = nbase >> 1;
#pragma unroll
    for (int j = 0; j < TJ; j++) {
      const int t = tok[j];
      const float rv = row_rinv16(SSX, t, 1.f / 1024.f);
#pragma unroll
      for (int q4 = 0; q4 < 4; q4++) {
        const int ng = nbase + 8 * q4 + 4 * hf;
        float4 bg4 = *(const float4*)(bias + ng);
        float4 bu4 = *(const float4*)(bias + ng + 32);
        float zg0 = acc[0][j][4 * q4 + 0] * rv + bg4.x, zu0 = acc[1][j][4 * q4 + 0] * rv + bu4.x;
        float zg1 = acc[0][j][4 * q4 + 1] * rv + bg4.y, zu1 = acc[1][j][4 * q4 + 1] * rv + bu4.y;
        float zg2 = acc[0][j][4 * q4 + 2] * rv + bg4.z, zu2 = acc[1][j][4 * q4 + 2] * rv + bu4.z;
        float zg3 = acc[0][j][4 * q4 + 3] * rv + bg4.w, zu3 = acc[1][j][4 * q4 + 3] * rv + bu4.w;
        float h0 = zg0 / (1.f + __expf(-zg0)) * zu0;
        float h1 = zg1 / (1.f + __expf(-zg1)) * zu1;
        float h2 = zg2 / (1.f + __expf(-zg2)) * zu2;
        float h3 = zg3 / (1.f + __expf(-zg3)) * zu3;
        st_bf4(HID + tl_idx(t, jbase + 8 * q4 + 4 * hf), h0, h1, h2, h3);
      }
    }
  }
}

template <int EPI>
DI void gemm_phase(int l, char* smem, const bool dry = false) {
  const Params p = kparams();
  constexpr int NT = (EPI == EPI_IN) ? 5 : (EPI == EPI_GLU ? 2 : (EPI == EPI_F1 ? 22 : 4));
  const int g8 = gridDim.x >> 3;
  const int xg = blockIdx.x & 7, lb = blockIdx.x >> 3;
  uint4 ra0, ra1, ra2, ra3, rb0, rb1, rb2, rb3;
  bool first = true;
  for (int q = lb; q < 16 * NT; q += g8) {
    const int mg = q / (8 * NT);
    const int rem = q - mg * 8 * NT;
    const int qn = q + g8;
    const bool has_next = qn < 16 * NT;
    const int mgn = qn / (8 * NT);
    const int remn = qn - mgn * 8 * NT;
    gemm_tile<EPI>(p, l, xg * 16 + mg * 8 + (rem & 7), rem >> 3, smem, ra0, ra1, ra2, ra3, rb0, rb1, rb2, rb3, first, has_next,
                   xg * 16 + mgn * 8 + (remn & 7), remn >> 3, dry);
    first = false;
  }
}

DI void attn_item(const Params& p, int item, char* smem) {
  u16* Ks = (u16*)smem;
  u16* Vs = Ks + 64 * 72;
  const int tid = tidx(), lane = tid & 63, wave = tid >> 6;
  const int hf = lane >> 5, li = lane & 31;
  const int xcd = item & 7, local = item >> 3;
  const int pair = xcd * 2 + (local >> 6);
  const int within = local & 63;
  const int hq = within >> 4, qb = within & 15;
  const int b = pair >> 1, kvh = pair & 1, h = kvh * 4 + hq;
  const int t = b * 4096 + qb * 256 + wave * 32 + li;

  const u16* Q = (const u16*)(p.ws + OFF_Q);
  bf16x8 qf[4];
#pragma unroll
  for (int s = 0; s < 4; s++) qf[s] = *(const bf16x8*)(Q + (size_t)t * 512 + h * 64 + 16 * s + 8 * hf);

  f32x16 o0, o1;
#pragma unroll
  for (int r = 0; r < 16; r++) { o0[r] = 0.f; o1[r] = 0.f; }
  float m_run = -1e30f, l_run = 0.f;

  const int lrow = tid >> 3, lc8 = tid & 7;
  const u16* Kg = (const u16*)(p.ws + OFF_K) + (size_t)pair * 4096 * 64 + (size_t)lrow * 64 + lc8 * 8;
  const u16* Vg = (const u16*)(p.ws + OFF_VT) + (size_t)pair * 64 * 4096 + (size_t)lrow * 4096 + lc8 * 8;
  uint4 rk0, rv0;
#define ATT_GLOAD(kt_)                                                   \
  {                                                                      \
    rk0 = *(const uint4*)(Kg + (size_t)((kt_) * 64) * 64);               \
    rv0 = *(const uint4*)(Vg + (kt_) * 64);                              \
  }
  ATT_GLOAD(0);
  const int kap = (li & 0x13) | ((li & 4) << 1) | ((li & 8) >> 1);

  for (int kt = 0; kt < 64; kt++) {
    __syncthreads();
    *(uint4*)(Ks + (lrow) * 72 + lc8 * 8) = rk0;
    *(uint4*)(Vs + (lrow) * 72 + lc8 * 8) = rv0;
    __syncthreads();
    if (kt + 1 < 64) ATT_GLOAD(kt + 1);

    f32x16 s0, s1;
#pragma unroll
    for (int r = 0; r < 16; r++) { s0[r] = 0.f; s1[r] = 0.f; }
#pragma unroll
    for (int s = 0; s < 4; s++) {
      bf16x8 kf0 = *(const bf16x8*)(Ks + kap * 72 + 16 * s + 8 * hf);
      bf16x8 kf1 = *(const bf16x8*)(Ks + (32 + kap) * 72 + 16 * s + 8 * hf);
      s0 = MFMA(kf0, qf[s], s0);
      s1 = MFMA(kf1, qf[s], s1);
    }
    float mx = s0[0];
#pragma unroll
    for (int r = 1; r < 16; r++) mx = fmaxf(mx, s0[r]);
#pragma unroll
    for (int r = 0; r < 16; r++) mx = fmaxf(mx, s1[r]);
    mx = fmaxf(mx, __shfl_xor(mx, 32));
    const float mnew = fmaxf(m_run, mx);
    const float alpha = __builtin_amdgcn_exp2f(m_run - mnew);
    m_run = mnew;
    float ps = 0.f;
#pragma unroll
    for (int r = 0; r < 16; r++) { s0[r] = __builtin_amdgcn_exp2f(s0[r] - mnew); ps += s0[r]; }
#pragma unroll
    for (int r = 0; r < 16; r++) { s1[r] = __builtin_amdgcn_exp2f(s1[r] - mnew); ps += s1[r]; }
    l_run = l_run * alpha + ps;
#pragma unroll
    for (int r = 0; r < 16; r++) { o0[r] *= alpha; o1[r] *= alpha; }
#pragma unroll
    for (int sp = 0; sp < 2; sp++) {
      bf16x8 pb;
      {
        unsigned u0 = pk(s0[8 * sp + 0], s0[8 * sp + 1]), u1 = pk(s0[8 * sp + 2], s0[8 * sp + 3]);
        unsigned u2 = pk(s0[8 * sp + 4], s0[8 * sp + 5]), u3 = pk(s0[8 * sp + 6], s0[8 * sp + 7]);
        uint4 uu = make_uint4(u0, u1, u2, u3);
        pb = __builtin_bit_cast(bf16x8, uu);
      }
      bf16x8 vf0 = *(const bf16x8*)(Vs + li * 72 + 16 * sp + 8 * hf);
      bf16x8 vf1 = *(const bf16x8*)(Vs + (32 + li) * 72 + 16 * sp + 8 * hf);
      o0 = MFMA(vf0, pb, o0);
      o1 = MFMA(vf1, pb, o1);
    }
#pragma unroll
    for (int sp = 0; sp < 2; sp++) {
      bf16x8 pb;
      {
        unsigned u0 = pk(s1[8 * sp + 0], s1[8 * sp + 1]), u1 = pk(s1[8 * sp + 2], s1[8 * sp + 3]);
        unsigned u2 = pk(s1[8 * sp + 4], s1[8 * sp + 5]), u3 = pk(s1[8 * sp + 6], s1[8 * sp + 7]);
        uint4 uu = make_uint4(u0, u1, u2, u3);
        pb = __builtin_bit_cast(bf16x8, uu);
      }
      bf16x8 vf0 = *(const bf16x8*)(Vs + li * 72 + 32 + 16 * sp + 8 * hf);
      bf16x8 vf1 = *(const bf16x8*)(Vs + (32 + li) * 72 + 32 + 16 * sp + 8 * hf);
      o0 = MFMA(vf0, pb, o0);
      o1 = MFMA(vf1, pb, o1);
    }
  }
  const float ltot = l_run + __shfl_xor(l_run, 32);
  const float inv = 1.f / ltot;
  u16* OATT = (u16*)(p.ws + OFF_OATT);
  float ss = 0.f;
#pragma unroll
  for (int q4 = 0; q4 < 4; q4++) {
    float a0 = o0[4 * q4 + 0] * inv, a1 = o0[4 * q4 + 1] * inv, a2 = o0[4 * q4 + 2] * inv, a3 = o0[4 * q4 + 3] * inv;
    float c0 = o1[4 * q4 + 0] * inv, c1 = o1[4 * q4 + 1] * inv, c2 = o1[4 * q4 + 2] * inv, c3 = o1[4 * q4 + 3] * inv;
    ss += a0 * a0 + a1 * a1 + a2 * a2 + a3 * a3 + c0 * c0 + c1 * c1 + c2 * c2 + c3 * c3;
    st_bf4(OATT + tl_idx(t, h * 64 + 8 * q4 + 4 * hf), a0, a1, a2, a3);
    st_bf4(OATT + tl_idx(t, h * 64 + 32 + 8 * q4 + 4 * hf), c0, c1, c2, c3);
  }
  ss += __shfl_xor(ss, 32);
  if (hf == 0) ((float*)(p.ws + OFF_SSA))[(size_t)t * 8 + h] = ss;
}

DI bf16x8 ssm_ufrag(const u16* U2, int bp, int g, int tb, int li, int hf) {
  const int seq = (li >> 2) & 1, step = ((li >> 3) << 2) | (li & 3);
  return *(const bf16x8*)(U2 + (((size_t)((2 * bp + seq) * 32 + g)) * 4096 + tb + step) * 16 + 8 * hf);
}

DI void ssm_scan16(const f32x16& x0, const f32x16& x1, const f32x16& x2, const f32x16& x3, const float4 a0, const float4 a1,
                   float& h0r, float& h0i, float& h1r, float& h1i, const int dir) {
  if (dir == 0) {
#pragma unroll
    for (int r = 0; r < 16; r++) {
      float nr = a0.x * h0r - a0.y * h0i + x0[r], ni = a0.x * h0i + a0.y * h0r + x2[r];
      h0r = nr; h0i = ni;
      float mr = a1.x * h1r - a1.y * h1i + x1[r], mi = a1.x * h1i + a1.y * h1r + x3[r];
      h1r = mr; h1i = mi;
    }
  } else {
#pragma unroll
    for (int r = 15; r >= 0; r--) {
      float nr = a0.x * h0r - a0.y * h0i + x0[r], ni = a0.x * h0i + a0.y * h0r + x2[r];
      h0r = nr; h0i = ni;
      float mr = a1.x * h1r - a1.y * h1i + x1[r], mi = a1.x * h1i + a1.y * h1r + x3[r];
      h1r = mr; h1i = mi;
    }
  }
}

DI void ssm1_item(const Params& p, int l, int item) {
  const int tid = vtid(), lane = tid & 63, wave = __builtin_amdgcn_readfirstlane(tid >> 6);
  const int hf = lane >> 5, li = lane & 31;
  const int w = item * 4 + wave;
  const int ch = w & 15, bp = (w >> 4) & 3, g = (w >> 6) & 31, dir = w >> 11;
  const int idx = (l * 2 + dir) * 32 + g;
  const u16* U2 = (const u16*)(p.ws + OFF_U2);
  const u16* BB = (const u16*)(p.ws + OFF_SSMBB) + (size_t)idx * 128 * 16;
  const float* SA = (const float*)(p.ws + OFF_SSMA) + (size_t)idx * 64 * 4;
  bf16x8 bbf[4];
#pragma unroll
  for (int j = 0; j < 4; j++) bbf[j] = *(const bf16x8*)(BB + (32 * j + li) * 16 + 8 * hf);
  const float4 a0 = *(const float4*)(SA + li * 4);
  const float4 a1 = *(const float4*)(SA + (li + 32) * 4);
  float h0r = 0.f, h0i = 0.f, h1r = 0.f, h1i = 0.f;
  f32x16 zero;
#pragma unroll
  for (int r = 0; r < 16; r++) zero[r] = 0.f;
#define SSM_TB(it_) (ch * 256 + (dir ? (15 - (it_)) : (it_)) * 16)
  bf16x8 q0 = ssm_ufrag(U2, bp, g, SSM_TB(0), li, hf), q1 = ssm_ufrag(U2, bp, g, SSM_TB(1), li, hf);
  bf16x8 q2 = ssm_ufrag(U2, bp, g, SSM_TB(2), li, hf), q3 = ssm_ufrag(U2, bp, g, SSM_TB(3), li, hf);
#pragma unroll 1
  for (int it = 0; it < 16; it++) {
    const bf16x8 uf = q0;
    q0 = q1; q1 = q2; q2 = q3;
    const int itn = (it + 4 < 16) ? (it + 4) : 15;
    q3 = ssm_ufrag(U2, bp, g, SSM_TB(itn), li, hf);
    f32x16 x0 = MFMA(uf, bbf[0], zero), x1 = MFMA(uf, bbf[1], zero), x2 = MFMA(uf, bbf[2], zero), x3 = MFMA(uf, bbf[3], zero);
    ssm_scan16(x0, x1, x2, x3, a0, a1, h0r, h0i, h1r, h1i, dir);
  }
  float* E = (float*)(p.ws + OFF_E) + ((((size_t)(dir * 32 + g) * 8 + (2 * bp + hf)) * 16 + ch) * 64) * 2;
  *(float2*)(E + li * 2) = make_float2(h0r, h0i);
  *(float2*)(E + (li + 32) * 2) = make_float2(h1r, h1i);
}

DI void ssm2_item(const Params& p, int l, int item, char* smem) {
  const int tid = vtid(), lane = tid & 63, wave = __builtin_amdgcn_readfirstlane(tid >> 6);
  const int hf = lane >> 5, li = lane & 31;
  const int w = item * 4 + wave;
  const int ch = w & 15, bp = (w >> 4) & 3, g = w >> 6;
  u16* Hs = (u16*)smem + wave * (32 * 136);
  const u16* U2 = (const u16*)(p.ws + OFF_U2);
  float* YF = (float*)(p.ws + OFF_ACT);
  u16* YG = (u16*)(p.ws + OFF_YG);
  f32x16 zero;
#pragma unroll
  for (int r = 0; r < 16; r++) zero[r] = 0.f;
  const int oseq = li >> 4, ostep = li & 15;
  const int ob = 2 * bp + oseq;

  for (int dir = 0; dir < 2; dir++) {
    const int idx = (l * 2 + dir) * 32 + g;
    const u16* BB = (const u16*)(p.ws + OFF_SSMBB) + (size_t)idx * 128 * 16;
    const u16* CC = (const u16*)(p.ws + OFF_SSMCC) + (size_t)idx * 16 * 128;
    const float* SA = (const float*)(p.ws + OFF_SSMA) + (size_t)idx * 64 * 4;
    bf16x8 bbf[4], ccf[8];
#pragma unroll
    for (int j = 0; j < 4; j++) bbf[j] = *(const bf16x8*)(BB + (32 * j + li) * 16 + 8 * hf);
#pragma unroll
    for (int s = 0; s < 8; s++) {
      bf16x8 v = *(const bf16x8*)(CC + (li & 15) * 128 + 16 * s + 8 * hf);
      if (li >= 16) {
#pragma unroll
        for (int e = 0; e < 8; e++) v[e] = 0;
      }
      ccf[s] = v;
    }
    const float4 a0 = *(const float4*)(SA + li * 4);
    const float4 a1 = *(const float4*)(SA + (li + 32) * 4);
    float h0r = 0.f, h0i = 0.f, h1r = 0.f, h1i = 0.f;
    {
      const float* E = (const float*)(p.ws + OFF_E) + ((((size_t)(dir * 32 + g) * 8 + (2 * bp + hf)) * 16) * 64) * 2;
      const int n = dir ? (15 - ch) : ch;
      for (int i0 = 0; i0 < n; i0 += 4) {
        float2 e0[4], e1[4];
#pragma unroll
        for (int u = 0; u < 4; u++) {
          int ii = i0 + u; if (ii > n - 1) ii = n - 1;
          const int ci = dir ? (15 - ii) : ii;
          e0[u] = *(const float2*)(E + (size_t)ci * 128 + li * 2);
          e1[u] = *(const float2*)(E + (size_t)ci * 128 + (li + 32) * 2);
        }
#pragma unroll
        for (int u = 0; u < 4; u++) {
          if (i0 + u < n) {
            float nr = a0.z * h0r - a0.w * h0i + e0[u].x, ni = a0.z * h0i + a0.w * h0r + e0[u].y;
            h0r = nr; h0i = ni;
            float mr = a1.z * h1r - a1.w * h1i + e1[u].x, mi = a1.z * h1i + a1.w * h1r + e1[u].y;
            h1r = mr; h1i = mi;
          }
        }
      }
    }
    bf16x8 ufn = ssm_ufrag(U2, bp, g, ch * 256 + (dir ? 15 : 0) * 16, li, hf);
    for (int it = 0; it < 16; it++) {
      const int tb = ch * 256 + (dir ? (15 - it) : it) * 16;
      const bf16x8 uf = ufn;
      f32x16 x0 = MFMA(uf, bbf[0], zero), x1 = MFMA(uf, bbf[1], zero), x2 = MFMA(uf, bbf[2], zero), x3 = MFMA(uf, bbf[3], zero);
      if (it + 1 < 16) ufn = ssm_ufrag(U2, bp, g, ch * 256 + (dir ? (14 - it) : (it + 1)) * 16, li, hf);
      const int tt = tb + ostep;
      const size_t yoff = (((size_t)(ob * 32 + g)) * 4096 + tt) * 16;
      float4 f0 = make_float4(0.f, 0.f, 0.f, 0.f), f1 = f0, u0 = f0, u1 = f0;
      if (dir) {
        f0 = *(const float4*)(YF + yoff + 4 * hf);
        f1 = *(const float4*)(YF + yoff + 8 + 4 * hf);
        u0 = ld_bf4(U2 + yoff + 4 * hf);
        u1 = ld_bf4(U2 + yoff + 8 + 4 * hf);
      }
      asm volatile("s_waitcnt lgkmcnt(0)" ::: "memory");
      if (dir == 0) {
#pragma unroll
        for (int r = 0; r < 16; r++) {
          float nr = a0.x * h0r - a0.y * h0i + x0[r], ni = a0.x * h0i + a0.y * h0r + x2[r];
          h0r = nr; h0i = ni;
          float mr = a1.x * h1r - a1.y * h1i + x1[r], mi = a1.x * h1i + a1.y * h1r + x3[r];
          h1r = mr; h1i = mi;
          *(unsigned*)(Hs + (hf * 16 + r) * 136 + 2 * li) = pk(h0r, h0i);
          *(unsigned*)(Hs + (hf * 16 + r) * 136 + 2 * (li + 32)) = pk(h1r, h1i);
        }
      } else {
#pragma unroll
        for (int r = 15; r >= 0; r--) {
          float nr = a0.x * h0r - a0.y * h0i + x0[r], ni = a0.x * h0i + a0.y * h0r + x2[r];
          h0r = nr; h0i = ni;
          float mr = a1.x * h1r - a1.y * h1i + x1[r], mi = a1.x * h1i + a1.y * h1r + x3[r];
          h1r = mr; h1i = mi;
          *(unsigned*)(Hs + (hf * 16 + r) * 136 + 2 * li) = pk(h0r, h0i);
          *(unsigned*)(Hs + (hf * 16 + r) * 136 + 2 * (li + 32)) = pk(h1r, h1i);
        }
      }
      asm volatile("s_waitcnt lgkmcnt(0)" ::: "memory");
      f32x16 y = zero;
#pragma unroll
      for (int s = 0; s < 8; s++) {
        bf16x8 hfv = *(const bf16x8*)(Hs + li * 136 + 16 * s + 8 * hf);
        y = MFMA(ccf[s], hfv, y);
      }
      if (dir == 0) {
        *(float4*)(YF + yoff + 4 * hf) = make_float4(y[0], y[1], y[2], y[3]);
        *(float4*)(YF + yoff + 8 + 4 * hf) = make_float4(y[4], y[5], y[6], y[7]);
      } else {
        float4 d0 = *(const float4*)(p.ssm_d + l * 512 + g * 16 + 4 * hf);
        float4 d1 = *(const float4*)(p.ssm_d + l * 512 + g * 16 + 8 + 4 * hf);
        float v[8];
        v[0] = f0.x + y[0] + d0.x * u0.x; v[1] = f0.y + y[1] + d0.y * u0.y;
        v[2] = f0.z + y[2] + d0.z * u0.z; v[3] = f0.w + y[3] + d0.w * u0.w;
        v[4] = f1.x + y[4] + d1.x * u1.x; v[5] = f1.y + y[5] + d1.y * u1.y;
        v[6] = f1.z + y[6] + d1.z * u1.z; v[7] = f1.w + y[7] + d1.w * u1.w;
#pragma unroll
        for (int e = 0; e < 8; e++) {
          float xx = v[e];
          float z = 0.7978845608028654f * (xx + 0.044715f * xx * xx * xx);
          float th = 1.f - 2.f / (__expf(2.f * z) + 1.f);
          v[e] = 0.5f * xx * (1.f + th);
        }
        u16* yg = YG + tl_idx(ob * 4096 + tt, g * 16);
        st_bf4(yg + 4 * hf, v[0], v[1], v[2], v[3]);
        st_bf4(yg + 8 + 4 * hf, v[4], v[5], v[6], v[7]);
      }
    }
    asm volatile("s_waitcnt lgkmcnt(0)" ::: "memory");
  }
}

DI void qkpost_phase(int l) {
  const Params p = kparams();
  const float* ROPE = (const float*)(p.ws + OFF_ROPE);
  const int nrows = T_TOK * 8 + T_TOK * 2;
  for (int r = blockIdx.x * 512 + tidx(); r < nrows; r += gridDim.x * 512) {
    const bool isq = r < T_TOK * 8;
    const int rk = r - T_TOK * 8;
    u16* row = isq ? ((u16*)(p.ws + OFF_Q) + (size_t)r * 64) : ((u16*)(p.ws + OFF_K) + (size_t)rk * 64);
    const int pos = isq ? ((r >> 3) & 4095) : (rk & 4095);
    const float* gn = isq ? (p.q_norm + l * 64) : (p.k_norm + l * 64);
    const float osc = isq ? QSCALE : 1.f;
    float v[64];
#pragma unroll
    for (int c = 0; c < 8; c++) {
      uint4 raw = ((const uint4*)row)[c];
      v[8 * c + 0] = __uint_as_float(raw.x << 16); v[8 * c + 1] = __uint_as_float(raw.x & 0xffff0000u);
      v[8 * c + 2] = __uint_as_float(raw.y << 16); v[8 * c + 3] = __uint_as_float(raw.y & 0xffff0000u);
      v[8 * c + 4] = __uint_as_float(raw.z << 16); v[8 * c + 5] = __uint_as_float(raw.z & 0xffff0000u);
      v[8 * c + 6] = __uint_as_float(raw.w << 16); v[8 * c + 7] = __uint_as_float(raw.w & 0xffff0000u);
    }
    float ss = 0.f;
#pragma unroll
    for (int e = 0; e < 64; e++) ss += v[e] * v[e];
    const float rn = rsqrtf(ss * (1.f / 64.f) + 1e-6f) * osc;
    const int irow = pos >> 6, icol = pos & 63;
#pragma unroll
    for (int c = 0; c < 8; c++) {
      float o[8];
#pragma unroll
      for (int e = 0; e < 4; e++) {
        const int pi = 4 * c + e;
        const int idx = (pi < 16) ? irow : icol;
        const float cs = ROPE[idx * 16 + (pi & 15)];
        const float sn = ROPE[1024 + idx * 16 + (pi & 15)];
        const float y0 = v[2 * pi] * rn * gn[2 * pi], y1 = v[2 * pi + 1] * rn * gn[2 * pi + 1];
        o[2 * e] = y0 * cs - y1 * sn;
        o[2 * e + 1] = y0 * sn + y1 * cs;
      }
      uint4 w;
      w.x = pk(o[0], o[1]); w.y = pk(o[2], o[3]); w.z = pk(o[4], o[5]); w.w = pk(o[6], o[7]);
      ((uint4*)row)[c] = w;
    }
  }
}

DI void attn_phase(char* smem) {
  const Params p = kparams();
  for (int lq = blockIdx.x >> 3; lq < 128; lq += (gridDim.x >> 3)) attn_item(p, (blockIdx.x & 7) + 8 * lq, smem);
}
DI void ssm1_phase(int l) {
  const Params p = kparams();
  for (int it = blockIdx.x * 2 + vhalf(); it < 1024; it += gridDim.x * 2) ssm1_item(p, l, it);
}
DI void ssm2_phase(int l, char* smem) {
  const Params p = kparams();
  char* sm = smem + vhalf() * 40960;
  for (int it = blockIdx.x * 2 + vhalf(); it < 512; it += gridDim.x * 2) ssm2_item(p, l, it, sm);
}

DI void final_phase() {
  const Params p = kparams();
  const float* X = (const float*)(p.ws + OFF_X);
  const float* SSX = (const float*)(p.ws + OFF_SSX);
  const int total = T_TOK * 256;
  for (int i = blockIdx.x * 512 + tidx(); i < total; i += gridDim.x * 512) {
    int t = i >> 8, n = (i & 255) * 4;
    float rv = row_rinv16(SSX, t, 1.f / 1024.f);
    float4 x = *(const float4*)(X + (size_t)t * 1024 + n);
    float4 g = *(const float4*)(p.final_norm + n);
    float4 o;
    o.x = x.x * rv * g.x * DBGS; o.y = x.y * rv * g.y * DBGS; o.z = x.z * rv * g.z * DBGS; o.w = x.w * rv * g.w * DBGS;
    *(float4*)(p.out + (size_t)t * 1024 + n) = o;
  }
}

#define XB_TMO      128
#define XB_XCNT(j)  (256  + 64 * (j))
#define XB_XSUB(j)  (1280 + 64 * (j))
#define XB_XGEN(j)  (2304 + 64 * (j))
#define XB_TOP      3328
#define XB_TOPGEN   3392
#define XCD_BAR_WORDS 3456
#define XB_SPIN_CAP (1u << 18)
#define LAS __attribute__((address_space(3)))

__device__ __forceinline__ unsigned xb_ld(unsigned* p)              { return __hip_atomic_load(p, __ATOMIC_RELAXED, __HIP_MEMORY_SCOPE_AGENT); }
__device__ __forceinline__ unsigned xb_add(unsigned* p, unsigned v) { return __hip_atomic_fetch_add(p, v, __ATOMIC_RELAXED, __HIP_MEMORY_SCOPE_AGENT); }
__device__ __forceinline__ unsigned xb_xcc_id() { return (unsigned)__builtin_amdgcn_s_getreg((3 << 11) | 20) & 0xFu; }
#define XB_SPIN(cond, bar) do { unsigned _sp = 0; while (cond) { __builtin_amdgcn_s_sleep(1); \
    if ((++_sp & 255u) == 0u) { if (xb_ld(&(bar)[XB_TMO])) break; if (_sp > XB_SPIN_CAP) { atomicAdd(&(bar)[XB_TMO], 1u); break; } } } } while (0)

struct XcdBarrier {
    unsigned* bar; unsigned x;
    volatile LAS unsigned* st;
};

__device__ __forceinline__ XcdBarrier xcd_barrier_post(unsigned* bar, volatile LAS unsigned* st) {
    XcdBarrier b; b.bar = bar; b.x = xb_xcc_id(); b.st = st;
    if (threadIdx.x == 0) (void)xb_add(&bar[XB_XCNT(b.x)], 1u);
    return b;
}
__device__ __forceinline__ void xcd_barrier_complete(unsigned* bar, unsigned x, unsigned& nloc, unsigned& nx) {
    const unsigned G = gridDim.x * gridDim.y * gridDim.z;
    unsigned sum, cnt, mine, sp = 0u;
    for (;;) {
        sum = 0u; cnt = 0u; mine = 0u;
#pragma unroll
        for (unsigned j = 0; j < 16; ++j) { const unsigned c = xb_ld(&bar[XB_XCNT(j)]); sum += c; cnt += (c > 0u) ? 1u : 0u; mine = (j == x) ? c : mine; }
        if (sum == G) break;
        __builtin_amdgcn_s_sleep(1);
        if ((++sp & 255u) == 0u) { if (xb_ld(&bar[XB_TMO])) break; if (sp > XB_SPIN_CAP) { atomicAdd(&bar[XB_TMO], 1u); break; } }
    }
    nloc = mine > 0u ? mine : 1u; nx = cnt > 0u ? cnt : 1u;
}

__device__ __forceinline__ void xcd_barrier(const XcdBarrier& b) {
    asm volatile("s_waitcnt vmcnt(0)" ::: "memory");
    __syncthreads();
    if (threadIdx.x == 0) {
        unsigned* bar = b.bar;
        __builtin_amdgcn_s_waitcnt(0);
        unsigned nloc = b.st[0], nx = b.st[1];
        if (nloc == 0u) { xcd_barrier_complete(bar, b.x, nloc, nx); b.st[0] = nloc; b.st[1] = nx; }
        const unsigned old = xb_add(&bar[XB_XSUB(b.x)], 1u);
        const unsigned gen = old / nloc;
        if (old + 1u == (gen + 1u) * nloc) {
            __builtin_amdgcn_fence(__ATOMIC_RELEASE, "agent");
            asm volatile("s_waitcnt vmcnt(0)" ::: "memory");
            const unsigned og = xb_add(&bar[XB_TOP], 1u);
            const unsigned tg = og / nx;
            if (og + 1u == (tg + 1u) * nx) xb_add(&bar[XB_TOPGEN], 1u);
            else XB_SPIN(xb_ld(&bar[XB_TOPGEN]) == tg, bar);
            __builtin_amdgcn_fence(__ATOMIC_ACQUIRE, "agent");
            xb_add(&bar[XB_XGEN(b.x)], 1u);
            asm volatile("s_waitcnt vmcnt(0)" ::: "memory");
        } else {
            XB_SPIN(xb_ld(&bar[XB_XGEN(b.x)]) == gen, bar);
            __builtin_amdgcn_fence(__ATOMIC_ACQUIRE, "agent");
            asm volatile("s_waitcnt vmcnt(0)" ::: "memory");
        }
    }
    __syncthreads();
}
#ifdef PROBE_BAR2
#define GSYNC() do { xcd_barrier(xbar); xcd_barrier(xbar); } while (0)
#else
#define GSYNC() xcd_barrier(xbar)
#endif
#ifndef ONLYK
#define ONLYK -1
#endif
#ifndef ENMASK
#define ENMASK 0x7ff
#endif
#define EN(n) ((ONLYK < 0 && ((ENMASK >> (n)) & 1)) || ONLYK == (n))
__global__ void __launch_bounds__(512) mega(Params p_) {
  __shared__ __attribute__((aligned(16))) char smem[147456];
  cg::grid_group grid = cg::this_grid();
  __shared__ __attribute__((aligned(16))) unsigned xb_words[4];
  if (tidx() < 4) xb_words[tidx()] = 0u;
  __syncthreads();
  if (p_.ph_lo < 0) grid.sync();
  const XcdBarrier xbar = xcd_barrier_post((unsigned*)(p_.ws + OFF_BAR), (volatile LAS unsigned*)xb_words);
#ifdef DBG_COPY
  {
    const Params p = kparams();
    for (int i = blockIdx.x * 512 + tidx(); i < T_TOK * 1024; i += gridDim.x * 512) p.out[i] = p.x[i] * 1.5f;
    return;
  }
#endif
  int ph = p_.ph_lo;
  const int ph_hi = p_.ph_hi;
  if (ph == 0 && ph < ph_hi) {
    if (EN(0)) phase0(smem);
    ph++;
    if (ph < ph_hi) GSYNC();
  }
  if (ph == 1 && ph < ph_hi) {
    if (EN(1)) phase1(smem);
    ph++;
    if (ph < ph_hi) GSYNC();
  }
#ifdef PROBE_P01X2
  phase0(smem); GSYNC(); phase1(smem); GSYNC();
#endif
#ifdef DBG_CUT
  for (; ph < ph_hi && ph < DBG_CUT; ph++) {
    const int l = (ph - 2) / 7, k = (ph - 2) % 7;
    if (k == 0) { gemm_phase<EPI_IN>(l, smem); }
    else if (k == 1) { qkpost_phase(l); ssm1_phase(l); }
    else if (k == 2) { attn_phase(smem); ssm2_phase(l, smem); }
    else if (k == 3) { gemm_phase<EPI_GLU>(l, smem); }
    else if (k == 4) { gemm_phase<EPI_OUT>(l, smem); }
    else if (k == 5) { gemm_phase<EPI_F1>(l, smem); }
    else { gemm_phase<EPI_F2>(l, smem); }
    GSYNC();
  }
  {
    const Params p = kparams();
    const u16* src = (const u16*)(p.ws + DBG_DUMP_OFF);
    for (int i = blockIdx.x * 512 + tidx(); i < T_TOK * 1024; i += gridDim.x * 512) p.out[i] = bf2f(src[i]);
  }
  return;
#endif
  for (; ph < ph_hi && ph < NPHASE - 1; ph++) {
    const int l = (ph - 2) / 7, k = (ph - 2) % 7;
    if (k == 0) { if (EN(3)) gemm_phase<EPI_IN>(l, smem);
#ifdef PROBE_GX2
      gemm_phase<EPI_IN>(l, smem);
#endif
    }
    else if (k == 1) { if (EN(4)) { qkpost_phase(l); ssm1_phase(l);
#ifdef PROBE_SSM2X
      ssm1_phase(l);
#ifdef PROBE_SSMX
      ssm1_phase(l);
#endif
#endif
    } }
    else if (k == 2) {
      const int first = (blockIdx.x >> 3) & 1;
      for (int s2 = 0; s2 < 2; s2++) {
        __syncthreads();
        if ((s2 ^ first) == 0) { if (EN(5)) attn_phase(smem);
#ifdef PROBE_ATT2
          attn_phase(smem);
#endif
        }
        else { if (EN(6)) ssm2_phase(l, smem);
#ifdef PROBE_SSMX
          ssm2_phase(l, smem);
#endif
        }
      }
    }
    else if (k == 3) { if (EN(7)) gemm_phase<EPI_GLU>(l, smem);
#ifdef PROBE_GX2
      gemm_phase<EPI_GLU>(l, smem);
#endif
    }
    else if (k == 4) { if (EN(8)) gemm_phase<EPI_OUT>(l, smem);
#ifdef PROBE_GX2
      gemm_phase<EPI_OUT>(l, smem, true);
#endif
    }
    else if (k == 5) { if (EN(9)) gemm_phase<EPI_F1>(l, smem);
#ifdef PROBE_F1X2
      gemm_phase<EPI_F1>(l, smem);
#endif
    }
    else { if (EN(10)) gemm_phase<EPI_F2>(l, smem);
#ifdef PROBE_GX2
      gemm_phase<EPI_F2>(l, smem, true);
#endif
    }
    if (ph + 1 < ph_hi) GSYNC();
  }
  if (ph == NPHASE - 1 && ph < ph_hi) {
    if (EN(2)) final_phase();
  }
}

extern "C" void kernel_launch(void* const* d_in, const int* in_sizes, int n_in, void* d_out, int out_size, void* d_ws,
                              size_t ws_size, hipStream_t stream) {
  static int grid_blocks = 0;
  if (!grid_blocks) {
    int dev = 0, cus = 0, per_cu = 0;
    hipGetDevice(&dev);
    hipDeviceGetAttribute(&cus, hipDeviceAttributeMultiprocessorCount, dev);
    hipOccupancyMaxActiveBlocksPerMultiprocessor(&per_cu, mega, 512, 0);
    per_cu = 1;
    grid_blocks = cus * per_cu;
    if (ws_size < WS_TOTAL) fprintf(stderr, "kernel_launch: workspace too small: %zu < %zu\n", ws_size, (size_t)WS_TOTAL);
  }
  if (ws_size < WS_TOTAL) return;
  Params p{};
  const float** pp = (const float**)&p;
  for (int i = 0; i < 25; i++) pp[i] = (const float*)d_in[i];
  p.out = (float*)d_out;
  p.ws = (char*)d_ws;
  hipMemsetAsync((char*)d_ws + OFF_BAR, 0, 16384, stream);
#ifdef DBG_MEMSET
  hipMemsetAsync(d_ws, 0, WS_TOTAL, stream);
#endif
#if MULTI_LAUNCH
  for (int ph = 0; ph < NPHASE; ph++) {
    p.ph_lo = ph; p.ph_hi = ph + 1;
    hipLaunchKernelGGL(mega, dim3(grid_blocks), dim3(512), 0, stream, p);
  }
#else
  p.ph_lo = 0; p.ph_hi = NPHASE;
  void* args[] = {&p};
  hipError_t e = hipLaunchCooperativeKernel((void*)mega, dim3(grid_blocks), dim3(512), args, 0, stream);
  if (e != hipSuccess) fprintf(stderr, "cooperative launch failed: %s (grid %d)\n", hipGetErrorString(e), grid_blocks);
#endif
}
```

```cpp
#include <hip/hip_runtime.h>
#include <hip/hip_cooperative_groups.h>
#include <cstdio>
namespace cg = cooperative_groups;

typedef __attribute__((ext_vector_type(8))) short bf16x8;
typedef __attribute__((ext_vector_type(16))) float f32x16;
typedef __attribute__((ext_vector_type(2))) __bf16 bf2v;
typedef __attribute__((ext_vector_type(2))) float f2v;
typedef unsigned short u16;

#define DI __device__ __forceinline__
#define MFMA(a, b, c) __builtin_amdgcn_mfma_f32_32x32x16_bf16((a), (b), (c), 0, 0, 0)

constexpr int T_TOK = 32768;
constexpr int NPHASE = 31;
constexpr float QSCALE = 0.125f * 1.4426950408889634f;

constexpr size_t OFF_WT_IN  = 0;
constexpr size_t OFF_WT_GLU = OFF_WT_IN + 10485760;
constexpr size_t OFF_WT_OUT = OFF_WT_GLU + 2097152;
constexpr size_t OFF_WT_F1  = OFF_WT_OUT + 8388608;
constexpr size_t OFF_WT_F2  = OFF_WT_F1 + 46137344;
constexpr size_t OFF_MOD    = OFF_WT_F2 + 23068672;
constexpr size_t OFF_BIAS1  = OFF_MOD + 786432;
constexpr size_t OFF_BIAS2  = OFF_BIAS1 + 163840;
constexpr size_t OFF_ROPE   = OFF_BIAS2 + 720896;
constexpr size_t OFF_SSMA   = OFF_ROPE + 8192;
constexpr size_t OFF_SSMBB  = OFF_SSMA + 262144;
constexpr size_t OFF_SSMCC  = OFF_SSMBB + 1048576;
constexpr size_t OFF_E      = OFF_SSMCC + 1048576;
constexpr size_t OFF_SSX    = OFF_E + 4194304;
constexpr size_t OFF_SSA    = OFF_SSX + 2097152;
constexpr size_t OFF_SSS    = OFF_SSA + 1048576;
constexpr size_t OFF_X      = OFF_SSS + 1048576;
constexpr size_t OFF_ACT    = OFF_X + 134217728;
constexpr size_t OFF_UNION  = OFF_ACT + 67108864;
constexpr size_t OFF_HID    = OFF_UNION;
constexpr size_t OFF_Q      = OFF_UNION;
constexpr size_t OFF_K      = OFF_Q + 33554432;
constexpr size_t OFF_VT     = OFF_K + 8388608;
constexpr size_t OFF_U2     = OFF_VT + 8388608;
constexpr size_t OFF_YG     = OFF_U2 + 33554432;
constexpr size_t OFF_OATT   = OFF_YG + 33554432;
constexpr size_t OFF_OSSM   = OFF_OATT + 33554432;
constexpr size_t OFF_BAR    = OFF_UNION + 184549376;
constexpr size_t WS_TOTAL   = OFF_BAR + 16384;

struct Params {
  const float *x, *c, *w_ada, *b_ada, *norm1, *w_in, *q_norm, *k_norm, *lam_re, *lam_im, *log_dt,
      *b_re, *b_im, *c_re, *c_im, *ssm_d, *w_glu, *b_glu, *attn_out_norm, *ssm_out_norm, *w_out, *norm2,
      *w_ffn_in, *w_ffn_out, *final_norm;
  float* out;
  char* ws;
  int ph_lo, ph_hi;
};

DI unsigned pk(float a, float b) {
  f2v v = {a, b};
  bf2v r = __builtin_convertvector(v, bf2v);
  return __builtin_bit_cast(unsigned, r);
}
DI int tidx() { int t = __builtin_amdgcn_workitem_id_x(); asm volatile("" : "+v"(t)); return t; }
typedef const Params __attribute__((address_space(4)))* KParamPtr;
DI Params kparams() {
#if defined(__HIP_DEVICE_COMPILE__)
  KParamPtr q = (KParamPtr)__builtin_amdgcn_kernarg_segment_ptr();
  asm volatile("" : "+s"(q));
  return *q;
#else
  return Params{};
#endif
}
DI int vtid() { return tidx() & 255; }
DI int vhalf() { return tidx() >> 8; }
DI float bf2f(unsigned short h) { return __uint_as_float(((unsigned)h) << 16); }
DI void st_bf4(u16* dst, float a, float b, float c, float d) {
  uint2 v; v.x = pk(a, b); v.y = pk(c, d);
  *(uint2*)dst = v;
}
DI float4 ld_bf4(const u16* src) {
  uint2 v = *(const uint2*)src;
  float4 r;
  r.x = __uint_as_float(v.x << 16); r.y = __uint_as_float(v.x & 0xffff0000u);
  r.z = __uint_as_float(v.y << 16); r.w = __uint_as_float(v.y & 0xffff0000u);
  return r;
}
DI float wave_sum(float v) {
#pragma unroll
  for (int o = 32; o > 0; o >>= 1) v += __shfl_xor(v, o);
  return v;
}
DI size_t tl_idx(int t, int n) { return ((size_t)(n >> 6) * T_TOK + t) * 64 + (n & 63); }
DI int crow(int r, int hf) { return (r & 3) + 8 * (r >> 2) + 4 * hf; }
DI int f1perm(int n) {
  int j = (n < 2816) ? n : n - 2816;
  return (j >> 5) * 64 + (j & 31) + ((n < 2816) ? 0 : 32);
}

DI void transpose_tile(const float* __restrict__ src, int N, u16* __restrict__ dst, int K, int k0, int n0,
                       int permmode, const float* __restrict__ kscale, float* tl) {
  const int tid = vtid();
  __syncthreads();
#pragma unroll 4
  for (int i = 0; i < 16; i++) {
    int r = (tid >> 6) + 4 * i;
    float v = src[(size_t)(k0 + r) * N + n0 + (tid & 63)];
    if (kscale) v *= kscale[k0 + r];
    tl[r * 65 + (tid & 63)] = v;
  }
  __syncthreads();
#pragma unroll 4
  for (int i = 0; i < 8; i++) {
    int n = (tid >> 5) + 8 * i;
    int kp = tid & 31;
    float a = tl[(2 * kp) * 65 + n], b = tl[(2 * kp + 1) * 65 + n];
    int nn = n0 + n;
    int no = permmode ? f1perm(nn) : nn;
    *(unsigned*)(dst + ((size_t)(k0 >> 6) * N + no) * 64 + 2 * kp) = pk(a, b);
  }
}

DI void gemv8_item(const float* vec, int vstride, bool do_silu, const float* __restrict__ W, int N, int j0,
                   const float* bias, float* out, int ostride, int permmode, float* sm) {
  const int tid = vtid();
  float* vs = sm;
  float* red = sm + 8192;
  __syncthreads();
  for (int i = tid; i < 8192; i += 256) {
    int b = i >> 10, k = i & 1023;
    float v = vec[(size_t)b * vstride + k];
    if (do_silu) v = v / (1.f + expf(-v));
    vs[i] = v;
  }
  __syncthreads();
  const int kq = tid >> 6, jj = tid & 63;
  float acc[8];
#pragma unroll
  for (int b = 0; b < 8; b++) acc[b] = 0.f;
#pragma unroll 4
  for (int k = kq * 256; k < kq * 256 + 256; k++) {
    float w = W[(size_t)k * N + j0 + jj];
#pragma unroll
    for (int b = 0; b < 8; b++) acc[b] += vs[b * 1024 + k] * w;
  }
#pragma unroll
  for (int b = 0; b < 8; b++) red[(kq * 8 + b) * 64 + jj] = acc[b];
  __syncthreads();
  for (int o = tid; o < 512; o += 256) {
    int b = o >> 6, j = o & 63;
    float s = red[(0 * 8 + b) * 64 + j] + red[(8 + b) * 64 + j] + red[(16 + b) * 64 + j] + red[(24 + b) * 64 + j];
    int jg = j0 + j;
    if (bias) s += bias[jg];
    int jo = permmode ? f1perm(jg) : jg;
    out[(size_t)b * ostride + jo] = s;
  }
}

DI void ssm_param_item(const Params& p, int idx) {
  const int tid = vtid();
  const int pp = tid & 63, cq = tid >> 6;
  float* SSMA = (float*)(p.ws + OFF_SSMA);
  u16* BB = (u16*)(p.ws + OFF_SSMBB);
  u16* CC = (u16*)(p.ws + OFF_SSMCC);
  double lr = (double)p.lam_re[idx * 64 + pp];
  if (lr > -1e-4) lr = (double)(-1e-4f);
  double li = (double)p.lam_im[idx * 64 + pp];
  double dt = exp((double)p.log_dt[idx]);
  double mag = exp(lr * dt);
  double ar = mag * cos(li * dt), ai = mag * sin(li * dt);
  double den = lr * lr + li * li;
  double nre = ar - 1.0;
  double kre = (nre * lr + ai * li) / den;
  double kim = (ai * lr - nre * li) / den;
  if (cq == 0) {
    double magL = exp(lr * dt * 256.0);
    float4 v;
    v.x = (float)ar; v.y = (float)ai;
    v.z = (float)(magL * cos(li * dt * 256.0)); v.w = (float)(magL * sin(li * dt * 256.0));
    *(float4*)(SSMA + (size_t)(idx * 64 + pp) * 4) = v;
  }
#pragma unroll
  for (int cc = 0; cc < 4; cc++) {
    int c = cq * 4 + cc;
    double br = (double)p.b_re[(size_t)(idx * 64 + pp) * 16 + c];
    double bi = (double)p.b_im[(size_t)(idx * 64 + pp) * 16 + c];
    float bbr = (float)(kre * br - kim * bi);
    float bbi = (float)(kre * bi + kim * br);
    BB[(size_t)(idx * 128 + pp) * 16 + c] = (u16)(pk(bbr, 0.f) & 0xffffu);
    BB[(size_t)(idx * 128 + 64 + pp) * 16 + c] = (u16)(pk(bbi, 0.f) & 0xffffu);
    float cr = p.c_re[(size_t)(idx * 16 + c) * 64 + pp];
    float ci = p.c_im[(size_t)(idx * 16 + c) * 64 + pp];
    *(unsigned*)(CC + (size_t)(idx * 16 + c) * 128 + 2 * pp) = pk(cr, -ci);
  }
}

DI void phase0(char* smem) {
  const Params p = kparams();
  float* sm = (float*)(smem + vhalf() * 40960);
  constexpr int N_TIN = 4 * 16 * 20, N_TGLU = 4 * 8 * 8, N_TOUT = 4 * 16 * 16, N_TF1 = 4 * 16 * 88, N_TF2 = 4 * 44 * 16;
  constexpr int N_MOD = 4 * 96, N_SSM = 256, N_ROPE = 1;
  constexpr int S0 = N_MOD, S1 = S0 + N_TIN, S2 = S1 + N_TGLU, S3 = S2 + N_TOUT, S4 = S3 + N_TF1, S5 = S4 + N_TF2,
                S6 = S5 + N_SSM, S7 = S6 + N_ROPE;
  for (int it = blockIdx.x * 2 + vhalf(); it < S7 + 1; it += gridDim.x * 2) {
    if (it < S0) {
      int l = it / 96, jb = it % 96;
      gemv8_item(p.c, 1024, true, p.w_ada + (size_t)l * 1024 * 6144, 6144, jb * 64, p.b_ada + l * 6144,
                 (float*)(p.ws + OFF_MOD) + (size_t)l * 8 * 6144, 6144, 0, sm);
    } else if (it < S1) {
      int r = it - S0; int l = r / 320; r %= 320; int kt = r / 20, ntile = r % 20;
      transpose_tile(p.w_in + (size_t)l * 1024 * 1280, 1280, (u16*)(p.ws + OFF_WT_IN) + (size_t)l * 1280 * 1024, 1024,
                     kt * 64, ntile * 64, 0, nullptr, sm);
    } else if (it < S2) {
      int r = it - S1; int l = r / 64; r %= 64; int kt = r / 8, ntile = r % 8;
      transpose_tile(p.w_glu + (size_t)l * 512 * 512, 512, (u16*)(p.ws + OFF_WT_GLU) + (size_t)l * 512 * 512, 512,
                     kt * 64, ntile * 64, 0, nullptr, sm);
    } else if (it < S3) {
      int r = it - S2; int l = r / 256; r %= 256; int kt = r / 16, ntile = r % 16;
      const float* ks = (kt < 8) ? (p.attn_out_norm + l * 512) : (p.ssm_out_norm + l * 512 - 512);
      transpose_tile(p.w_out + (size_t)l * 1024 * 1024, 1024, (u16*)(p.ws + OFF_WT_OUT) + (size_t)l * 1024 * 1024, 1024,
                     kt * 64, ntile * 64, 0, ks, sm);
    } else if (it < S4) {
      int r = it - S3; int l = r / 1408; r %= 1408; int kt = r / 88, ntile = r % 88;
      transpose_tile(p.w_ffn_in + (size_t)l * 1024 * 5632, 5632, (u16*)(p.ws + OFF_WT_F1) + (size_t)l * 5632 * 1024, 1024,
                     kt * 64, ntile * 64, 1, nullptr, sm);
    } else if (it < S5) {
      int r = it - S4; int l = r / 704; r %= 704; int kt = r / 16, ntile = r % 16;
      transpose_tile(p.w_ffn_out + (size_t)l * 2816 * 1024, 1024, (u16*)(p.ws + OFF_WT_F2) + (size_t)l * 1024 * 2816, 2816,
                     kt * 64, ntile * 64, 0, nullptr, sm);
    } else if (it < S6) {
      ssm_param_item(p, it - S5);
    } else {
      float* rope = (float*)(p.ws + OFF_ROPE);
      for (int i = vtid(); i < 1024; i += 256) {
        int idx = i >> 4, f = i & 15;
        double ang = (double)idx * pow(10000.0, -(double)f / 16.0);
        rope[i] = (float)cos(ang);
        rope[1024 + i] = (float)sin(ang);
      }
    }
  }
}

DI void phase1(char* smem) {
  const Params p = kparams();
  float* sm = (float*)(smem + vhalf() * 40960);
  const float* MOD = (const float*)(p.ws + OFF_MOD);
  constexpr int N_B1 = 4 * 20, N_B2 = 4 * 88, N_PREP = T_TOK / 4;
  for (int it = blockIdx.x * 2 + vhalf(); it < N_B1 + N_B2 + N_PREP; it += gridDim.x * 2) {
    if (it < N_B1) {
      int l = it / 20, jb = it % 20;
      gemv8_item(MOD + (size_t)l * 8 * 6144 + 0, 6144, false, p.w_in + (size_t)l * 1024 * 1280, 1280, jb * 64, nullptr,
                 (float*)(p.ws + OFF_BIAS1) + (size_t)l * 8 * 1280, 1280, 0, sm);
    } else if (it < N_B1 + N_B2) {
      int r = it - N_B1; int l = r / 88, jb = r % 88;
      gemv8_item(MOD + (size_t)l * 8 * 6144 + 3072, 6144, false, p.w_ffn_in + (size_t)l * 1024 * 5632, 5632, jb * 64, nullptr,
                 (float*)(p.ws + OFF_BIAS2) + (size_t)l * 8 * 5632, 5632, 1, sm);
    } else {
      int r = it - N_B1 - N_B2;
      const int lane = vtid() & 63, wave = vtid() >> 6;
      int t = r * 4 + wave;
      int b = t >> 12;
      const float4* xr = (const float4*)(p.x + (size_t)t * 1024);
      float4 v[4];
      float ss = 0.f;
#pragma unroll
      for (int i = 0; i < 4; i++) {
        v[i] = xr[lane + 64 * i];
        ss += v[i].x * v[i].x + v[i].y * v[i].y + v[i].z * v[i].z + v[i].w * v[i].w;
      }
      ss = wave_sum(ss);
      float* SSX = (float*)(p.ws + OFF_SSX);
      if (lane < 16) SSX[(size_t)t * 16 + lane] = (lane == 0) ? ss : 0.f;
      u16* ACT = (u16*)(p.ws + OFF_ACT);
      const float* sc1 = MOD + (size_t)(0 * 8 + b) * 6144 + 1024;
#pragma unroll
      for (int i = 0; i < 4; i++) {
        int k = (lane + 64 * i) * 4;
        float4 g = *(const float4*)(p.norm1 + k);
        float4 s = *(const float4*)(sc1 + k);
        st_bf4(ACT + tl_idx(t, k), v[i].x * g.x * (1.f + s.x), v[i].y * g.y * (1.f + s.y),
               v[i].z * g.z * (1.f + s.z), v[i].w * g.w * (1.f + s.w));
      }
    }
  }
}

enum { EPI_IN = 0, EPI_GLU = 1, EPI_OUT = 2, EPI_F1 = 3, EPI_F2 = 4 };

DI float row_rinv16(const float* ssx, int t, float invn) {
  const float4* q = (const float4*)(ssx + (size_t)t * 16);
  float4 a = q[0], b = q[1], c = q[2], d = q[3];
  float s = ((a.x + a.y) + (a.z + a.w)) + ((b.x + b.y) + (b.z + b.w)) + ((c.x + c.y) + (c.z + c.w)) + ((d.x + d.y) + (d.z + d.w));
  return rsqrtf(s * invn + 1e-6f);
}
DI float row_rinv8(const float* ss8, int t, float invn) {
  const float4* q = (const float4*)(ss8 + (size_t)t * 8);
  float4 a = q[0], b = q[1];
  float s = ((a.x + a.y) + (a.z + a.w)) + ((b.x + b.y) + (b.z + b.w));
  return rsqrtf(s * invn + 1e-6f);
}

template <int EPI>
DI void gemm_tile(const Params& p, const int l, const int mt, const int nt, char* smem, uint4& ra0, uint4& ra1, uint4& ra2, uint4& ra3,
               uint4& rb0, uint4& rb1, uint4& rb2, uint4& rb3, const bool first, const bool has_next, const int mt_next, const int nt_next) {
  constexpr int TJ = 4;
  constexpr int K = (EPI == EPI_GLU) ? 512 : (EPI == EPI_F2 ? 2816 : 1024);
  constexpr int KT = K / 64;
  u16* As = (u16*)smem;
  u16* Bs = As + 256 * 72;
  const int tid = tidx(), lane = tid & 63, wave = tid >> 6;
  const int wm = wave >> 2, wn = wave & 3;
  const int hf = lane >> 5, li = lane & 31;
  const int m0 = mt * 256, n0 = nt * 256;

  const u16* A0;
  const u16* A1 = nullptr;
  const u16* W;
  if (EPI == EPI_IN) { A0 = (const u16*)(p.ws + OFF_ACT); W = (const u16*)(p.ws + OFF_WT_IN) + (size_t)l * 1280 * 1024; }
  else if (EPI == EPI_GLU) { A0 = (const u16*)(p.ws + OFF_YG); W = (const u16*)(p.ws + OFF_WT_GLU) + (size_t)l * 512 * 512; }
  else if (EPI == EPI_OUT) { A0 = (const u16*)(p.ws + OFF_OATT); A1 = (const u16*)(p.ws + OFF_OSSM); W = (const u16*)(p.ws + OFF_WT_OUT) + (size_t)l * 1024 * 1024; }
  else if (EPI == EPI_F1) { A0 = (const u16*)(p.ws + OFF_ACT); W = (const u16*)(p.ws + OFF_WT_F1) + (size_t)l * 5632 * 1024; }
  else { A0 = (const u16*)(p.ws + OFF_HID); W = (const u16*)(p.ws + OFF_WT_F2) + (size_t)l * 1024 * 2816; }

  const int lrow = tid >> 3, lc8 = tid & 7;
  constexpr int NW = (EPI == EPI_IN) ? 1280 : (EPI == EPI_GLU ? 512 : (EPI == EPI_F1 ? 5632 : 1024));
  constexpr size_t AKT = (size_t)T_TOK * 64, WKT = (size_t)NW * 64;
  const u16* ag0 = A0 + (size_t)(m0 + lrow) * 64 + lc8 * 8;
  const u16* ag1 = (EPI == EPI_OUT) ? (A1 + (size_t)(m0 + lrow) * 64 + lc8 * 8) : nullptr;
  const u16* wg = W + (size_t)(n0 + lrow) * 64 + lc8 * 8;

  f32x16 acc[2][TJ];
#pragma unroll
  for (int i = 0; i < 2; i++)
#pragma unroll
    for (int j = 0; j < TJ; j++)
#pragma unroll
      for (int r = 0; r < 16; r++) acc[i][j][r] = 0.f;

#define GEMM_GLOAD_R(kt_, A0_, A1_, A2_, A3_, B0_, B1_, B2_, B3_)                                 \
  {                                                                                              \
    const u16* ap;                                                                               \
    if (EPI == EPI_OUT) ap = ((kt_) < 8) ? (ag0 + (kt_) * AKT) : (ag1 + (long)((kt_) - 8) * (long)AKT);      \
    else ap = ag0 + (kt_) * AKT;                                                                 \
    const u16* wp = wg + (kt_) * WKT;                                                            \
    A0_ = *(const uint4*)(ap);                                                                   \
    A1_ = *(const uint4*)(ap + 64 * 64);                                                         \
    A2_ = *(const uint4*)(ap + 128 * 64);                                                        \
    A3_ = *(const uint4*)(ap + 192 * 64);                                                        \
    B0_ = *(const uint4*)(wp);                                                                   \
    B1_ = *(const uint4*)(wp + 64 * 64);                                                         \
    B2_ = *(const uint4*)(wp + 128 * 64);                                                        \
    B3_ = *(const uint4*)(wp + 192 * 64);                                                        \
  }
#define GEMM_LSTORE_R(boff_, A0_, A1_, A2_, A3_, B0_, B1_, B2_, B3_) \
  {                                                                \
    u16* a_ = As + (boff_) + lrow * 72 + lc8 * 8;                  \
    u16* b_ = Bs + (boff_) + lrow * 72 + lc8 * 8;                  \
    *(uint4*)(a_) = A0_;                                           \
    *(uint4*)(a_ + 64 * 72) = A1_;                                 \
    *(uint4*)(a_ + 128 * 72) = A2_;                                \
    *(uint4*)(a_ + 192 * 72) = A3_;                                \
    *(uint4*)(b_) = B0_;                                           \
    *(uint4*)(b_ + 64 * 72) = B1_;                                 \
    *(uint4*)(b_ + 128 * 72) = B2_;                                \
    *(uint4*)(b_ + 192 * 72) = B3_;                                \
  }
#define GEMM_COMPUTE(cur_, DOST_, oth_, A0_, A1_, A2_, A3_, B0_, B1_, B2_, B3_)                                          \
  {                                                                                                                     \
    u16* a_ = As + (oth_) + lrow * 72 + lc8 * 8;                                                                        \
    u16* b_ = Bs + (oth_) + lrow * 72 + lc8 * 8;                                                                        \
    _Pragma("unroll") for (int s = 0; s < 4; s++) {                                                                     \
      bf16x8 wf[2], af[TJ];                                                                                             \
      _Pragma("unroll") for (int i = 0; i < 2; i++)                                                                     \
        wf[i] = *(const bf16x8*)(Bs + (cur_) + (wn * 64 + i * 32 + li) * 72 + s * 16 + hf * 8);                         \
      _Pragma("unroll") for (int j = 0; j < TJ; j++)                                                                    \
        af[j] = *(const bf16x8*)(As + (cur_) + (wm * 128 + j * 32 + li) * 72 + s * 16 + hf * 8);                        \
      _Pragma("unroll") for (int i = 0; i < 2; i++)                                                                     \
        _Pragma("unroll") for (int j = 0; j < TJ; j++) acc[i][j] = MFMA(wf[i], af[j], acc[i][j]);                       \
        \
      if (DOST_) {                                                                                                      \
        if (s == 0) { *(uint4*)(a_) = A0_; *(uint4*)(a_ + 64 * 72) = A1_; }                                             \
        if (s == 1) { *(uint4*)(a_ + 128 * 72) = A2_; *(uint4*)(a_ + 192 * 72) = A3_; }                                 \
        if (s == 2) { *(uint4*)(b_) = B0_; *(uint4*)(b_ + 64 * 72) = B1_; }                                             \
        if (s == 3) { *(uint4*)(b_ + 128 * 72) = B2_; *(uint4*)(b_ + 192 * 72) = B3_; }                                 \
      }                                                                                                                 \
    }                                                                                                                   \
  }
  constexpr int BUF = 2 * 256 * 72;
  uint4 sa0, sa1, sa2, sa3, sb0, sb1, sb2, sb3;
  if (first) GEMM_GLOAD_R(0, ra0, ra1, ra2, ra3, rb0, rb1, rb2, rb3);
  GEMM_GLOAD_R(1, sa0, sa1, sa2, sa3, sb0, sb1, sb2, sb3);
  int tok[TJ];
#pragma unroll
  for (int j = 0; j < TJ; j++) tok[j] = m0 + wm * 128 + j * 32 + li;

  __syncthreads();
  GEMM_LSTORE_R(0, ra0, ra1, ra2, ra3, rb0, rb1, rb2, rb3);
  GEMM_GLOAD_R(2, ra0, ra1, ra2, ra3, rb0, rb1, rb2, rb3);
  __syncthreads();
#pragma unroll 1
  for (int kt = 0; kt < KT; kt += 2) {
    if (EPI == EPI_OUT) {
      if (kt == 8) {
#pragma unroll
        for (int j = 0; j < TJ; j++) {
          const float ra_ = row_rinv8((const float*)(p.ws + OFF_SSA), tok[j], 1.f / 512.f);
          const float rs_ = row_rinv8((const float*)(p.ws + OFF_SSS), tok[j], 1.f / 512.f);
          const float mr = ra_ / rs_;
#pragma unroll
          for (int i = 0; i < 2; i++)
#pragma unroll
            for (int r = 0; r < 16; r++) acc[i][j][r] *= mr;
        }
      }
    }
    GEMM_COMPUTE(0, true, BUF, sa0, sa1, sa2, sa3, sb0, sb1, sb2, sb3);
    if (kt + 3 < KT) GEMM_GLOAD_R(kt + 3, sa0, sa1, sa2, sa3, sb0, sb1, sb2, sb3);
    __syncthreads();
    GEMM_COMPUTE(BUF, (kt + 2 < KT), 0, ra0, ra1, ra2, ra3, rb0, rb1, rb2, rb3);
    if (kt + 4 < KT) GEMM_GLOAD_R(kt + 4, ra0, ra1, ra2, ra3, rb0, rb1, rb2, rb3);
    __syncthreads();
  }
  if (has_next && EPI != EPI_OUT && EPI != EPI_F2) {
    const u16* ap = A0 + (size_t)(mt_next * 256 + lrow) * 64 + lc8 * 8;
    const u16* wp = W + (size_t)(nt_next * 256 + lrow) * 64 + lc8 * 8;
    ra0 = *(const uint4*)(ap);
    ra1 = *(const uint4*)(ap + 64 * 64);
    ra2 = *(const uint4*)(ap + 128 * 64);
    ra3 = *(const uint4*)(ap + 192 * 64);
    rb0 = *(const uint4*)(wp);
    rb1 = *(const uint4*)(wp + 64 * 64);
    rb2 = *(const uint4*)(wp + 128 * 64);
    rb3 = *(const uint4*)(wp + 192 * 64);
  }

  const int b = m0 >> 12;
  const int nbase = n0 + wn * 64;
  const float* MOD = (const float*)(p.ws + OFF_MOD);

  if (EPI == EPI_IN) {
    const float* bias = (const float*)(p.ws + OFF_BIAS1) + (size_t)(l * 8 + b) * 1280;
    const float* SSX = (const float*)(p.ws + OFF_SSX);
    float rinv[TJ];
#pragma unroll
    for (int j = 0; j < TJ; j++) rinv[j] = row_rinv16(SSX, tok[j], 1.f / 1024.f);
#pragma unroll
    for (int i = 0; i < 2; i++)
#pragma unroll
      for (int q4 = 0; q4 < 4; q4++) {
        float4 b4 = *(const float4*)(bias + nbase + i * 32 + 8 * q4 + 4 * hf);
#pragma unroll
        for (int j = 0; j < TJ; j++) {
          acc[i][j][4 * q4 + 0] = acc[i][j][4 * q4 + 0] * rinv[j] + b4.x;
          acc[i][j][4 * q4 + 1] = acc[i][j][4 * q4 + 1] * rinv[j] + b4.y;
          acc[i][j][4 * q4 + 2] = acc[i][j][4 * q4 + 2] * rinv[j] + b4.z;
          acc[i][j][4 * q4 + 3] = acc[i][j][4 * q4 + 3] * rinv[j] + b4.w;
        }
      }
    if (nbase < 640) {
#pragma unroll
      for (int j = 0; j < TJ; j++) {
        const int t = tok[j], pos = t & 4095;
#pragma unroll
        for (int i = 0; i < 2; i++)
#pragma unroll
          for (int q4 = 0; q4 < 4; q4++) {
            const int d0 = i * 32 + 8 * q4 + 4 * hf;
            u16* dst = (nbase < 512) ? ((u16*)(p.ws + OFF_Q) + (size_t)t * 512 + nbase + d0)
                                     : ((u16*)(p.ws + OFF_K) + ((size_t)(b * 2 + ((nbase - 512) >> 6)) * 4096 + pos) * 64 + d0);
            st_bf4(dst, acc[i][j][4 * q4 + 0], acc[i][j][4 * q4 + 1], acc[i][j][4 * q4 + 2], acc[i][j][4 * q4 + 3]);
          }
      }
    } else if (nbase < 768) {
      u16* VT = (u16*)(p.ws + OFF_VT);
      const int vh = (nbase - 640) >> 6;
#pragma unroll
      for (int j = 0; j < TJ; j++) {
        const int pos = tok[j] & 4095;
#pragma unroll
        for (int i = 0; i < 2; i++)
#pragma unroll
          for (int r = 0; r < 16; r++) {
            int d = i * 32 + crow(r, hf);
            VT[((size_t)(b * 2 + vh) * 64 + d) * 4096 + pos] = (u16)(pk(acc[i][j][r], 0.f) & 0xffffu);
          }
      }
    } else {
      u16* U2 = (u16*)(p.ws + OFF_U2);
      const int ch0 = nbase - 768;
#pragma unroll
      for (int j = 0; j < TJ; j++) {
        const int pos = tok[j] & 4095;
#pragma unroll
        for (int i = 0; i < 2; i++)
#pragma unroll
          for (int q4 = 0; q4 < 4; q4++) {
            int ch = ch0 + i * 32 + 8 * q4 + 4 * hf;
            int g = ch >> 4, c0 = ch & 15;
            st_bf4(U2 + (((size_t)(b * 32 + g)) * 4096 + pos) * 16 + c0, acc[i][j][4 * q4 + 0], acc[i][j][4 * q4 + 1],
                   acc[i][j][4 * q4 + 2], acc[i][j][4 * q4 + 3]);
          }
      }
    }
  } else if (EPI == EPI_GLU) {
    const float* bg = p.b_glu + l * 512;
    const u16* YG = (const u16*)(p.ws + OFF_YG);
    u16* OSSM = (u16*)(p.ws + OFF_OSSM);
    float* SSS = (float*)(p.ws + OFF_SSS);
#pragma unroll
    for (int j = 0; j < TJ; j++) {
      const int t = tok[j];
      float ss = 0.f;
#pragma unroll
      for (int i = 0; i < 2; i++)
#pragma unroll
        for (int q4 = 0; q4 < 4; q4++) {
          const int n = nbase + i * 32 + 8 * q4 + 4 * hf;
          float4 b4 = *(const float4*)(bg + n);
          float4 y = ld_bf4(YG + tl_idx(t, n));
          float o0 = y.x / (1.f + __expf(-(acc[i][j][4 * q4 + 0] + b4.x)));
          float o1 = y.y / (1.f + __expf(-(acc[i][j][4 * q4 + 1] + b4.y)));
          float o2 = y.z / (1.f + __expf(-(acc[i][j][4 * q4 + 2] + b4.z)));
          float o3 = y.w / (1.f + __expf(-(acc[i][j][4 * q4 + 3] + b4.w)));
          ss += o0 * o0 + o1 * o1 + o2 * o2 + o3 * o3;
          st_bf4(OSSM + tl_idx(t, n), o0, o1, o2, o3);
        }
      ss += __shfl_xor(ss, 32);
      if (hf == 0) SSS[(size_t)t * 8 + (nbase >> 6)] = ss;
    }
  } else if (EPI == EPI_OUT || EPI == EPI_F2) {
    const float* gate = MOD + (size_t)(l * 8 + b) * 6144 + (EPI == EPI_OUT ? 2048 : 5120);
    const bool has_next = (EPI == EPI_OUT) || (l < 3);
    const float* nrm = (EPI == EPI_OUT) ? (p.norm2 + l * 1024) : (p.norm1 + (l + 1) * 1024);
    const float* scn = (EPI == EPI_OUT) ? (MOD + (size_t)(l * 8 + b) * 6144 + 4096) : (MOD + (size_t)((l + 1) * 8 + b) * 6144 + 1024);
    const float* xin = (EPI == EPI_OUT && l == 0) ? p.x : (const float*)(p.ws + OFF_X);
    float* X = (float*)(p.ws + OFF_X);
    u16* ACT = (u16*)(p.ws + OFF_ACT);
    float* SSX = (float*)(p.ws + OFF_SSX);
    float* stg = (float*)smem + wave * (32 * 68);
    const int rr = lane >> 4, c4 = (lane & 15) * 4;
    const int n = nbase + c4;
    const float4 g4 = *(const float4*)(gate + n);
    float4 nsc = make_float4(0.f, 0.f, 0.f, 0.f);
    if (has_next) {
      const float4 nr = *(const float4*)(nrm + n);
      const float4 sc = *(const float4*)(scn + n);
      nsc = make_float4(nr.x * (1.f + sc.x), nr.y * (1.f + sc.y), nr.z * (1.f + sc.z), nr.w * (1.f + sc.w));
    }
    float4 xi[8], xn[8];
    float fj[TJ];
#pragma unroll
    for (int j = 0; j < TJ; j++) fj[j] = (EPI == EPI_OUT) ? row_rinv8((const float*)(p.ws + OFF_SSS), tok[j], 1.f / 512.f) : 1.f;
#pragma unroll
    for (int it = 0; it < 8; it++) xi[it] = *(const float4*)(xin + (size_t)(m0 + wm * 128 + rr + 4 * it) * 1024 + n);
#pragma unroll
    for (int j = 0; j < TJ; j++) {
#pragma unroll
      for (int i = 0; i < 2; i++)
#pragma unroll
        for (int q4 = 0; q4 < 4; q4++)
          *(float4*)(stg + li * 68 + i * 32 + 8 * q4 + 4 * hf) =
              make_float4(acc[i][j][4 * q4 + 0] * fj[j], acc[i][j][4 * q4 + 1] * fj[j], acc[i][j][4 * q4 + 2] * fj[j], acc[i][j][4 * q4 + 3] * fj[j]);
      asm volatile("s_waitcnt lgkmcnt(0)" ::: "memory");
      if (j + 1 < TJ) {
#pragma unroll
        for (int it = 0; it < 8; it++) xn[it] = *(const float4*)(xin + (size_t)(m0 + wm * 128 + (j + 1) * 32 + rr + 4 * it) * 1024 + n);
      }
#pragma unroll
      for (int it = 0; it < 8; it++) {
        const int row = rr + 4 * it;
        const int t = m0 + wm * 128 + j * 32 + row;
        const float4 a = *(const float4*)(stg + row * 68 + c4);
        float4 y;
        y.x = xi[it].x + g4.x * a.x;
        y.y = xi[it].y + g4.y * a.y;
        y.z = xi[it].z + g4.z * a.z;
        y.w = xi[it].w + g4.w * a.w;
        *(float4*)(X + (size_t)t * 1024 + n) = y;
        float ss = y.x * y.x + y.y * y.y + y.z * y.z + y.w * y.w;
        ss += __shfl_xor(ss, 1); ss += __shfl_xor(ss, 2); ss += __shfl_xor(ss, 4); ss += __shfl_xor(ss, 8);
        if ((lane & 15) == 0) SSX[(size_t)t * 16 + (nbase >> 6)] = ss;
        if (has_next) st_bf4(ACT + tl_idx(t, n), y.x * nsc.x, y.y * nsc.y, y.z * nsc.z, y.w * nsc.w);
      }
      asm volatile("s_waitcnt lgkmcnt(0)" ::: "memory");
      if (j + 1 < TJ) {
#pragma unroll
        for (int it = 0; it < 8; it++) xi[it] = xn[it];
      }
    }
  } else {
    const float* bias = (const float*)(p.ws + OFF_BIAS2) + (size_t)(l * 8 + b) * 5632;
    const float* SSX = (const float*)(p.ws + OFF_SSX);
    u16* HID = (u16*)(p.ws + OFF_HID);
    const int jbase = nbase >> 1;
#pragma unroll
    for (int j = 0; j < TJ; j++) {
      const int t = tok[j];
      const float rv = row_rinv16(SSX, t, 1.f / 1024.f);
#pragma unroll
      for (int q4 = 0; q4 < 4; q4++) {
        const int ng = nbase + 8 * q4 + 4 * hf;
        float4 bg4 = *(const float4*)(bias + ng);
        float4 bu4 = *(const float4*)(bias + ng + 32);
        float zg0 = acc[0][j][4 * q4 + 0] * rv + bg4.x, zu0 = acc[1][j][4 * q4 + 0] * rv + bu4.x;
        float zg1 = acc[0][j][4 * q4 + 1] * rv + bg4.y, zu1 = acc[1][j][4 * q4 + 1] * rv + bu4.y;
        float zg2 = acc[0][j][4 * q4 + 2] * rv + bg4.z, zu2 = acc[1][j][4 * q4 + 2] * rv + bu4.z;
        float zg3 = acc[0][j][4 * q4 + 3] * rv + bg4.w, zu3 = acc[1][j][4 * q4 + 3] * rv + bu4.w;
        float h0 = zg0 / (1.f + __expf(-zg0)) * zu0;
        float h1 = zg1 / (1.f + __expf(-zg1)) * zu1;
        float h2 = zg2 / (1.f + __expf(-zg2)) * zu2;
        float h3 = zg3 / (1.f + __expf(-zg3)) * zu3;
        st_bf4(HID + tl_idx(t, jbase + 8 * q4 + 4 * hf), h0, h1, h2, h3);
      }
    }
  }
}

template <int EPI>
DI void gemm_phase(int l, char* smem) {
  const Params p = kparams();
  constexpr int NT = (EPI == EPI_IN) ? 5 : (EPI == EPI_GLU ? 2 : (EPI == EPI_F1 ? 22 : 4));
  const int g8 = gridDim.x >> 3;
  const int xg = blockIdx.x & 7, lb = blockIdx.x >> 3;
  uint4 ra0, ra1, ra2, ra3, rb0, rb1, rb2, rb3;
  bool first = true;
  for (int q = lb; q < 16 * NT; q += g8) {
    const int mg = q / (8 * NT);
    const int rem = q - mg * 8 * NT;
    const int qn = q + g8;
    const bool has_next = qn < 16 * NT;
    const int mgn = qn / (8 * NT);
    const int remn = qn - mgn * 8 * NT;
    gemm_tile<EPI>(p, l, xg * 16 + mg * 8 + (rem & 7), rem >> 3, smem, ra0, ra1, ra2, ra3, rb0, rb1, rb2, rb3, first, has_next,
                   xg * 16 + mgn * 8 + (remn & 7), remn >> 3);
    first = (EPI == EPI_OUT || EPI == EPI_F2);
  }
}

DI void attn_item(const Params& p, int item, char* smem) {
  u16* Ks = (u16*)smem;
  u16* Vs = Ks + 64 * 72;
  const int tid = tidx(), lane = tid & 63, wave = tid >> 6;
  const int hf = lane >> 5, li = lane & 31;
  const int xcd = item & 7, local = item >> 3;
  const int pair = xcd * 2 + (local >> 6);
  const int within = local & 63;
  const int hq = within >> 4, qb = within & 15;
  const int b = pair >> 1, kvh = pair & 1, h = kvh * 4 + hq;
  const int t = b * 4096 + qb * 256 + wave * 32 + li;

  const u16* Q = (const u16*)(p.ws + OFF_Q);
  bf16x8 qf[4];
#pragma unroll
  for (int s = 0; s < 4; s++) qf[s] = *(const bf16x8*)(Q + (size_t)t * 512 + h * 64 + 16 * s + 8 * hf);

  f32x16 o0, o1;
#pragma unroll
  for (int r = 0; r < 16; r++) { o0[r] = 0.f; o1[r] = 0.f; }
  float m_run = -1e30f, l_run = 0.f;

  const int lrow = tid >> 3, lc8 = tid & 7;
  const u16* Kg = (const u16*)(p.ws + OFF_K) + (size_t)pair * 4096 * 64 + (size_t)lrow * 64 + lc8 * 8;
  const u16* Vg = (const u16*)(p.ws + OFF_VT) + (size_t)pair * 64 * 4096 + (size_t)lrow * 4096 + lc8 * 8;
  uint4 rk0, rv0;
#define ATT_GLOAD(kt_)                                                   \
  {                                                                      \
    rk0 = *(const uint4*)(Kg + (size_t)((kt_) * 64) * 64);               \
    rv0 = *(const uint4*)(Vg + (kt_) * 64);                              \
  }
  ATT_GLOAD(0);
  const int kap = (li & 0x13) | ((li & 4) << 1) | ((li & 8) >> 1);

  for (int kt = 0; kt < 64; kt++) {
    __syncthreads();
    *(uint4*)(Ks + (lrow) * 72 + lc8 * 8) = rk0;
    *(uint4*)(Vs + (lrow) * 72 + lc8 * 8) = rv0;
    __syncthreads();
    if (kt + 1 < 64) ATT_GLOAD(kt + 1);

    f32x16 s0, s1;
#pragma unroll
    for (int r = 0; r < 16; r++) { s0[r] = 0.f; s1[r] = 0.f; }
#pragma unroll
    for (int s = 0; s < 4; s++) {
      bf16x8 kf0 = *(const bf16x8*)(Ks + kap * 72 + 16 * s + 8 * hf);
      bf16x8 kf1 = *(const bf16x8*)(Ks + (32 + kap) * 72 + 16 * s + 8 * hf);
      s0 = MFMA(kf0, qf[s], s0);
      s1 = MFMA(kf1, qf[s], s1);
    }
    float mx = s0[0];
#pragma unroll
    for (int r = 1; r < 16; r++) mx = fmaxf(mx, s0[r]);
#pragma unroll
    for (int r = 0; r < 16; r++) mx = fmaxf(mx, s1[r]);
    mx = fmaxf(mx, __shfl_xor(mx, 32));
    const float mnew = fmaxf(m_run, mx);
    const float alpha = __builtin_amdgcn_exp2f(m_run - mnew);
    m_run = mnew;
    float ps = 0.f;
#pragma unroll
    for (int r = 0; r < 16; r++) { s0[r] = __builtin_amdgcn_exp2f(s0[r] - mnew); ps += s0[r]; }
#pragma unroll
    for (int r = 0; r < 16; r++) { s1[r] = __builtin_amdgcn_exp2f(s1[r] - mnew); ps += s1[r]; }
    l_run = l_run * alpha + ps;
#pragma unroll
    for (int r = 0; r < 16; r++) { o0[r] *= alpha; o1[r] *= alpha; }
#pragma unroll
    for (int sp = 0; sp < 2; sp++) {
      bf16x8 pb;
      {
        unsigned u0 = pk(s0[8 * sp + 0], s0[8 * sp + 1]), u1 = pk(s0[8 * sp + 2], s0[8 * sp + 3]);
        unsigned u2 = pk(s0[8 * sp + 4], s0[8 * sp + 5]), u3 = pk(s0[8 * sp + 6], s0[8 * sp + 7]);
        uint4 uu = make_uint4(u0, u1, u2, u3);
        pb = __builtin_bit_cast(bf16x8, uu);
      }
      bf16x8 vf0 = *(const bf16x8*)(Vs + li * 72 + 16 * sp + 8 * hf);
      bf16x8 vf1 = *(const bf16x8*)(Vs + (32 + li) * 72 + 16 * sp + 8 * hf);
      o0 = MFMA(vf0, pb, o0);
      o1 = MFMA(vf1, pb, o1);
    }
#pragma unroll
    for (int sp = 0; sp < 2; sp++) {
      bf16x8 pb;
      {
        unsigned u0 = pk(s1[8 * sp + 0], s1[8 * sp + 1]), u1 = pk(s1[8 * sp + 2], s1[8 * sp + 3]);
        unsigned u2 = pk(s1[8 * sp + 4], s1[8 * sp + 5]), u3 = pk(s1[8 * sp + 6], s1[8 * sp + 7]);
        uint4 uu = make_uint4(u0, u1, u2, u3);
        pb = __builtin_bit_cast(bf16x8, uu);
      }
      bf16x8 vf0 = *(const bf16x8*)(Vs + li * 72 + 32 + 16 * sp + 8 * hf);
      bf16x8 vf1 = *(const bf16x8*)(Vs + (32 + li) * 72 + 32 + 16 * sp + 8 * hf);
      o0 = MFMA(vf0, pb, o0);
      o1 = MFMA(vf1, pb, o1);
    }
  }
  const float ltot = l_run + __shfl_xor(l_run, 32);
  const float inv = 1.f / ltot;
  u16* OATT = (u16*)(p.ws + OFF_OATT);
  float ss = 0.f;
#pragma unroll
  for (int q4 = 0; q4 < 4; q4++) {
    float a0 = o0[4 * q4 + 0] * inv, a1 = o0[4 * q4 + 1] * inv, a2 = o0[4 * q4 + 2] * inv, a3 = o0[4 * q4 + 3] * inv;
    float c0 = o1[4 * q4 + 0] * inv, c1 = o1[4 * q4 + 1] * inv, c2 = o1[4 * q4 + 2] * inv, c3 = o1[4 * q4 + 3] * inv;
    ss += a0 * a0 + a1 * a1 + a2 * a2 + a3 * a3 + c0 * c0 + c1 * c1 + c2 * c2 + c3 * c3;
    st_bf4(OATT + tl_idx(t, h * 64 + 8 * q4 + 4 * hf), a0, a1, a2, a3);
    st_bf4(OATT + tl_idx(t, h * 64 + 32 + 8 * q4 + 4 * hf), c0, c1, c2, c3);
  }
  ss += __shfl_xor(ss, 32);
  if (hf == 0) ((float*)(p.ws + OFF_SSA))[(size_t)t * 8 + h] = ss;
}

DI bf16x8 ssm_ufrag(const u16* U2, int bp, int g, int tb, int li, int hf) {
  const int seq = (li >> 2) & 1, step = ((li >> 3) << 2) | (li & 3);
  return *(const bf16x8*)(U2 + (((size_t)((2 * bp + seq) * 32 + g)) * 4096 + tb + step) * 16 + 8 * hf);
}

DI void ssm_scan16(const f32x16& x0, const f32x16& x1, const f32x16& x2, const f32x16& x3, const float4 a0, const float4 a1,
                   float& h0r, float& h0i, float& h1r, float& h1i, const int dir) {
  if (dir == 0) {
#pragma unroll
    for (int r = 0; r < 16; r++) {
      float nr = a0.x * h0r - a0.y * h0i + x0[r], ni = a0.x * h0i + a0.y * h0r + x2[r];
      h0r = nr; h0i = ni;
      float mr = a1.x * h1r - a1.y * h1i + x1[r], mi = a1.x * h1i + a1.y * h1r + x3[r];
      h1r = mr; h1i = mi;
    }
  } else {
#pragma unroll
    for (int r = 15; r >= 0; r--) {
      float nr = a0.x * h0r - a0.y * h0i + x0[r], ni = a0.x * h0i + a0.y * h0r + x2[r];
      h0r = nr; h0i = ni;
      float mr = a1.x * h1r - a1.y * h1i + x1[r], mi = a1.x * h1i + a1.y * h1r + x3[r];
      h1r = mr; h1i = mi;
    }
  }
}

DI void ssm1_item(const Params& p, int l, int item) {
  const int tid = vtid(), lane = tid & 63, wave = __builtin_amdgcn_readfirstlane(tid >> 6);
  const int hf = lane >> 5, li = lane & 31;
  const int w = item * 4 + wave;
  const int ch = w & 15, bp = (w >> 4) & 3, g = (w >> 6) & 31, dir = w >> 11;
  const int idx = (l * 2 + dir) * 32 + g;
  const u16* U2 = (const u16*)(p.ws + OFF_U2);
  const u16* BB = (const u16*)(p.ws + OFF_SSMBB) + (size_t)idx * 128 * 16;
  const float* SA = (const float*)(p.ws + OFF_SSMA) + (size_t)idx * 64 * 4;
  bf16x8 bbf[4];
#pragma unroll
  for (int j = 0; j < 4; j++) bbf[j] = *(const bf16x8*)(BB + (32 * j + li) * 16 + 8 * hf);
  const float4 a0 = *(const float4*)(SA + li * 4);
  const float4 a1 = *(const float4*)(SA + (li + 32) * 4);
  float h0r = 0.f, h0i = 0.f, h1r = 0.f, h1i = 0.f;
  f32x16 zero;
#pragma unroll
  for (int r = 0; r < 16; r++) zero[r] = 0.f;
#define SSM_TB(it_) (ch * 256 + (dir ? (15 - (it_)) : (it_)) * 16)
  bf16x8 q0 = ssm_ufrag(U2, bp, g, SSM_TB(0), li, hf), q1 = ssm_ufrag(U2, bp, g, SSM_TB(1), li, hf);
  bf16x8 q2 = ssm_ufrag(U2, bp, g, SSM_TB(2), li, hf), q3 = ssm_ufrag(U2, bp, g, SSM_TB(3), li, hf);
#pragma unroll 1
  for (int it = 0; it < 16; it++) {
    const bf16x8 uf = q0;
    q0 = q1; q1 = q2; q2 = q3;
    const int itn = (it + 4 < 16) ? (it + 4) : 15;
    q3 = ssm_ufrag(U2, bp, g, SSM_TB(itn), li, hf);
    f32x16 x0 = MFMA(uf, bbf[0], zero), x1 = MFMA(uf, bbf[1], zero), x2 = MFMA(uf, bbf[2], zero), x3 = MFMA(uf, bbf[3], zero);
    ssm_scan16(x0, x1, x2, x3, a0, a1, h0r, h0i, h1r, h1i, dir);
  }
  float* E = (float*)(p.ws + OFF_E) + ((((size_t)(dir * 32 + g) * 8 + (2 * bp + hf)) * 16 + ch) * 64) * 2;
  *(float2*)(E + li * 2) = make_float2(h0r, h0i);
  *(float2*)(E + (li + 32) * 2) = make_float2(h1r, h1i);
}

DI void ssm2_item(const Params& p, int l, int item, char* smem) {
  const int tid = vtid(), lane = tid & 63, wave = __builtin_amdgcn_readfirstlane(tid >> 6);
  const int hf = lane >> 5, li = lane & 31;
  const int w = item * 4 + wave;
  const int ch = w & 15, bp = (w >> 4) & 3, g = w >> 6;
  u16* Hs = (u16*)smem + wave * (32 * 136);
  const u16* U2 = (const u16*)(p.ws + OFF_U2);
  float* YF = (float*)(p.ws + OFF_ACT);
  u16* YG = (u16*)(p.ws + OFF_YG);
  f32x16 zero;
#pragma unroll
  for (int r = 0; r < 16; r++) zero[r] = 0.f;
  const int oseq = li >> 4, ostep = li & 15;
  const int ob = 2 * bp + oseq;

  for (int dir = 0; dir < 2; dir++) {
    const int idx = (l * 2 + dir) * 32 + g;
    const u16* BB = (const u16*)(p.ws + OFF_SSMBB) + (size_t)idx * 128 * 16;
    const u16* CC = (const u16*)(p.ws + OFF_SSMCC) + (size_t)idx * 16 * 128;
    const float* SA = (const float*)(p.ws + OFF_SSMA) + (size_t)idx * 64 * 4;
    bf16x8 bbf[4], ccf[8];
#pragma unroll
    for (int j = 0; j < 4; j++) bbf[j] = *(const bf16x8*)(BB + (32 * j + li) * 16 + 8 * hf);
#pragma unroll
    for (int s = 0; s < 8; s++) {
      bf16x8 v = *(const bf16x8*)(CC + (li & 15) * 128 + 16 * s + 8 * hf);
      if (li >= 16) {
#pragma unroll
        for (int e = 0; e < 8; e++) v[e] = 0;
      }
      ccf[s] = v;
    }
    const float4 a0 = *(const float4*)(SA + li * 4);
    const float4 a1 = *(const float4*)(SA + (li + 32) * 4);
    float h0r = 0.f, h0i = 0.f, h1r = 0.f, h1i = 0.f;
    {
      const float* E = (const float*)(p.ws + OFF_E) + ((((size_t)(dir * 32 + g) * 8 + (2 * bp + hf)) * 16) * 64) * 2;
      const int n = dir ? (15 - ch) : ch;
      for (int i0 = 0; i0 < n; i0 += 4) {
        float2 e0[4], e1[4];
#pragma unroll
        for (int u = 0; u < 4; u++) {
          int ii = i0 + u; if (ii > n - 1) ii = n - 1;
          const int ci = dir ? (15 - ii) : ii;
          e0[u] = *(const float2*)(E + (size_t)ci * 128 + li * 2);
          e1[u] = *(const float2*)(E + (size_t)ci * 128 + (li + 32) * 2);
        }
#pragma unroll
        for (int u = 0; u < 4; u++) {
          if (i0 + u < n) {
            float nr = a0.z * h0r - a0.w * h0i + e0[u].x, ni = a0.z * h0i + a0.w * h0r + e0[u].y;
            h0r = nr; h0i = ni;
            float mr = a1.z * h1r - a1.w * h1i + e1[u].x, mi = a1.z * h1i + a1.w * h1r + e1[u].y;
            h1r = mr; h1i = mi;
          }
        }
      }
    }
    bf16x8 ufn = ssm_ufrag(U2, bp, g, ch * 256 + (dir ? 15 : 0) * 16, li, hf);
    for (int it = 0; it < 16; it++) {
      const int tb = ch * 256 + (dir ? (15 - it) : it) * 16;
      const bf16x8 uf = ufn;
      f32x16 x0 = MFMA(uf, bbf[0], zero), x1 = MFMA(uf, bbf[1], zero), x2 = MFMA(uf, bbf[2], zero), x3 = MFMA(uf, bbf[3], zero);
      if (it + 1 < 16) ufn = ssm_ufrag(U2, bp, g, ch * 256 + (dir ? (14 - it) : (it + 1)) * 16, li, hf);
      const int tt = tb + ostep;
      const size_t yoff = (((size_t)(ob * 32 + g)) * 4096 + tt) * 16;
      float4 f0 = make_float4(0.f, 0.f, 0.f, 0.f), f1 = f0, u0 = f0, u1 = f0;
      if (dir) {
        f0 = *(const float4*)(YF + yoff + 4 * hf);
        f1 = *(const float4*)(YF + yoff + 8 + 4 * hf);
        u0 = ld_bf4(U2 + yoff + 4 * hf);
        u1 = ld_bf4(U2 + yoff + 8 + 4 * hf);
      }
      asm volatile("s_waitcnt lgkmcnt(0)" ::: "memory");
      if (dir == 0) {
#pragma unroll
        for (int r = 0; r < 16; r++) {
          float nr = a0.x * h0r - a0.y * h0i + x0[r], ni = a0.x * h0i + a0.y * h0r + x2[r];
          h0r = nr; h0i = ni;
          float mr = a1.x * h1r - a1.y * h1i + x1[r], mi = a1.x * h1i + a1.y * h1r + x3[r];
          h1r = mr; h1i = mi;
          *(unsigned*)(Hs + (hf * 16 + r) * 136 + 2 * li) = pk(h0r, h0i);
          *(unsigned*)(Hs + (hf * 16 + r) * 136 + 2 * (li + 32)) = pk(h1r, h1i);
        }
      } else {
#pragma unroll
        for (int r = 15; r >= 0; r--) {
          float nr = a0.x * h0r - a0.y * h0i + x0[r], ni = a0.x * h0i + a0.y * h0r + x2[r];
          h0r = nr; h0i = ni;
          float mr = a1.x * h1r - a1.y * h1i + x1[r], mi = a1.x * h1i + a1.y * h1r + x3[r];
          h1r = mr; h1i = mi;
          *(unsigned*)(Hs + (hf * 16 + r) * 136 + 2 * li) = pk(h0r, h0i);
          *(unsigned*)(Hs + (hf * 16 + r) * 136 + 2 * (li + 32)) = pk(h1r, h1i);
        }
      }
      asm volatile("s_waitcnt lgkmcnt(0)" ::: "memory");
      f32x16 y = zero;
#pragma unroll
      for (int s = 0; s < 8; s++) {
        bf16x8 hfv = *(const bf16x8*)(Hs + li * 136 + 16 * s + 8 * hf);
        y = MFMA(ccf[s], hfv, y);
      }
      if (dir == 0) {
        *(float4*)(YF + yoff + 4 * hf) = make_float4(y[0], y[1], y[2], y[3]);
        *(float4*)(YF + yoff + 8 + 4 * hf) = make_float4(y[4], y[5], y[6], y[7]);
      } else {
        float4 d0 = *(const float4*)(p.ssm_d + l * 512 + g * 16 + 4 * hf);
        float4 d1 = *(const float4*)(p.ssm_d + l * 512 + g * 16 + 8 + 4 * hf);
        float v[8];
        v[0] = f0.x + y[0] + d0.x * u0.x; v[1] = f0.y + y[1] + d0.y * u0.y;
        v[2] = f0.z + y[2] + d0.z * u0.z; v[3] = f0.w + y[3] + d0.w * u0.w;
        v[4] = f1.x + y[4] + d1.x * u1.x; v[5] = f1.y + y[5] + d1.y * u1.y;
        v[6] = f1.z + y[6] + d1.z * u1.z; v[7] = f1.w + y[7] + d1.w * u1.w;
#pragma unroll
        for (int e = 0; e < 8; e++) {
          float xx = v[e];
          float z = 0.7978845608028654f * (xx + 0.044715f * xx * xx * xx);
          float th = 1.f - 2.f / (__expf(2.f * z) + 1.f);
          v[e] = 0.5f * xx * (1.f + th);
        }
        u16* yg = YG + tl_idx(ob * 4096 + tt, g * 16);
        st_bf4(yg + 4 * hf, v[0], v[1], v[2], v[3]);
        st_bf4(yg + 8 + 4 * hf, v[4], v[5], v[6], v[7]);
      }
    }
    asm volatile("s_waitcnt lgkmcnt(0)" ::: "memory");
  }
}

DI void qkpost_phase(int l) {
  const Params p = kparams();
  const float* ROPE = (const float*)(p.ws + OFF_ROPE);
  const int nrows = T_TOK * 8 + T_TOK * 2;
  for (int r = blockIdx.x * 512 + tidx(); r < nrows; r += gridDim.x * 512) {
    const bool isq = r < T_TOK * 8;
    const int rk = r - T_TOK * 8;
    u16* row = isq ? ((u16*)(p.ws + OFF_Q) + (size_t)r * 64) : ((u16*)(p.ws + OFF_K) + (size_t)rk * 64);
    const int pos = isq ? ((r >> 3) & 4095) : (rk & 4095);
    const float* gn = isq ? (p.q_norm + l * 64) : (p.k_norm + l * 64);
    const float osc = isq ? QSCALE : 1.f;
    float v[64];
#pragma unroll
    for (int c = 0; c < 8; c++) {
      uint4 raw = ((const uint4*)row)[c];
      v[8 * c + 0] = __uint_as_float(raw.x << 16); v[8 * c + 1] = __uint_as_float(raw.x & 0xffff0000u);
      v[8 * c + 2] = __uint_as_float(raw.y << 16); v[8 * c + 3] = __uint_as_float(raw.y & 0xffff0000u);
      v[8 * c + 4] = __uint_as_float(raw.z << 16); v[8 * c + 5] = __uint_as_float(raw.z & 0xffff0000u);
      v[8 * c + 6] = __uint_as_float(raw.w << 16); v[8 * c + 7] = __uint_as_float(raw.w & 0xffff0000u);
    }
    float ss = 0.f;
#pragma unroll
    for (int e = 0; e < 64; e++) ss += v[e] * v[e];
    const float rn = rsqrtf(ss * (1.f / 64.f) + 1e-6f) * osc;
    const int irow = pos >> 6, icol = pos & 63;
    float tc[32], ts[32];
#pragma unroll
    for (int q = 0; q < 4; q++) {
      const float4 c0 = *(const float4*)(ROPE + irow * 16 + 4 * q), s0 = *(const float4*)(ROPE + 1024 + irow * 16 + 4 * q);
      const float4 c1 = *(const float4*)(ROPE + icol * 16 + 4 * q), s1 = *(const float4*)(ROPE + 1024 + icol * 16 + 4 * q);
      tc[4 * q + 0] = c0.x; tc[4 * q + 1] = c0.y; tc[4 * q + 2] = c0.z; tc[4 * q + 3] = c0.w;
      ts[4 * q + 0] = s0.x; ts[4 * q + 1] = s0.y; ts[4 * q + 2] = s0.z; ts[4 * q + 3] = s0.w;
      tc[16 + 4 * q + 0] = c1.x; tc[16 + 4 * q + 1] = c1.y; tc[16 + 4 * q + 2] = c1.z; tc[16 + 4 * q + 3] = c1.w;
      ts[16 + 4 * q + 0] = s1.x; ts[16 + 4 * q + 1] = s1.y; ts[16 + 4 * q + 2] = s1.z; ts[16 + 4 * q + 3] = s1.w;
    }
#pragma unroll
    for (int c = 0; c < 8; c++) {
      float o[8];
#pragma unroll
      for (int e = 0; e < 4; e++) {
        const int pi = 4 * c + e;
        const float cs = tc[pi], sn = ts[pi];
        const float y0 = v[2 * pi] * rn * gn[2 * pi], y1 = v[2 * pi + 1] * rn * gn[2 * pi + 1];
        o[2 * e] = y0 * cs - y1 * sn;
        o[2 * e + 1] = y0 * sn + y1 * cs;
      }
      uint4 w;
      w.x = pk(o[0], o[1]); w.y = pk(o[2], o[3]); w.z = pk(o[4], o[5]); w.w = pk(o[6], o[7]);
      ((uint4*)row)[c] = w;
    }
  }
}

DI void attn_phase(char* smem) {
  const Params p = kparams();
  for (int lq = blockIdx.x >> 3; lq < 128; lq += (gridDim.x >> 3)) attn_item(p, (blockIdx.x & 7) + 8 * lq, smem);
}
DI void ssm1_phase(int l) {
  const Params p = kparams();
  for (int it = blockIdx.x * 2 + vhalf(); it < 1024; it += gridDim.x * 2) ssm1_item(p, l, it);
}
DI void ssm2_phase(int l, char* smem) {
  const Params p = kparams();
  char* sm = smem + vhalf() * 40960;
  for (int it = blockIdx.x * 2 + vhalf(); it < 512; it += gridDim.x * 2) ssm2_item(p, l, it, sm);
}

DI void final_phase() {
  const Params p = kparams();
  const float* X = (const float*)(p.ws + OFF_X);
  const float* SSX = (const float*)(p.ws + OFF_SSX);
  const int total = T_TOK * 256;
  for (int i = blockIdx.x * 512 + tidx(); i < total; i += gridDim.x * 512) {
    int t = i >> 8, n = (i & 255) * 4;
    float rv = row_rinv16(SSX, t, 1.f / 1024.f);
    float4 x = *(const float4*)(X + (size_t)t * 1024 + n);
    float4 g = *(const float4*)(p.final_norm + n);
    float4 o;
    o.x = x.x * rv * g.x; o.y = x.y * rv * g.y; o.z = x.z * rv * g.z; o.w = x.w * rv * g.w;
    *(float4*)(p.out + (size_t)t * 1024 + n) = o;
  }
}

#define XB_TMO      128
#define XB_XCNT(j)  (256  + 64 * (j))
#define XB_XSUB(j)  (1280 + 64 * (j))
#define XB_XGEN(j)  (2304 + 64 * (j))
#define XB_TOP      3328
#define XB_TOPGEN   3392
#define XCD_BAR_WORDS 3456
#define XB_SPIN_CAP (1u << 18)
#define LAS __attribute__((address_space(3)))

__device__ __forceinline__ unsigned xb_ld(unsigned* p)              { return __hip_atomic_load(p, __ATOMIC_RELAXED, __HIP_MEMORY_SCOPE_AGENT); }
__device__ __forceinline__ unsigned xb_add(unsigned* p, unsigned v) { return __hip_atomic_fetch_add(p, v, __ATOMIC_RELAXED, __HIP_MEMORY_SCOPE_AGENT); }
__device__ __forceinline__ unsigned xb_xcc_id() { return (unsigned)__builtin_amdgcn_s_getreg((3 << 11) | 20) & 0xFu; }
#define XB_SPIN(cond, bar) do { unsigned _sp = 0; while (cond) { __builtin_amdgcn_s_sleep(1); \
    if ((++_sp & 255u) == 0u) { if (xb_ld(&(bar)[XB_TMO])) break; if (_sp > XB_SPIN_CAP) { atomicAdd(&(bar)[XB_TMO], 1u); break; } } } } while (0)

struct XcdBarrier {
    unsigned* bar; unsigned x;
    volatile LAS unsigned* st;
};

__device__ __forceinline__ XcdBarrier xcd_barrier_post(unsigned* bar, volatile LAS unsigned* st) {
    XcdBarrier b; b.bar = bar; b.x = xb_xcc_id(); b.st = st;
    if (threadIdx.x == 0) (void)xb_add(&bar[XB_XCNT(b.x)], 1u);
    return b;
}
__device__ __forceinline__ void xcd_barrier_complete(unsigned* bar, unsigned x, unsigned& nloc, unsigned& nx) {
    const unsigned G = gridDim.x * gridDim.y * gridDim.z;
    unsigned sum, cnt, mine, sp = 0u;
    for (;;) {
        sum = 0u; cnt = 0u; mine = 0u;
#pragma unroll
        for (unsigned j = 0; j < 16; ++j) { const unsigned c = xb_ld(&bar[XB_XCNT(j)]); sum += c; cnt += (c > 0u) ? 1u : 0u; mine = (j == x) ? c : mine; }
        if (sum == G) break;
        __builtin_amdgcn_s_sleep(1);
        if ((++sp & 255u) == 0u) { if (xb_ld(&bar[XB_TMO])) break; if (sp > XB_SPIN_CAP) { atomicAdd(&bar[XB_TMO], 1u); break; } }
    }
    nloc = mine > 0u ? mine : 1u; nx = cnt > 0u ? cnt : 1u;
}

__device__ __forceinline__ void xcd_barrier(const XcdBarrier& b) {
    asm volatile("s_waitcnt vmcnt(0)" ::: "memory");
    __syncthreads();
    if (threadIdx.x == 0) {
        unsigned* bar = b.bar;
        __builtin_amdgcn_s_waitcnt(0);
        unsigned nloc = b.st[0], nx = b.st[1];
        if (nloc == 0u) { xcd_barrier_complete(bar, b.x, nloc, nx); b.st[0] = nloc; b.st[1] = nx; }
        const unsigned old = xb_add(&bar[XB_XSUB(b.x)], 1u);
        const unsigned gen = old / nloc;
        if (old + 1u == (gen + 1u) * nloc) {
            __builtin_amdgcn_fence(__ATOMIC_RELEASE, "agent");
            asm volatile("s_waitcnt vmcnt(0)" ::: "memory");
            const unsigned og = xb_add(&bar[XB_TOP], 1u);
            const unsigned tg = og / nx;
            if (og + 1u == (tg + 1u) * nx) xb_add(&bar[XB_TOPGEN], 1u);
            else XB_SPIN(xb_ld(&bar[XB_TOPGEN]) == tg, bar);
            __builtin_amdgcn_fence(__ATOMIC_ACQUIRE, "agent");
            xb_add(&bar[XB_XGEN(b.x)], 1u);
            asm volatile("s_waitcnt vmcnt(0)" ::: "memory");
        } else {
            XB_SPIN(xb_ld(&bar[XB_XGEN(b.x)]) == gen, bar);
            __builtin_amdgcn_fence(__ATOMIC_ACQUIRE, "agent");
            asm volatile("s_waitcnt vmcnt(0)" ::: "memory");
        }
    }
    __syncthreads();
}
#define GSYNC() xcd_barrier(xbar)

__global__ void __launch_bounds__(512) mega(Params p_) {
  __shared__ __attribute__((aligned(16))) char smem[147456];
  cg::grid_group grid = cg::this_grid();
  __shared__ __attribute__((aligned(16))) unsigned xb_words[4];
  if (tidx() < 4) xb_words[tidx()] = 0u;
  __syncthreads();
  if (p_.ph_lo < 0) grid.sync();
  const XcdBarrier xbar = xcd_barrier_post((unsigned*)(p_.ws + OFF_BAR), (volatile LAS unsigned*)xb_words);
  int ph = p_.ph_lo;
  const int ph_hi = p_.ph_hi;
  if (ph == 0 && ph < ph_hi) {
    phase0(smem);
    ph++;
    if (ph < ph_hi) GSYNC();
  }
  if (ph == 1 && ph < ph_hi) {
    phase1(smem);
    ph++;
    if (ph < ph_hi) GSYNC();
  }
  for (; ph < ph_hi && ph < NPHASE - 1; ph++) {
    const int l = (ph - 2) / 7, k = (ph - 2) % 7;
    if (k == 0) gemm_phase<EPI_IN>(l, smem);
    else if (k == 1) { qkpost_phase(l); ssm1_phase(l); }
    else if (k == 2) {
      const int first = (blockIdx.x >> 3) & 1;
      for (int s2 = 0; s2 < 2; s2++) {
        __syncthreads();
        if ((s2 ^ first) == 0) attn_phase(smem);
        else ssm2_phase(l, smem);
      }
    }
    else if (k == 3) gemm_phase<EPI_GLU>(l, smem);
    else if (k == 4) gemm_phase<EPI_OUT>(l, smem);
    else if (k == 5) gemm_phase<EPI_F1>(l, smem);
    else gemm_phase<EPI_F2>(l, smem);
    if (ph + 1 < ph_hi) GSYNC();
  }
  if (ph == NPHASE - 1 && ph < ph_hi) final_phase();
}

extern "C" void kernel_launch(void* const* d_in, const int* in_sizes, int n_in, void* d_out, int out_size, void* d_ws,
                              size_t ws_size, hipStream_t stream) {
  static int grid_blocks = 0;
  if (!grid_blocks) {
    int dev = 0, cus = 0;
    (void)hipGetDevice(&dev);
    (void)hipDeviceGetAttribute(&cus, hipDeviceAttributeMultiprocessorCount, dev);
    grid_blocks = cus;
    if (grid_blocks < 8 || (grid_blocks & 7)) grid_blocks = 256;
    if (ws_size < WS_TOTAL) fprintf(stderr, "kernel_launch: workspace too small: %zu < %zu\n", ws_size, (size_t)WS_TOTAL);
  }
  if (ws_size < WS_TOTAL) return;
  Params p{};
  const float** pp = (const float**)&p;
  for (int i = 0; i < 25; i++) pp[i] = (const float*)d_in[i];
  p.out = (float*)d_out;
  p.ws = (char*)d_ws;
  p.ph_lo = 0;
  p.ph_hi = NPHASE;
  (void)hipMemsetAsync((char*)d_ws + OFF_BAR, 0, 16384, stream);
  void* args[] = {&p};
  hipError_t e = hipLaunchCooperativeKernel((void*)mega, dim3(grid_blocks), dim3(512), args, 0, stream);
  if (e != hipSuccess) fprintf(stderr, "cooperative launch failed: %s (grid %d)\n", hipGetErrorString(e), grid_blocks);
}
```

```cpp
#include <hip/hip_runtime.h>
#include <hip/hip_cooperative_groups.h>
#include <cstdio>
namespace cg = cooperative_groups;

typedef __attribute__((ext_vector_type(8))) short bf16x8;
typedef __attribute__((ext_vector_type(16))) float f32x16;
typedef __attribute__((ext_vector_type(2))) __bf16 bf2v;
typedef __attribute__((ext_vector_type(2))) float f2v;
typedef unsigned short u16;

#define DI __device__ __forceinline__
#define MFMA(a, b, c) __builtin_amdgcn_mfma_f32_32x32x16_bf16((a), (b), (c), 0, 0, 0)

constexpr int T_TOK = 32768;
constexpr int NPHASE = 31;
constexpr float QSCALE = 0.125f * 1.4426950408889634f;

constexpr size_t OFF_WT_IN  = 0;
constexpr size_t OFF_WT_GLU = OFF_WT_IN + 10485760;
constexpr size_t OFF_WT_OUT = OFF_WT_GLU + 2097152;
constexpr size_t OFF_WT_F1  = OFF_WT_OUT + 8388608;
constexpr size_t OFF_WT_F2  = OFF_WT_F1 + 46137344;
constexpr size_t OFF_MOD    = OFF_WT_F2 + 23068672;
constexpr size_t OFF_BIAS1  = OFF_MOD + 786432;
constexpr size_t OFF_BIAS2  = OFF_BIAS1 + 163840;
constexpr size_t OFF_ROPE   = OFF_BIAS2 + 720896;
constexpr size_t OFF_SSMA   = OFF_ROPE + 8192;
constexpr size_t OFF_SSMBB  = OFF_SSMA + 262144;
constexpr size_t OFF_SSMCC  = OFF_SSMBB + 1048576;
constexpr size_t OFF_E      = OFF_SSMCC + 1048576;
constexpr size_t OFF_SSX    = OFF_E + 4194304;
constexpr size_t OFF_SSA    = OFF_SSX + 2097152;
constexpr size_t OFF_SSS    = OFF_SSA + 1048576;
constexpr size_t OFF_X      = OFF_SSS + 1048576;
constexpr size_t OFF_ACT    = OFF_X + 134217728;
constexpr size_t OFF_UNION  = OFF_ACT + 67108864;
constexpr size_t OFF_HID    = OFF_UNION;
constexpr size_t OFF_Q      = OFF_UNION;
constexpr size_t OFF_K      = OFF_Q + 33554432;
constexpr size_t OFF_VT     = OFF_K + 8388608;
constexpr size_t OFF_U2     = OFF_VT + 8388608;
constexpr size_t OFF_YG     = OFF_U2 + 33554432;
constexpr size_t OFF_OATT   = OFF_YG + 33554432;
constexpr size_t OFF_OSSM   = OFF_OATT + 33554432;
constexpr size_t OFF_BAR    = OFF_UNION + 184549376;
constexpr size_t WS_TOTAL   = OFF_BAR + 16384;

struct Params {
  const float *x, *c, *w_ada, *b_ada, *norm1, *w_in, *q_norm, *k_norm, *lam_re, *lam_im, *log_dt,
      *b_re, *b_im, *c_re, *c_im, *ssm_d, *w_glu, *b_glu, *attn_out_norm, *ssm_out_norm, *w_out, *norm2,
      *w_ffn_in, *w_ffn_out, *final_norm;
  float* out;
  char* ws;
  int ph_lo, ph_hi;
};

DI unsigned pk(float a, float b) {
  f2v v = {a, b};
  bf2v r = __builtin_convertvector(v, bf2v);
  return __builtin_bit_cast(unsigned, r);
}
DI int tidx() { int t = __builtin_amdgcn_workitem_id_x(); asm volatile("" : "+v"(t)); return t; }
typedef const Params __attribute__((address_space(4)))* KParamPtr;
DI Params kparams() {
#if defined(__HIP_DEVICE_COMPILE__)
  KParamPtr q = (KParamPtr)__builtin_amdgcn_kernarg_segment_ptr();
  asm volatile("" : "+s"(q));
  return *q;
#else
  return Params{};
#endif
}
DI int vtid() { return tidx() & 255; }
DI int vhalf() { return tidx() >> 8; }
DI float bf2f(unsigned short h) { return __uint_as_float(((unsigned)h) << 16); }
DI void st_bf4(u16* dst, float a, float b, float c, float d) {
  uint2 v; v.x = pk(a, b); v.y = pk(c, d);
  *(uint2*)dst = v;
}
DI float4 ld_bf4(const u16* src) {
  uint2 v = *(const uint2*)src;
  float4 r;
  r.x = __uint_as_float(v.x << 16); r.y = __uint_as_float(v.x & 0xffff0000u);
  r.z = __uint_as_float(v.y << 16); r.w = __uint_as_float(v.y & 0xffff0000u);
  return r;
}
DI float shfl_x32(float v, int hi) {
  auto r = __builtin_amdgcn_permlane32_swap(__float_as_uint(v), __float_as_uint(v), false, false);
  return __uint_as_float(hi ? r[0] : r[1]);
}
DI float row16_sum(float v) {
  v += __int_as_float(__builtin_amdgcn_update_dpp(0, __float_as_int(v), 0x121, 0xf, 0xf, false));
  v += __int_as_float(__builtin_amdgcn_update_dpp(0, __float_as_int(v), 0x122, 0xf, 0xf, false));
  v += __int_as_float(__builtin_amdgcn_update_dpp(0, __float_as_int(v), 0x124, 0xf, 0xf, false));
  v += __int_as_float(__builtin_amdgcn_update_dpp(0, __float_as_int(v), 0x128, 0xf, 0xf, false));
  return v;
}
DI float wave_sum(float v) {
  v = row16_sum(v);
  v += __int_as_float(__builtin_amdgcn_ds_swizzle(__float_as_int(v), 0x401F));
  const int hi = (tidx() >> 5) & 1;
  return v + shfl_x32(v, hi);
}
DI size_t tl_idx(int t, int n) { return ((size_t)(n >> 6) * T_TOK + t) * 64 + (n & 63); }
DI int crow(int r, int hf) { return (r & 3) + 8 * (r >> 2) + 4 * hf; }
DI int f1perm(int n) {
  int j = (n < 2816) ? n : n - 2816;
  return (j >> 5) * 64 + (j & 31) + ((n < 2816) ? 0 : 32);
}

DI void transpose_tile(const float* __restrict__ src, int N, u16* __restrict__ dst, int K, int k0, int n0,
                       int permmode, const float* __restrict__ kscale, float* tl) {
  const int tid = vtid();
  __syncthreads();
#pragma unroll 4
  for (int i = 0; i < 16; i++) {
    int r = (tid >> 6) + 4 * i;
    float v = src[(size_t)(k0 + r) * N + n0 + (tid & 63)];
    if (kscale) v *= kscale[k0 + r];
    tl[r * 65 + (tid & 63)] = v;
  }
  __syncthreads();
#pragma unroll 4
  for (int i = 0; i < 8; i++) {
    int n = (tid >> 5) + 8 * i;
    int kp = tid & 31;
    float a = tl[(2 * kp) * 65 + n], b = tl[(2 * kp + 1) * 65 + n];
    int nn = n0 + n;
    int no = permmode ? f1perm(nn) : nn;
    *(unsigned*)(dst + ((size_t)(k0 >> 6) * N + no) * 64 + 2 * kp) = pk(a, b);
  }
}

DI void gemv8_item(const float* vec, int vstride, bool do_silu, const float* __restrict__ W, int N, int j0,
                   const float* bias, float* out, int ostride, int permmode, float* sm) {
  const int tid = vtid();
  float* vs = sm;
  float* red = sm + 8192;
  __syncthreads();
  for (int i = tid; i < 8192; i += 256) {
    int b = i >> 10, k = i & 1023;
    float v = vec[(size_t)b * vstride + k];
    if (do_silu) v = v / (1.f + expf(-v));
    vs[i] = v;
  }
  __syncthreads();
  const int kq = tid >> 6, jj = tid & 63;
  float acc[8];
#pragma unroll
  for (int b = 0; b < 8; b++) acc[b] = 0.f;
#pragma unroll 4
  for (int k = kq * 256; k < kq * 256 + 256; k++) {
    float w = W[(size_t)k * N + j0 + jj];
#pragma unroll
    for (int b = 0; b < 8; b++) acc[b] += vs[b * 1024 + k] * w;
  }
#pragma unroll
  for (int b = 0; b < 8; b++) red[(kq * 8 + b) * 64 + jj] = acc[b];
  __syncthreads();
  for (int o = tid; o < 512; o += 256) {
    int b = o >> 6, j = o & 63;
    float s = red[(0 * 8 + b) * 64 + j] + red[(8 + b) * 64 + j] + red[(16 + b) * 64 + j] + red[(24 + b) * 64 + j];
    int jg = j0 + j;
    if (bias) s += bias[jg];
    int jo = permmode ? f1perm(jg) : jg;
    out[(size_t)b * ostride + jo] = s;
  }
}

DI void ssm_param_item(const Params& p, int idx) {
  const int tid = vtid();
  const int pp = tid & 63, cq = tid >> 6;
  float* SSMA = (float*)(p.ws + OFF_SSMA);
  u16* BB = (u16*)(p.ws + OFF_SSMBB);
  u16* CC = (u16*)(p.ws + OFF_SSMCC);
  double lr = (double)p.lam_re[idx * 64 + pp];
  if (lr > -1e-4) lr = (double)(-1e-4f);
  double li = (double)p.lam_im[idx * 64 + pp];
  double dt = exp((double)p.log_dt[idx]);
  double mag = exp(lr * dt);
  double ar = mag * cos(li * dt), ai = mag * sin(li * dt);
  double den = lr * lr + li * li;
  double nre = ar - 1.0;
  double kre = (nre * lr + ai * li) / den;
  double kim = (ai * lr - nre * li) / den;
  if (cq == 0) {
    double magL = exp(lr * dt * 256.0);
    float4 v;
    v.x = (float)ar; v.y = (float)ai;
    v.z = (float)(magL * cos(li * dt * 256.0)); v.w = (float)(magL * sin(li * dt * 256.0));
    *(float4*)(SSMA + (size_t)(idx * 64 + pp) * 4) = v;
  }
#pragma unroll
  for (int cc = 0; cc < 4; cc++) {
    int c = cq * 4 + cc;
    double br = (double)p.b_re[(size_t)(idx * 64 + pp) * 16 + c];
    double bi = (double)p.b_im[(size_t)(idx * 64 + pp) * 16 + c];
    float bbr = (float)(kre * br - kim * bi);
    float bbi = (float)(kre * bi + kim * br);
    BB[(size_t)(idx * 128 + pp) * 16 + c] = (u16)(pk(bbr, 0.f) & 0xffffu);
    BB[(size_t)(idx * 128 + 64 + pp) * 16 + c] = (u16)(pk(bbi, 0.f) & 0xffffu);
    float cr = p.c_re[(size_t)(idx * 16 + c) * 64 + pp];
    float ci = p.c_im[(size_t)(idx * 16 + c) * 64 + pp];
    *(unsigned*)(CC + (size_t)(idx * 16 + c) * 128 + 2 * pp) = pk(cr, -ci);
  }
}

DI void phase0(char* smem) {
  const Params p = kparams();
  float* sm = (float*)(smem + vhalf() * 40960);
  constexpr int N_TIN = 4 * 16 * 20, N_TGLU = 4 * 8 * 8, N_TOUT = 4 * 16 * 16, N_TF1 = 4 * 16 * 88, N_TF2 = 4 * 44 * 16;
  constexpr int N_MOD = 4 * 96, N_SSM = 256, N_ROPE = 1;
  constexpr int S0 = N_MOD, S1 = S0 + N_TIN, S2 = S1 + N_TGLU, S3 = S2 + N_TOUT, S4 = S3 + N_TF1, S5 = S4 + N_TF2,
                S6 = S5 + N_SSM, S7 = S6 + N_ROPE;
  for (int it = blockIdx.x * 2 + vhalf(); it < S7 + 1; it += gridDim.x * 2) {
    if (it < S0) {
      int l = it / 96, jb = it % 96;
      gemv8_item(p.c, 1024, true, p.w_ada + (size_t)l * 1024 * 6144, 6144, jb * 64, p.b_ada + l * 6144,
                 (float*)(p.ws + OFF_MOD) + (size_t)l * 8 * 6144, 6144, 0, sm);
    } else if (it < S1) {
      int r = it - S0; int l = r / 320; r %= 320; int kt = r / 20, ntile = r % 20;
      transpose_tile(p.w_in + (size_t)l * 1024 * 1280, 1280, (u16*)(p.ws + OFF_WT_IN) + (size_t)l * 1280 * 1024, 1024,
                     kt * 64, ntile * 64, 0, nullptr, sm);
    } else if (it < S2) {
      int r = it - S1; int l = r / 64; r %= 64; int kt = r / 8, ntile = r % 8;
      transpose_tile(p.w_glu + (size_t)l * 512 * 512, 512, (u16*)(p.ws + OFF_WT_GLU) + (size_t)l * 512 * 512, 512,
                     kt * 64, ntile * 64, 0, nullptr, sm);
    } else if (it < S3) {
      int r = it - S2; int l = r / 256; r %= 256; int kt = r / 16, ntile = r % 16;
      const float* ks = (kt < 8) ? (p.attn_out_norm + l * 512) : (p.ssm_out_norm + l * 512 - 512);
      transpose_tile(p.w_out + (size_t)l * 1024 * 1024, 1024, (u16*)(p.ws + OFF_WT_OUT) + (size_t)l * 1024 * 1024, 1024,
                     kt * 64, ntile * 64, 0, ks, sm);
    } else if (it < S4) {
      int r = it - S3; int l = r / 1408; r %= 1408; int kt = r / 88, ntile = r % 88;
      transpose_tile(p.w_ffn_in + (size_t)l * 1024 * 5632, 5632, (u16*)(p.ws + OFF_WT_F1) + (size_t)l * 5632 * 1024, 1024,
                     kt * 64, ntile * 64, 1, nullptr, sm);
    } else if (it < S5) {
      int r = it - S4; int l = r / 704; r %= 704; int kt = r / 16, ntile = r % 16;
      transpose_tile(p.w_ffn_out + (size_t)l * 2816 * 1024, 1024, (u16*)(p.ws + OFF_WT_F2) + (size_t)l * 1024 * 2816, 2816,
                     kt * 64, ntile * 64, 0, nullptr, sm);
    } else if (it < S6) {
      ssm_param_item(p, it - S5);
    } else {
      float* rope = (float*)(p.ws + OFF_ROPE);
      for (int i = vtid(); i < 1024; i += 256) {
        int idx = i >> 4, f = i & 15;
        double ang = (double)idx * pow(10000.0, -(double)f / 16.0);
        rope[i] = (float)cos(ang);
        rope[1024 + i] = (float)sin(ang);
      }
    }
  }
}

DI void phase1(char* smem) {
  const Params p = kparams();
  float* sm = (float*)(smem + vhalf() * 40960);
  const float* MOD = (const float*)(p.ws + OFF_MOD);
  constexpr int N_B1 = 4 * 20, N_B2 = 4 * 88, N_PREP = T_TOK / 4;
  for (int it = blockIdx.x * 2 + vhalf(); it < N_B1 + N_B2 + N_PREP; it += gridDim.x * 2) {
    if (it < N_B1) {
      int l = it / 20, jb = it % 20;
      gemv8_item(MOD + (size_t)l * 8 * 6144 + 0, 6144, false, p.w_in + (size_t)l * 1024 * 1280, 1280, jb * 64, nullptr,
                 (float*)(p.ws + OFF_BIAS1) + (size_t)l * 8 * 1280, 1280, 0, sm);
    } else if (it < N_B1 + N_B2) {
      int r = it - N_B1; int l = r / 88, jb = r % 88;
      gemv8_item(MOD + (size_t)l * 8 * 6144 + 3072, 6144, false, p.w_ffn_in + (size_t)l * 1024 * 5632, 5632, jb * 64, nullptr,
                 (float*)(p.ws + OFF_BIAS2) + (size_t)l * 8 * 5632, 5632, 1, sm);
    } else {
      int r = it - N_B1 - N_B2;
      const int lane = vtid() & 63, wave = vtid() >> 6;
      int t = r * 4 + wave;
      int b = t >> 12;
      const float4* xr = (const float4*)(p.x + (size_t)t * 1024);
      float4 v[4];
      float ss = 0.f;
#pragma unroll
      for (int i = 0; i < 4; i++) {
        v[i] = xr[lane + 64 * i];
        ss += v[i].x * v[i].x + v[i].y * v[i].y + v[i].z * v[i].z + v[i].w * v[i].w;
      }
      ss = wave_sum(ss);
      float* SSX = (float*)(p.ws + OFF_SSX);
      if (lane < 16) SSX[(size_t)t * 16 + lane] = (lane == 0) ? ss : 0.f;
      u16* ACT = (u16*)(p.ws + OFF_ACT);
      const float* sc1 = MOD + (size_t)(0 * 8 + b) * 6144 + 1024;
#pragma unroll
      for (int i = 0; i < 4; i++) {
        int k = (lane + 64 * i) * 4;
        float4 g = *(const float4*)(p.norm1 + k);
        float4 s = *(const float4*)(sc1 + k);
        st_bf4(ACT + tl_idx(t, k), v[i].x * g.x * (1.f + s.x), v[i].y * g.y * (1.f + s.y),
               v[i].z * g.z * (1.f + s.z), v[i].w * g.w * (1.f + s.w));
      }
    }
  }
}

enum { EPI_IN = 0, EPI_GLU = 1, EPI_OUT = 2, EPI_F1 = 3, EPI_F2 = 4 };

DI float row_rinv16(const float* ssx, int t, float invn) {
  const float4* q = (const float4*)(ssx + (size_t)t * 16);
  float4 a = q[0], b = q[1], c = q[2], d = q[3];
  float s = ((a.x + a.y) + (a.z + a.w)) + ((b.x + b.y) + (b.z + b.w)) + ((c.x + c.y) + (c.z + c.w)) + ((d.x + d.y) + (d.z + d.w));
  return rsqrtf(s * invn + 1e-6f);
}
DI float row_rinv8(const float* ss8, int t, float invn) {
  const float4* q = (const float4*)(ss8 + (size_t)t * 8);
  float4 a = q[0], b = q[1];
  float s = ((a.x + a.y) + (a.z + a.w)) + ((b.x + b.y) + (b.z + b.w));
  return rsqrtf(s * invn + 1e-6f);
}

template <int EPI>
DI void gemm_tile(const Params& p, const int l, const int mt, const int nt, char* smem, uint4& ra0, uint4& ra1, uint4& ra2, uint4& ra3,
               uint4& rb0, uint4& rb1, uint4& rb2, uint4& rb3, const bool first, const bool has_next, const int mt_next, const int nt_next) {
  constexpr int TJ = 4;
  constexpr int K = (EPI == EPI_GLU) ? 512 : (EPI == EPI_F2 ? 2816 : 1024);
  constexpr int KT = K / 64;
  u16* As = (u16*)smem;
  u16* Bs = As + 256 * 72;
  const int tid = tidx(), lane = tid & 63, wave = tid >> 6;
  const int wm = wave >> 2, wn = wave & 3;
  const int hf = lane >> 5, li = lane & 31;
  const int m0 = mt * 256, n0 = nt * 256;

  const u16* A0;
  const u16* A1 = nullptr;
  const u16* W;
  if (EPI == EPI_IN) { A0 = (const u16*)(p.ws + OFF_ACT); W = (const u16*)(p.ws + OFF_WT_IN) + (size_t)l * 1280 * 1024; }
  else if (EPI == EPI_GLU) { A0 = (const u16*)(p.ws + OFF_YG); W = (const u16*)(p.ws + OFF_WT_GLU) + (size_t)l * 512 * 512; }
  else if (EPI == EPI_OUT) { A0 = (const u16*)(p.ws + OFF_OATT); A1 = (const u16*)(p.ws + OFF_OSSM); W = (const u16*)(p.ws + OFF_WT_OUT) + (size_t)l * 1024 * 1024; }
  else if (EPI == EPI_F1) { A0 = (const u16*)(p.ws + OFF_ACT); W = (const u16*)(p.ws + OFF_WT_F1) + (size_t)l * 5632 * 1024; }
  else { A0 = (const u16*)(p.ws + OFF_HID); W = (const u16*)(p.ws + OFF_WT_F2) + (size_t)l * 1024 * 2816; }

  const int lrow = tid >> 3, lc8 = tid & 7;
  constexpr int NW = (EPI == EPI_IN) ? 1280 : (EPI == EPI_GLU ? 512 : (EPI == EPI_F1 ? 5632 : 1024));
  constexpr size_t AKT = (size_t)T_TOK * 64, WKT = (size_t)NW * 64;
  const u16* ag0 = A0 + (size_t)(m0 + lrow) * 64 + lc8 * 8;
  const u16* ag1 = (EPI == EPI_OUT) ? (A1 + (size_t)(m0 + lrow) * 64 + lc8 * 8) : nullptr;
  const u16* wg = W + (size_t)(n0 + lrow) * 64 + lc8 * 8;

  f32x16 acc[2][TJ];
#pragma unroll
  for (int i = 0; i < 2; i++)
#pragma unroll
    for (int j = 0; j < TJ; j++)
#pragma unroll
      for (int r = 0; r < 16; r++) acc[i][j][r] = 0.f;

#define GEMM_GLOAD_R(kt_, A0_, A1_, A2_, A3_, B0_, B1_, B2_, B3_)                                 \
  {                                                                                              \
    const u16* ap;                                                                               \
    if (EPI == EPI_OUT) ap = ((kt_) < 8) ? (ag0 + (kt_) * AKT) : (ag1 + (long)((kt_) - 8) * (long)AKT);      \
    else ap = ag0 + (kt_) * AKT;                                                                 \
    const u16* wp = wg + (kt_) * WKT;                                                            \
    A0_ = *(const uint4*)(ap);                                                                   \
    A1_ = *(const uint4*)(ap + 64 * 64);                                                         \
    A2_ = *(const uint4*)(ap + 128 * 64);                                                        \
    A3_ = *(const uint4*)(ap + 192 * 64);                                                        \
    B0_ = *(const uint4*)(wp);                                                                   \
    B1_ = *(const uint4*)(wp + 64 * 64);                                                         \
    B2_ = *(const uint4*)(wp + 128 * 64);                                                        \
    B3_ = *(const uint4*)(wp + 192 * 64);                                                        \
  }
#define GEMM_LSTORE_R(boff_, A0_, A1_, A2_, A3_, B0_, B1_, B2_, B3_) \
  {                                                                \
    u16* a_ = As + (boff_) + lrow * 72 + lc8 * 8;                  \
    u16* b_ = Bs + (boff_) + lrow * 72 + lc8 * 8;                  \
    *(uint4*)(a_) = A0_;                                           \
    *(uint4*)(a_ + 64 * 72) = A1_;                                 \
    *(uint4*)(a_ + 128 * 72) = A2_;                                \
    *(uint4*)(a_ + 192 * 72) = A3_;                                \
    *(uint4*)(b_) = B0_;                                           \
    *(uint4*)(b_ + 64 * 72) = B1_;                                 \
    *(uint4*)(b_ + 128 * 72) = B2_;                                \
    *(uint4*)(b_ + 192 * 72) = B3_;                                \
  }
#define GEMM_COMPUTE(cur_, DOST_, oth_, A0_, A1_, A2_, A3_, B0_, B1_, B2_, B3_)                                          \
  {                                                                                                                     \
    u16* a_ = As + (oth_) + lrow * 72 + lc8 * 8;                                                                        \
    u16* b_ = Bs + (oth_) + lrow * 72 + lc8 * 8;                                                                        \
    _Pragma("unroll") for (int s = 0; s < 4; s++) {                                                                     \
      bf16x8 wf[2], af[TJ];                                                                                             \
      _Pragma("unroll") for (int i = 0; i < 2; i++)                                                                     \
        wf[i] = *(const bf16x8*)(Bs + (cur_) + (wn * 64 + i * 32 + li) * 72 + s * 16 + hf * 8);                         \
      _Pragma("unroll") for (int j = 0; j < TJ; j++)                                                                    \
        af[j] = *(const bf16x8*)(As + (cur_) + (wm * 128 + j * 32 + li) * 72 + s * 16 + hf * 8);                        \
      _Pragma("unroll") for (int i = 0; i < 2; i++)                                                                     \
        _Pragma("unroll") for (int j = 0; j < TJ; j++) acc[i][j] = MFMA(wf[i], af[j], acc[i][j]);                       \
        \
      if (DOST_) {                                                                                                      \
        if (s == 0) { *(uint4*)(a_) = A0_; *(uint4*)(a_ + 64 * 72) = A1_; }                                             \
        if (s == 1) { *(uint4*)(a_ + 128 * 72) = A2_; *(uint4*)(a_ + 192 * 72) = A3_; }                                 \
        if (s == 2) { *(uint4*)(b_) = B0_; *(uint4*)(b_ + 64 * 72) = B1_; }                                             \
        if (s == 3) { *(uint4*)(b_ + 128 * 72) = B2_; *(uint4*)(b_ + 192 * 72) = B3_; }                                 \
      }                                                                                                                 \
    }                                                                                                                   \
  }
  constexpr int BUF = 2 * 256 * 72;
  uint4 sa0, sa1, sa2, sa3, sb0, sb1, sb2, sb3;
  if (first) GEMM_GLOAD_R(0, ra0, ra1, ra2, ra3, rb0, rb1, rb2, rb3);
  GEMM_GLOAD_R(1, sa0, sa1, sa2, sa3, sb0, sb1, sb2, sb3);
  int tok[TJ];
#pragma unroll
  for (int j = 0; j < TJ; j++) tok[j] = m0 + wm * 128 + j * 32 + li;

  __syncthreads();
  GEMM_LSTORE_R(0, ra0, ra1, ra2, ra3, rb0, rb1, rb2, rb3);
  GEMM_GLOAD_R(2, ra0, ra1, ra2, ra3, rb0, rb1, rb2, rb3);
  __syncthreads();
#pragma unroll 1
  for (int kt = 0; kt < KT; kt += 2) {
    if (EPI == EPI_OUT) {
      if (kt == 8) {
#pragma unroll
        for (int j = 0; j < TJ; j++) {
          const float ra_ = row_rinv8((const float*)(p.ws + OFF_SSA), tok[j], 1.f / 512.f);
          const float rs_ = row_rinv8((const float*)(p.ws + OFF_SSS), tok[j], 1.f / 512.f);
          const float mr = ra_ / rs_;
#pragma unroll
          for (int i = 0; i < 2; i++)
#pragma unroll
            for (int r = 0; r < 16; r++) acc[i][j][r] *= mr;
        }
      }
    }
    GEMM_COMPUTE(0, true, BUF, sa0, sa1, sa2, sa3, sb0, sb1, sb2, sb3);
    if (kt + 3 < KT) GEMM_GLOAD_R(kt + 3, sa0, sa1, sa2, sa3, sb0, sb1, sb2, sb3);
    __syncthreads();
    GEMM_COMPUTE(BUF, (kt + 2 < KT), 0, ra0, ra1, ra2, ra3, rb0, rb1, rb2, rb3);
    if (kt + 4 < KT) GEMM_GLOAD_R(kt + 4, ra0, ra1, ra2, ra3, rb0, rb1, rb2, rb3);
    __syncthreads();
  }
  if (has_next && EPI != EPI_OUT && EPI != EPI_F2) {
    const u16* ap = A0 + (size_t)(mt_next * 256 + lrow) * 64 + lc8 * 8;
    const u16* wp = W + (size_t)(nt_next * 256 + lrow) * 64 + lc8 * 8;
    ra0 = *(const uint4*)(ap);
    ra1 = *(const uint4*)(ap + 64 * 64);
    ra2 = *(const uint4*)(ap + 128 * 64);
    ra3 = *(const uint4*)(ap + 192 * 64);
    rb0 = *(const uint4*)(wp);
    rb1 = *(const uint4*)(wp + 64 * 64);
    rb2 = *(const uint4*)(wp + 128 * 64);
    rb3 = *(const uint4*)(wp + 192 * 64);
  }

  const int b = m0 >> 12;
  const int nbase = n0 + wn * 64;
  const float* MOD = (const float*)(p.ws + OFF_MOD);

  if (EPI == EPI_IN) {
    const float* bias = (const float*)(p.ws + OFF_BIAS1) + (size_t)(l * 8 + b) * 1280;
    const float* SSX = (const float*)(p.ws + OFF_SSX);
    float rinv[TJ];
#pragma unroll
    for (int j = 0; j < TJ; j++) rinv[j] = row_rinv16(SSX, tok[j], 1.f / 1024.f);
#pragma unroll
    for (int i = 0; i < 2; i++)
#pragma unroll
      for (int q4 = 0; q4 < 4; q4++) {
        float4 b4 = *(const float4*)(bias + nbase + i * 32 + 8 * q4 + 4 * hf);
#pragma unroll
        for (int j = 0; j < TJ; j++) {
          acc[i][j][4 * q4 + 0] = acc[i][j][4 * q4 + 0] * rinv[j] + b4.x;
          acc[i][j][4 * q4 + 1] = acc[i][j][4 * q4 + 1] * rinv[j] + b4.y;
          acc[i][j][4 * q4 + 2] = acc[i][j][4 * q4 + 2] * rinv[j] + b4.z;
          acc[i][j][4 * q4 + 3] = acc[i][j][4 * q4 + 3] * rinv[j] + b4.w;
        }
      }
    if (nbase < 640) {
#pragma unroll
      for (int j = 0; j < TJ; j++) {
        const int t = tok[j], pos = t & 4095;
#pragma unroll
        for (int i = 0; i < 2; i++)
#pragma unroll
          for (int q4 = 0; q4 < 4; q4++) {
            const int d0 = i * 32 + 8 * q4 + 4 * hf;
            u16* dst = (nbase < 512) ? ((u16*)(p.ws + OFF_Q) + (size_t)t * 512 + nbase + d0)
                                     : ((u16*)(p.ws + OFF_K) + ((size_t)(b * 2 + ((nbase - 512) >> 6)) * 4096 + pos) * 64 + d0);
            st_bf4(dst, acc[i][j][4 * q4 + 0], acc[i][j][4 * q4 + 1], acc[i][j][4 * q4 + 2], acc[i][j][4 * q4 + 3]);
          }
      }
    } else if (nbase < 768) {
      u16* VT = (u16*)(p.ws + OFF_VT);
      const int vh = (nbase - 640) >> 6;
#pragma unroll
      for (int j = 0; j < TJ; j++) {
        const int pos = tok[j] & 4095;
#pragma unroll
        for (int i = 0; i < 2; i++)
#pragma unroll
          for (int r = 0; r < 16; r++) {
            int d = i * 32 + crow(r, hf);
            VT[((size_t)(b * 2 + vh) * 64 + d) * 4096 + pos] = (u16)(pk(acc[i][j][r], 0.f) & 0xffffu);
          }
      }
    } else {
      u16* U2 = (u16*)(p.ws + OFF_U2);
      const int ch0 = nbase - 768;
#pragma unroll
      for (int j = 0; j < TJ; j++) {
        const int pos = tok[j] & 4095;
#pragma unroll
        for (int i = 0; i < 2; i++)
#pragma unroll
          for (int q4 = 0; q4 < 4; q4++) {
            int ch = ch0 + i * 32 + 8 * q4 + 4 * hf;
            int g = ch >> 4, c0 = ch & 15;
            st_bf4(U2 + (((size_t)(b * 32 + g)) * 4096 + pos) * 16 + c0, acc[i][j][4 * q4 + 0], acc[i][j][4 * q4 + 1],
                   acc[i][j][4 * q4 + 2], acc[i][j][4 * q4 + 3]);
          }
      }
    }
  } else if (EPI == EPI_GLU) {
    const float* bg = p.b_glu + l * 512;
    const u16* YG = (const u16*)(p.ws + OFF_YG);
    u16* OSSM = (u16*)(p.ws + OFF_OSSM);
    float* SSS = (float*)(p.ws + OFF_SSS);
#pragma unroll
    for (int j = 0; j < TJ; j++) {
      const int t = tok[j];
      float ss = 0.f;
#pragma unroll
      for (int i = 0; i < 2; i++)
#pragma unroll
        for (int q4 = 0; q4 < 4; q4++) {
          const int n = nbase + i * 32 + 8 * q4 + 4 * hf;
          float4 b4 = *(const float4*)(bg + n);
          float4 y = ld_bf4(YG + tl_idx(t, n));
          float o0 = y.x / (1.f + __expf(-(acc[i][j][4 * q4 + 0] + b4.x)));
          float o1 = y.y / (1.f + __expf(-(acc[i][j][4 * q4 + 1] + b4.y)));
          float o2 = y.z / (1.f + __expf(-(acc[i][j][4 * q4 + 2] + b4.z)));
          float o3 = y.w / (1.f + __expf(-(acc[i][j][4 * q4 + 3] + b4.w)));
          ss += o0 * o0 + o1 * o1 + o2 * o2 + o3 * o3;
          st_bf4(OSSM + tl_idx(t, n), o0, o1, o2, o3);
        }
      ss += shfl_x32(ss, hf);
      if (hf == 0) SSS[(size_t)t * 8 + (nbase >> 6)] = ss;
    }
  } else if (EPI == EPI_OUT || EPI == EPI_F2) {
    const float* gate = MOD + (size_t)(l * 8 + b) * 6144 + (EPI == EPI_OUT ? 2048 : 5120);
    const bool has_next = (EPI == EPI_OUT) || (l < 3);
    const float* nrm = (EPI == EPI_OUT) ? (p.norm2 + l * 1024) : (p.norm1 + (l + 1) * 1024);
    const float* scn = (EPI == EPI_OUT) ? (MOD + (size_t)(l * 8 + b) * 6144 + 4096) : (MOD + (size_t)((l + 1) * 8 + b) * 6144 + 1024);
    const float* xin = (EPI == EPI_OUT && l == 0) ? p.x : (const float*)(p.ws + OFF_X);
    float* X = (float*)(p.ws + OFF_X);
    u16* ACT = (u16*)(p.ws + OFF_ACT);
    float* SSX = (float*)(p.ws + OFF_SSX);
    float* stg = (float*)smem + wave * (32 * 68);
    const int rr = lane >> 4, c4 = (lane & 15) * 4;
    const int n = nbase + c4;
    const float4 g4 = *(const float4*)(gate + n);
    float4 nsc = make_float4(0.f, 0.f, 0.f, 0.f);
    if (has_next) {
      const float4 nr = *(const float4*)(nrm + n);
      const float4 sc = *(const float4*)(scn + n);
      nsc = make_float4(nr.x * (1.f + sc.x), nr.y * (1.f + sc.y), nr.z * (1.f + sc.z), nr.w * (1.f + sc.w));
    }
    float4 xi[8], xn[8];
    float fj[TJ];
#pragma unroll
    for (int j = 0; j < TJ; j++) fj[j] = (EPI == EPI_OUT) ? row_rinv8((const float*)(p.ws + OFF_SSS), tok[j], 1.f / 512.f) : 1.f;
#pragma unroll
    for (int it = 0; it < 8; it++) xi[it] = *(const float4*)(xin + (size_t)(m0 + wm * 128 + rr + 4 * it) * 1024 + n);
#pragma unroll
    for (int j = 0; j < TJ; j++) {
#pragma unroll
      for (int i = 0; i < 2; i++)
#pragma unroll
        for (int q4 = 0; q4 < 4; q4++)
          *(float4*)(stg + li * 68 + i * 32 + 8 * q4 + 4 * hf) =
              make_float4(acc[i][j][4 * q4 + 0] * fj[j], acc[i][j][4 * q4 + 1] * fj[j], acc[i][j][4 * q4 + 2] * fj[j], acc[i][j][4 * q4 + 3] * fj[j]);
      asm volatile("s_waitcnt lgkmcnt(0)" ::: "memory");
      if (j + 1 < TJ) {
#pragma unroll
        for (int it = 0; it < 8; it++) xn[it] = *(const float4*)(xin + (size_t)(m0 + wm * 128 + (j + 1) * 32 + rr + 4 * it) * 1024 + n);
      }
#pragma unroll
      for (int it = 0; it < 8; it++) {
        const int row = rr + 4 * it;
        const int t = m0 + wm * 128 + j * 32 + row;
        const float4 a = *(const float4*)(stg + row * 68 + c4);
        float4 y;
        y.x = xi[it].x + g4.x * a.x;
        y.y = xi[it].y + g4.y * a.y;
        y.z = xi[it].z + g4.z * a.z;
        y.w = xi[it].w + g4.w * a.w;
        *(float4*)(X + (size_t)t * 1024 + n) = y;
        float ss = y.x * y.x + y.y * y.y + y.z * y.z + y.w * y.w;
        ss = row16_sum(ss);
        if ((lane & 15) == 0) SSX[(size_t)t * 16 + (nbase >> 6)] = ss;
        if (has_next) st_bf4(ACT + tl_idx(t, n), y.x * nsc.x, y.y * nsc.y, y.z * nsc.z, y.w * nsc.w);
      }
      asm volatile("s_waitcnt lgkmcnt(0)" ::: "memory");
      if (j + 1 < TJ) {
#pragma unroll
        for (int it = 0; it < 8; it++) xi[it] = xn[it];
      }
    }
  } else {
    const float* bias = (const float*)(p.ws + OFF_BIAS2) + (size_t)(l * 8 + b) * 5632;
    const float* SSX = (const float*)(p.ws + OFF_SSX);
    u16* HID = (u16*)(p.ws + OFF_HID);
    const int jbase = nbase >> 1;
#pragma unroll
    for (int j = 0; j < TJ; j++) {
      const int t = tok[j];
      const float rv = row_rinv16(SSX, t, 1.f / 1024.f);
#pragma unroll
      for (int q4 = 0; q4 < 4; q4++) {
        const int ng = nbase + 8 * q4 + 4 * hf;
        float4 bg4 = *(const float4*)(bias + ng);
        float4 bu4 = *(const float4*)(bias + ng + 32);
        float zg0 = acc[0][j][4 * q4 + 0] * rv + bg4.x, zu0 = acc[1][j][4 * q4 + 0] * rv + bu4.x;
        float zg1 = acc[0][j][4 * q4 + 1] * rv + bg4.y, zu1 = acc[1][j][4 * q4 + 1] * rv + bu4.y;
        float zg2 = acc[0][j][4 * q4 + 2] * rv + bg4.z, zu2 = acc[1][j][4 * q4 + 2] * rv + bu4.z;
        float zg3 = acc[0][j][4 * q4 + 3] * rv + bg4.w, zu3 = acc[1][j][4 * q4 + 3] * rv + bu4.w;
        float h0 = zg0 / (1.f + __expf(-zg0)) * zu0;
        float h1 = zg1 / (1.f + __expf(-zg1)) * zu1;
        float h2 = zg2 / (1.f + __expf(-zg2)) * zu2;
        float h3 = zg3 / (1.f + __expf(-zg3)) * zu3;
        st_bf4(HID + tl_idx(t, jbase + 8 * q4 + 4 * hf), h0, h1, h2, h3);
      }
    }
  }
}

template <int EPI>
DI void gemm_phase(int l, char* smem) {
  const Params p = kparams();
  constexpr int NT = (EPI == EPI_IN) ? 5 : (EPI == EPI_GLU ? 2 : (EPI == EPI_F1 ? 22 : 4));
  const int g8 = gridDim.x >> 3;
  const int xg = blockIdx.x & 7, lb = blockIdx.x >> 3;
  uint4 ra0, ra1, ra2, ra3, rb0, rb1, rb2, rb3;
  bool first = true;
  for (int q = lb; q < 16 * NT; q += g8) {
    const int mg = q / (8 * NT);
    const int rem = q - mg * 8 * NT;
    const int qn = q + g8;
    const bool has_next = qn < 16 * NT;
    const int mgn = qn / (8 * NT);
    const int remn = qn - mgn * 8 * NT;
    gemm_tile<EPI>(p, l, xg * 16 + mg * 8 + (rem & 7), rem >> 3, smem, ra0, ra1, ra2, ra3, rb0, rb1, rb2, rb3, first, has_next,
                   xg * 16 + mgn * 8 + (remn & 7), remn >> 3);
    first = (EPI == EPI_OUT || EPI == EPI_F2);
  }
}

DI void attn_item(const Params& p, int item, char* smem) {
  u16* Ks = (u16*)smem;
  u16* Vs = Ks + 64 * 72;
  const int tid = tidx(), lane = tid & 63, wave = tid >> 6;
  const int hf = lane >> 5, li = lane & 31;
  const int xcd = item & 7, local = item >> 3;
  const int pair = xcd * 2 + (local >> 5);
  const int within = local & 31;
  const int hq = within >> 3, qb = within & 7;
  const int b = pair >> 1, kvh = pair & 1, h = kvh * 4 + hq;
  const int t0 = b * 4096 + qb * 512 + wave * 64 + li;

  const u16* Q = (const u16*)(p.ws + OFF_Q);
  bf16x8 qf[2][4];
#pragma unroll
  for (int u = 0; u < 2; u++)
#pragma unroll
    for (int s = 0; s < 4; s++) qf[u][s] = *(const bf16x8*)(Q + (size_t)(t0 + 32 * u) * 512 + h * 64 + 16 * s + 8 * hf);

  f32x16 o0[2], o1[2];
  float m_run[2], l_run[2];
#pragma unroll
  for (int u = 0; u < 2; u++) {
#pragma unroll
    for (int r = 0; r < 16; r++) { o0[u][r] = 0.f; o1[u][r] = 0.f; }
    m_run[u] = -1e30f; l_run[u] = 0.f;
  }

  const int lrow = tid >> 3, lc8 = tid & 7;
  const u16* Kg = (const u16*)(p.ws + OFF_K) + (size_t)pair * 4096 * 64 + (size_t)lrow * 64 + lc8 * 8;
  const u16* Vg = (const u16*)(p.ws + OFF_VT) + (size_t)pair * 64 * 4096 + (size_t)lrow * 4096 + lc8 * 8;
  uint4 rk0, rv0;
#define ATT_GLOAD(kt_)                                                   \
  {                                                                      \
    rk0 = *(const uint4*)(Kg + (size_t)((kt_) * 64) * 64);               \
    rv0 = *(const uint4*)(Vg + (kt_) * 64);                              \
  }
  ATT_GLOAD(0);
  const int kap = (li & 0x13) | ((li & 4) << 1) | ((li & 8) >> 1);

  for (int kt = 0; kt < 64; kt++) {
    __syncthreads();
    *(uint4*)(Ks + (lrow) * 72 + lc8 * 8) = rk0;
    *(uint4*)(Vs + (lrow) * 72 + lc8 * 8) = rv0;
    __syncthreads();
    if (kt + 1 < 64) ATT_GLOAD(kt + 1);

    f32x16 s0[2], s1[2];
#pragma unroll
    for (int u = 0; u < 2; u++)
#pragma unroll
      for (int r = 0; r < 16; r++) { s0[u][r] = 0.f; s1[u][r] = 0.f; }
#pragma unroll
    for (int s = 0; s < 4; s++) {
      const bf16x8 kf0 = *(const bf16x8*)(Ks + kap * 72 + 16 * s + 8 * hf);
      const bf16x8 kf1 = *(const bf16x8*)(Ks + (32 + kap) * 72 + 16 * s + 8 * hf);
#pragma unroll
      for (int u = 0; u < 2; u++) {
        s0[u] = MFMA(kf0, qf[u][s], s0[u]);
        s1[u] = MFMA(kf1, qf[u][s], s1[u]);
      }
    }
#pragma unroll
    for (int u = 0; u < 2; u++) {
      float mx = s0[u][0];
#pragma unroll
      for (int r = 1; r < 16; r++) mx = fmaxf(mx, s0[u][r]);
#pragma unroll
      for (int r = 0; r < 16; r++) mx = fmaxf(mx, s1[u][r]);
      mx = fmaxf(mx, shfl_x32(mx, hf));
      const float mnew = fmaxf(m_run[u], mx);
      const float alpha = __builtin_amdgcn_exp2f(m_run[u] - mnew);
      m_run[u] = mnew;
      float ps = 0.f;
#pragma unroll
      for (int r = 0; r < 16; r++) { s0[u][r] = __builtin_amdgcn_exp2f(s0[u][r] - mnew); ps += s0[u][r]; }
#pragma unroll
      for (int r = 0; r < 16; r++) { s1[u][r] = __builtin_amdgcn_exp2f(s1[u][r] - mnew); ps += s1[u][r]; }
      l_run[u] = l_run[u] * alpha + ps;
#pragma unroll
      for (int r = 0; r < 16; r++) { o0[u][r] *= alpha; o1[u][r] *= alpha; }
#pragma unroll
      for (int c = 0; c < 4; c++) {
        const int sp = c & 1;
        uint4 uu;
        if (c < 2) uu = make_uint4(pk(s0[u][8 * sp + 0], s0[u][8 * sp + 1]), pk(s0[u][8 * sp + 2], s0[u][8 * sp + 3]),
                                   pk(s0[u][8 * sp + 4], s0[u][8 * sp + 5]), pk(s0[u][8 * sp + 6], s0[u][8 * sp + 7]));
        else uu = make_uint4(pk(s1[u][8 * sp + 0], s1[u][8 * sp + 1]), pk(s1[u][8 * sp + 2], s1[u][8 * sp + 3]),
                             pk(s1[u][8 * sp + 4], s1[u][8 * sp + 5]), pk(s1[u][8 * sp + 6], s1[u][8 * sp + 7]));
        const bf16x8 pbv = __builtin_bit_cast(bf16x8, uu);
        const bf16x8 vf0 = *(const bf16x8*)(Vs + li * 72 + 16 * c + 8 * hf);
        const bf16x8 vf1 = *(const bf16x8*)(Vs + (32 + li) * 72 + 16 * c + 8 * hf);
        o0[u] = MFMA(vf0, pbv, o0[u]);
        o1[u] = MFMA(vf1, pbv, o1[u]);
      }
    }
  }
  u16* OATT = (u16*)(p.ws + OFF_OATT);
#pragma unroll
  for (int u = 0; u < 2; u++) {
    const int t = t0 + 32 * u;
    const float ltot = l_run[u] + shfl_x32(l_run[u], hf);
    const float inv = 1.f / ltot;
    float ss = 0.f;
#pragma unroll
    for (int q4 = 0; q4 < 4; q4++) {
      float a0 = o0[u][4 * q4 + 0] * inv, a1 = o0[u][4 * q4 + 1] * inv, a2 = o0[u][4 * q4 + 2] * inv, a3 = o0[u][4 * q4 + 3] * inv;
      float c0 = o1[u][4 * q4 + 0] * inv, c1 = o1[u][4 * q4 + 1] * inv, c2 = o1[u][4 * q4 + 2] * inv, c3 = o1[u][4 * q4 + 3] * inv;
      ss += a0 * a0 + a1 * a1 + a2 * a2 + a3 * a3 + c0 * c0 + c1 * c1 + c2 * c2 + c3 * c3;
      st_bf4(OATT + tl_idx(t, h * 64 + 8 * q4 + 4 * hf), a0, a1, a2, a3);
      st_bf4(OATT + tl_idx(t, h * 64 + 32 + 8 * q4 + 4 * hf), c0, c1, c2, c3);
    }
    ss += shfl_x32(ss, hf);
    if (hf == 0) ((float*)(p.ws + OFF_SSA))[(size_t)t * 8 + h] = ss;
  }
}

DI bf16x8 ssm_ufrag(const u16* U2, int bp, int g, int tb, int li, int hf) {
  const int seq = (li >> 2) & 1, step = ((li >> 3) << 2) | (li & 3);
  return *(const bf16x8*)(U2 + (((size_t)((2 * bp + seq) * 32 + g)) * 4096 + tb + step) * 16 + 8 * hf);
}

DI void ssm_scan16(const f32x16& x0, const f32x16& x1, const f32x16& x2, const f32x16& x3, const float4 a0, const float4 a1,
                   float& h0r, float& h0i, float& h1r, float& h1i, const int dir) {
  if (dir == 0) {
#pragma unroll
    for (int r = 0; r < 16; r++) {
      float nr = a0.x * h0r - a0.y * h0i + x0[r], ni = a0.x * h0i + a0.y * h0r + x2[r];
      h0r = nr; h0i = ni;
      float mr = a1.x * h1r - a1.y * h1i + x1[r], mi = a1.x * h1i + a1.y * h1r + x3[r];
      h1r = mr; h1i = mi;
    }
  } else {
#pragma unroll
    for (int r = 15; r >= 0; r--) {
      float nr = a0.x * h0r - a0.y * h0i + x0[r], ni = a0.x * h0i + a0.y * h0r + x2[r];
      h0r = nr; h0i = ni;
      float mr = a1.x * h1r - a1.y * h1i + x1[r], mi = a1.x * h1i + a1.y * h1r + x3[r];
      h1r = mr; h1i = mi;
    }
  }
}

DI void ssm1_item(const Params& p, int l, int item) {
  const int tid = vtid(), lane = tid & 63, wave = __builtin_amdgcn_readfirstlane(tid >> 6);
  const int hf = lane >> 5, li = lane & 31;
  const int w = item * 4 + wave;
  const int ch = w & 15, bp = (w >> 4) & 3, g = (w >> 6) & 31, dir = w >> 11;
  const int idx = (l * 2 + dir) * 32 + g;
  const u16* U2 = (const u16*)(p.ws + OFF_U2);
  const u16* BB = (const u16*)(p.ws + OFF_SSMBB) + (size_t)idx * 128 * 16;
  const float* SA = (const float*)(p.ws + OFF_SSMA) + (size_t)idx * 64 * 4;
  bf16x8 bbf[4];
#pragma unroll
  for (int j = 0; j < 4; j++) bbf[j] = *(const bf16x8*)(BB + (32 * j + li) * 16 + 8 * hf);
  const float4 a0 = *(const float4*)(SA + li * 4);
  const float4 a1 = *(const float4*)(SA + (li + 32) * 4);
  float h0r = 0.f, h0i = 0.f, h1r = 0.f, h1i = 0.f;
  f32x16 zero;
#pragma unroll
  for (int r = 0; r < 16; r++) zero[r] = 0.f;
#define SSM_TB(it_) (ch * 256 + (dir ? (15 - (it_)) : (it_)) * 16)
  bf16x8 q0 = ssm_ufrag(U2, bp, g, SSM_TB(0), li, hf), q1 = ssm_ufrag(U2, bp, g, SSM_TB(1), li, hf);
  bf16x8 q2 = ssm_ufrag(U2, bp, g, SSM_TB(2), li, hf), q3 = ssm_ufrag(U2, bp, g, SSM_TB(3), li, hf);
#pragma unroll 1
  for (int it = 0; it < 16; it++) {
    const bf16x8 uf = q0;
    q0 = q1; q1 = q2; q2 = q3;
    const int itn = (it + 4 < 16) ? (it + 4) : 15;
    q3 = ssm_ufrag(U2, bp, g, SSM_TB(itn), li, hf);
    f32x16 x0 = MFMA(uf, bbf[0], zero), x1 = MFMA(uf, bbf[1], zero), x2 = MFMA(uf, bbf[2], zero), x3 = MFMA(uf, bbf[3], zero);
    ssm_scan16(x0, x1, x2, x3, a0, a1, h0r, h0i, h1r, h1i, dir);
  }
  float* E = (float*)(p.ws + OFF_E) + ((((size_t)(dir * 32 + g) * 8 + (2 * bp + hf)) * 16 + ch) * 64) * 2;
  *(float2*)(E + li * 2) = make_float2(h0r, h0i);
  *(float2*)(E + (li + 32) * 2) = make_float2(h1r, h1i);
}

DI void ssm2_item(const Params& p, int l, int item, char* smem) {
  const int tid = vtid(), lane = tid & 63, wave = __builtin_amdgcn_readfirstlane(tid >> 6);
  const int hf = lane >> 5, li = lane & 31;
  const int w = item * 4 + wave;
  const int ch = w & 15, bp = (w >> 4) & 3, g = w >> 6;
  u16* Hs = (u16*)smem + wave * (32 * 136);
  const u16* U2 = (const u16*)(p.ws + OFF_U2);
  float* YF = (float*)(p.ws + OFF_ACT);
  u16* YG = (u16*)(p.ws + OFF_YG);
  f32x16 zero;
#pragma unroll
  for (int r = 0; r < 16; r++) zero[r] = 0.f;
  const int oseq = li >> 4, ostep = li & 15;
  const int ob = 2 * bp + oseq;

  for (int dir = 0; dir < 2; dir++) {
    const int idx = (l * 2 + dir) * 32 + g;
    const u16* BB = (const u16*)(p.ws + OFF_SSMBB) + (size_t)idx * 128 * 16;
    const u16* CC = (const u16*)(p.ws + OFF_SSMCC) + (size_t)idx * 16 * 128;
    const float* SA = (const float*)(p.ws + OFF_SSMA) + (size_t)idx * 64 * 4;
    bf16x8 bbf[4], ccf[8];
#pragma unroll
    for (int j = 0; j < 4; j++) bbf[j] = *(const bf16x8*)(BB + (32 * j + li) * 16 + 8 * hf);
#pragma unroll
    for (int s = 0; s < 8; s++) {
      bf16x8 v = *(const bf16x8*)(CC + (li & 15) * 128 + 16 * s + 8 * hf);
      if (li >= 16) {
#pragma unroll
        for (int e = 0; e < 8; e++) v[e] = 0;
      }
      ccf[s] = v;
    }
    const float4 a0 = *(const float4*)(SA + li * 4);
    const float4 a1 = *(const float4*)(SA + (li + 32) * 4);
    float h0r = 0.f, h0i = 0.f, h1r = 0.f, h1i = 0.f;
    {
      const float* E = (const float*)(p.ws + OFF_E) + ((((size_t)(dir * 32 + g) * 8 + (2 * bp + hf)) * 16) * 64) * 2;
      const int n = dir ? (15 - ch) : ch;
      for (int i0 = 0; i0 < n; i0 += 4) {
        float2 e0[4], e1[4];
#pragma unroll
        for (int u = 0; u < 4; u++) {
          int ii = i0 + u; if (ii > n - 1) ii = n - 1;
          const int ci = dir ? (15 - ii) : ii;
          e0[u] = *(const float2*)(E + (size_t)ci * 128 + li * 2);
          e1[u] = *(const float2*)(E + (size_t)ci * 128 + (li + 32) * 2);
        }
#pragma unroll
        for (int u = 0; u < 4; u++) {
          if (i0 + u < n) {
            float nr = a0.z * h0r - a0.w * h0i + e0[u].x, ni = a0.z * h0i + a0.w * h0r + e0[u].y;
            h0r = nr; h0i = ni;
            float mr = a1.z * h1r - a1.w * h1i + e1[u].x, mi = a1.z * h1i + a1.w * h1r + e1[u].y;
            h1r = mr; h1i = mi;
          }
        }
      }
    }
    bf16x8 ufn = ssm_ufrag(U2, bp, g, ch * 256 + (dir ? 15 : 0) * 16, li, hf);
    for (int it = 0; it < 16; it++) {
      const int tb = ch * 256 + (dir ? (15 - it) : it) * 16;
      const bf16x8 uf = ufn;
      f32x16 x0 = MFMA(uf, bbf[0], zero), x1 = MFMA(uf, bbf[1], zero), x2 = MFMA(uf, bbf[2], zero), x3 = MFMA(uf, bbf[3], zero);
      if (it + 1 < 16) ufn = ssm_ufrag(U2, bp, g, ch * 256 + (dir ? (14 - it) : (it + 1)) * 16, li, hf);
      const int tt = tb + ostep;
      const size_t yoff = (((size_t)(ob * 32 + g)) * 4096 + tt) * 16;
      float4 f0 = make_float4(0.f, 0.f, 0.f, 0.f), f1 = f0, u0 = f0, u1 = f0;
      if (dir) {
        f0 = *(const float4*)(YF + yoff + 4 * hf);
        f1 = *(const float4*)(YF + yoff + 8 + 4 * hf);
        u0 = ld_bf4(U2 + yoff + 4 * hf);
        u1 = ld_bf4(U2 + yoff + 8 + 4 * hf);
      }
      asm volatile("s_waitcnt lgkmcnt(0)" ::: "memory");
      if (dir == 0) {
#pragma unroll
        for (int r = 0; r < 16; r++) {
          float nr = a0.x * h0r - a0.y * h0i + x0[r], ni = a0.x * h0i + a0.y * h0r + x2[r];
          h0r = nr; h0i = ni;
          float mr = a1.x * h1r - a1.y * h1i + x1[r], mi = a1.x * h1i + a1.y * h1r + x3[r];
          h1r = mr; h1i = mi;
          *(unsigned*)(Hs + (hf * 16 + r) * 136 + 2 * li) = pk(h0r, h0i);
          *(unsigned*)(Hs + (hf * 16 + r) * 136 + 2 * (li + 32)) = pk(h1r, h1i);
        }
      } else {
#pragma unroll
        for (int r = 15; r >= 0; r--) {
          float nr = a0.x * h0r - a0.y * h0i + x0[r], ni = a0.x * h0i + a0.y * h0r + x2[r];
          h0r = nr; h0i = ni;
          float mr = a1.x * h1r - a1.y * h1i + x1[r], mi = a1.x * h1i + a1.y * h1r + x3[r];
          h1r = mr; h1i = mi;
          *(unsigned*)(Hs + (hf * 16 + r) * 136 + 2 * li) = pk(h0r, h0i);
          *(unsigned*)(Hs + (hf * 16 + r) * 136 + 2 * (li + 32)) = pk(h1r, h1i);
        }
      }
      asm volatile("s_waitcnt lgkmcnt(0)" ::: "memory");
      f32x16 y = zero;
#pragma unroll
      for (int s = 0; s < 8; s++) {
        bf16x8 hfv = *(const bf16x8*)(Hs + li * 136 + 16 * s + 8 * hf);
        y = MFMA(ccf[s], hfv, y);
      }
      if (dir == 0) {
        *(float4*)(YF + yoff + 4 * hf) = make_float4(y[0], y[1], y[2], y[3]);
        *(float4*)(YF + yoff + 8 + 4 * hf) = make_float4(y[4], y[5], y[6], y[7]);
      } else {
        float4 d0 = *(const float4*)(p.ssm_d + l * 512 + g * 16 + 4 * hf);
        float4 d1 = *(const float4*)(p.ssm_d + l * 512 + g * 16 + 8 + 4 * hf);
        float v[8];
        v[0] = f0.x + y[0] + d0.x * u0.x; v[1] = f0.y + y[1] + d0.y * u0.y;
        v[2] = f0.z + y[2] + d0.z * u0.z; v[3] = f0.w + y[3] + d0.w * u0.w;
        v[4] = f1.x + y[4] + d1.x * u1.x; v[5] = f1.y + y[5] + d1.y * u1.y;
        v[6] = f1.z + y[6] + d1.z * u1.z; v[7] = f1.w + y[7] + d1.w * u1.w;
#pragma unroll
        for (int e = 0; e < 8; e++) {
          float xx = v[e];
          float z = 0.7978845608028654f * (xx + 0.044715f * xx * xx * xx);
          float th = 1.f - 2.f / (__expf(2.f * z) + 1.f);
          v[e] = 0.5f * xx * (1.f + th);
        }
        u16* yg = YG + tl_idx(ob * 4096 + tt, g * 16);
        st_bf4(yg + 4 * hf, v[0], v[1], v[2], v[3]);
        st_bf4(yg + 8 + 4 * hf, v[4], v[5], v[6], v[7]);
      }
    }
    asm volatile("s_waitcnt lgkmcnt(0)" ::: "memory");
  }
}

DI void qkpost_phase(int l) {
  const Params p = kparams();
  const float* ROPE = (const float*)(p.ws + OFF_ROPE);
  const int nrows = T_TOK * 8 + T_TOK * 2;
  for (int r = blockIdx.x * 512 + tidx(); r < nrows; r += gridDim.x * 512) {
    const bool isq = r < T_TOK * 8;
    const int rk = r - T_TOK * 8;
    u16* row = isq ? ((u16*)(p.ws + OFF_Q) + (size_t)r * 64) : ((u16*)(p.ws + OFF_K) + (size_t)rk * 64);
    const int pos = isq ? ((r >> 3) & 4095) : (rk & 4095);
    const float* gn = isq ? (p.q_norm + l * 64) : (p.k_norm + l * 64);
    const float osc = isq ? QSCALE : 1.f;
    float v[64];
#pragma unroll
    for (int c = 0; c < 8; c++) {
      uint4 raw = ((const uint4*)row)[c];
      v[8 * c + 0] = __uint_as_float(raw.x << 16); v[8 * c + 1] = __uint_as_float(raw.x & 0xffff0000u);
      v[8 * c + 2] = __uint_as_float(raw.y << 16); v[8 * c + 3] = __uint_as_float(raw.y & 0xffff0000u);
      v[8 * c + 4] = __uint_as_float(raw.z << 16); v[8 * c + 5] = __uint_as_float(raw.z & 0xffff0000u);
      v[8 * c + 6] = __uint_as_float(raw.w << 16); v[8 * c + 7] = __uint_as_float(raw.w & 0xffff0000u);
    }
    float ss = 0.f;
#pragma unroll
    for (int e = 0; e < 64; e++) ss += v[e] * v[e];
    const float rn = rsqrtf(ss * (1.f / 64.f) + 1e-6f) * osc;
    const int irow = pos >> 6, icol = pos & 63;
    float tc[32], ts[32];
#pragma unroll
    for (int q = 0; q < 4; q++) {
      const float4 c0 = *(const float4*)(ROPE + irow * 16 + 4 * q), s0 = *(const float4*)(ROPE + 1024 + irow * 16 + 4 * q);
      const float4 c1 = *(const float4*)(ROPE + icol * 16 + 4 * q), s1 = *(const float4*)(ROPE + 1024 + icol * 16 + 4 * q);
      tc[4 * q + 0] = c0.x; tc[4 * q + 1] = c0.y; tc[4 * q + 2] = c0.z; tc[4 * q + 3] = c0.w;
      ts[4 * q + 0] = s0.x; ts[4 * q + 1] = s0.y; ts[4 * q + 2] = s0.z; ts[4 * q + 3] = s0.w;
      tc[16 + 4 * q + 0] = c1.x; tc[16 + 4 * q + 1] = c1.y; tc[16 + 4 * q + 2] = c1.z; tc[16 + 4 * q + 3] = c1.w;
      ts[16 + 4 * q + 0] = s1.x; ts[16 + 4 * q + 1] = s1.y; ts[16 + 4 * q + 2] = s1.z; ts[16 + 4 * q + 3] = s1.w;
    }
#pragma unroll
    for (int c = 0; c < 8; c++) {
      float o[8];
#pragma unroll
      for (int e = 0; e < 4; e++) {
        const int pi = 4 * c + e;
        const float cs = tc[pi], sn = ts[pi];
        const float y0 = v[2 * pi] * rn * gn[2 * pi], y1 = v[2 * pi + 1] * rn * gn[2 * pi + 1];
        o[2 * e] = y0 * cs - y1 * sn;
        o[2 * e + 1] = y0 * sn + y1 * cs;
      }
      uint4 w;
      w.x = pk(o[0], o[1]); w.y = pk(o[2], o[3]); w.z = pk(o[4], o[5]); w.w = pk(o[6], o[7]);
      ((uint4*)row)[c] = w;
    }
  }
}

DI void attn_phase(char* smem) {
  const Params p = kparams();
  for (int lq = blockIdx.x >> 3; lq < 64; lq += (gridDim.x >> 3)) attn_item(p, (blockIdx.x & 7) + 8 * lq, smem);
}
DI void ssm1_phase(int l) {
  const Params p = kparams();
  for (int it = blockIdx.x * 2 + vhalf(); it < 1024; it += gridDim.x * 2) ssm1_item(p, l, it);
}
DI void ssm2_phase(int l, char* smem) {
  const Params p = kparams();
  char* sm = smem + vhalf() * 40960;
  for (int it = blockIdx.x * 2 + vhalf(); it < 512; it += gridDim.x * 2) ssm2_item(p, l, it, sm);
}

DI void final_phase() {
  const Params p = kparams();
  const float* X = (const float*)(p.ws + OFF_X);
  const float* SSX = (const float*)(p.ws + OFF_SSX);
  const int total = T_TOK * 256;
  for (int i = blockIdx.x * 512 + tidx(); i < total; i += gridDim.x * 512) {
    int t = i >> 8, n = (i & 255) * 4;
    float rv = row_rinv16(SSX, t, 1.f / 1024.f);
    float4 x = *(const float4*)(X + (size_t)t * 1024 + n);
    float4 g = *(const float4*)(p.final_norm + n);
    float4 o;
    o.x = x.x * rv * g.x; o.y = x.y * rv * g.y; o.z = x.z * rv * g.z; o.w = x.w * rv * g.w;
    *(float4*)(p.out + (size_t)t * 1024 + n) = o;
  }
}

#define XB_TMO      128
#define XB_XCNT(j)  (256  + 64 * (j))
#define XB_XSUB(j)  (1280 + 64 * (j))
#define XB_XGEN(j)  (2304 + 64 * (j))
#define XB_TOP      3328
#define XB_TOPGEN   3392
#define XCD_BAR_WORDS 3456
#define XB_SPIN_CAP (1u << 18)
#define LAS __attribute__((address_space(3)))

__device__ __forceinline__ unsigned xb_ld(unsigned* p)              { return __hip_atomic_load(p, __ATOMIC_RELAXED, __HIP_MEMORY_SCOPE_AGENT); }
__device__ __forceinline__ unsigned xb_add(unsigned* p, unsigned v) { return __hip_atomic_fetch_add(p, v, __ATOMIC_RELAXED, __HIP_MEMORY_SCOPE_AGENT); }
__device__ __forceinline__ unsigned xb_xcc_id() { return (unsigned)__builtin_amdgcn_s_getreg((3 << 11) | 20) & 0xFu; }
#define XB_SPIN(cond, bar) do { unsigned _sp = 0; while (cond) { __builtin_amdgcn_s_sleep(1); \
    if ((++_sp & 255u) == 0u) { if (xb_ld(&(bar)[XB_TMO])) break; if (_sp > XB_SPIN_CAP) { atomicAdd(&(bar)[XB_TMO], 1u); break; } } } } while (0)

struct XcdBarrier {
    unsigned* bar; unsigned x;
    volatile LAS unsigned* st;
};

__device__ __forceinline__ XcdBarrier xcd_barrier_post(unsigned* bar, volatile LAS unsigned* st) {
    XcdBarrier b; b.bar = bar; b.x = xb_xcc_id(); b.st = st;
    if (threadIdx.x == 0) (void)xb_add(&bar[XB_XCNT(b.x)], 1u);
    return b;
}
__device__ __forceinline__ void xcd_barrier_complete(unsigned* bar, unsigned x, unsigned& nloc, unsigned& nx) {
    const unsigned G = gridDim.x * gridDim.y * gridDim.z;
    unsigned sum, cnt, mine, sp = 0u;
    for (;;) {
        sum = 0u; cnt = 0u; mine = 0u;
#pragma unroll
        for (unsigned j = 0; j < 16; ++j) { const unsigned c = xb_ld(&bar[XB_XCNT(j)]); sum += c; cnt += (c > 0u) ? 1u : 0u; mine = (j == x) ? c : mine; }
        if (sum == G) break;
        __builtin_amdgcn_s_sleep(1);
        if ((++sp & 255u) == 0u) { if (xb_ld(&bar[XB_TMO])) break; if (sp > XB_SPIN_CAP) { atomicAdd(&bar[XB_TMO], 1u); break; } }
    }
    nloc = mine > 0u ? mine : 1u; nx = cnt > 0u ? cnt : 1u;
}

__device__ __forceinline__ void xcd_barrier(const XcdBarrier& b) {
    asm volatile("s_waitcnt vmcnt(0)" ::: "memory");
    __syncthreads();
    if (threadIdx.x == 0) {
        unsigned* bar = b.bar;
        __builtin_amdgcn_s_waitcnt(0);
        unsigned nloc = b.st[0], nx = b.st[1];
        if (nloc == 0u) { xcd_barrier_complete(bar, b.x, nloc, nx); b.st[0] = nloc; b.st[1] = nx; }
        const unsigned old = xb_add(&bar[XB_XSUB(b.x)], 1u);
        const unsigned gen = old / nloc;
        if (old + 1u == (gen + 1u) * nloc) {
            __builtin_amdgcn_fence(__ATOMIC_RELEASE, "agent");
            asm volatile("s_waitcnt vmcnt(0)" ::: "memory");
            const unsigned og = xb_add(&bar[XB_TOP], 1u);
            const unsigned tg = og / nx;
            if (og + 1u == (tg + 1u) * nx) xb_add(&bar[XB_TOPGEN], 1u);
            else XB_SPIN(xb_ld(&bar[XB_TOPGEN]) == tg, bar);
            __builtin_amdgcn_fence(__ATOMIC_ACQUIRE, "agent");
            xb_add(&bar[XB_XGEN(b.x)], 1u);
            asm volatile("s_waitcnt vmcnt(0)" ::: "memory");
        } else {
            XB_SPIN(xb_ld(&bar[XB_XGEN(b.x)]) == gen, bar);
            __builtin_amdgcn_fence(__ATOMIC_ACQUIRE, "agent");
            asm volatile("s_waitcnt vmcnt(0)" ::: "memory");
        }
    }
    __syncthreads();
}
#define GSYNC() do { XcdBarrier xb_; xb_.bar = (unsigned*)(kparams().ws + OFF_BAR); xb_.x = xb_xcc_id(); xb_.st = (volatile LAS unsigned*)xb_words; xcd_barrier(xb_); } while (0)

__global__ void __launch_bounds__(512) mega(Params p_) {
  __shared__ __attribute__((aligned(16))) char smem[147456];
  cg::grid_group grid = cg::this_grid();
  __shared__ __attribute__((aligned(16))) unsigned xb_words[4];
  if (tidx() < 4) xb_words[tidx()] = 0u;
  __syncthreads();
  if (p_.ph_lo < 0) grid.sync();
  (void)xcd_barrier_post((unsigned*)(p_.ws + OFF_BAR), (volatile LAS unsigned*)xb_words);
  int ph = p_.ph_lo;
  const int ph_hi = p_.ph_hi;
  if (ph == 0 && ph < ph_hi) {
    phase0(smem);
    ph++;
    if (ph < ph_hi) GSYNC();
  }
  if (ph == 1 && ph < ph_hi) {
    phase1(smem);
    ph++;
    if (ph < ph_hi) GSYNC();
  }
  for (; ph < ph_hi && ph < NPHASE - 1; ph++) {
    const int l = (ph - 2) / 7, k = (ph - 2) % 7;
    if (k == 0) gemm_phase<EPI_IN>(l, smem);
    else if (k == 1) { qkpost_phase(l); ssm1_phase(l); }
    else if (k == 2) {
      const int first = (blockIdx.x >> 3) & 1;
      for (int s2 = 0; s2 < 2; s2++) {
        __syncthreads();
        if ((s2 ^ first) == 0) attn_phase(smem);
        else ssm2_phase(l, smem);
      }
    }
    else if (k == 3) gemm_phase<EPI_GLU>(l, smem);
    else if (k == 4) gemm_phase<EPI_OUT>(l, smem);
    else if (k == 5) gemm_phase<EPI_F1>(l, smem);
    else gemm_phase<EPI_F2>(l, smem);
    if (ph + 1 < ph_hi) GSYNC();
  }
  if (ph == NPHASE - 1 && ph < ph_hi) final_phase();
}

extern "C" void kernel_launch(void* const* d_in, const int* in_sizes, int n_in, void* d_out, int out_size, void* d_ws,
                              size_t ws_size, hipStream_t stream) {
  static int grid_blocks = 0;
  if (!grid_blocks) {
    int dev = 0, cus = 0;
    (void)hipGetDevice(&dev);
    (void)hipDeviceGetAttribute(&cus, hipDeviceAttributeMultiprocessorCount, dev);
    grid_blocks = cus;
    if (grid_blocks < 8 || (grid_blocks & 7)) grid_blocks = 256;
    if (ws_size < WS_TOTAL) fprintf(stderr, "kernel_launch: workspace too small: %zu < %zu\n", ws_size, (size_t)WS_TOTAL);
  }
  if (ws_size < WS_TOTAL) return;
  Params p{};
  const float** pp = (const float**)&p;
  for (int i = 0; i < 25; i++) pp[i] = (const float*)d_in[i];
  p.out = (float*)d_out;
  p.ws = (char*)d_ws;
  p.ph_lo = 0;
  p.ph_hi = NPHASE;
  (void)hipMemsetAsync((char*)d_ws + OFF_BAR, 0, 16384, stream);
  void* args[] = {&p};
  hipError_t e = hipLaunchCooperativeKernel((void*)mega, dim3(grid_blocks), dim3(512), args, 0, stream);
  if (e != hipSuccess) fprintf(stderr, "cooperative launch failed: %s (grid %d)\n", hipGetErrorString(e), grid_blocks);
}
```

```cpp
#include <hip/hip_runtime.h>
#include <hip/hip_cooperative_groups.h>
#include <cstdio>
namespace cg = cooperative_groups;

typedef __attribute__((ext_vector_type(8))) short bf16x8;
typedef __attribute__((ext_vector_type(16))) float f32x16;
typedef __attribute__((ext_vector_type(2))) __bf16 bf2v;
typedef __attribute__((ext_vector_type(2))) float f2v;
typedef unsigned short u16;

#define DI __device__ __forceinline__
#define MFMA(a, b, c) __builtin_amdgcn_mfma_f32_32x32x16_bf16((a), (b), (c), 0, 0, 0)

constexpr int T_TOK = 32768;
constexpr int NPHASE = 31;
constexpr float QSCALE = 0.125f * 1.4426950408889634f;

constexpr size_t OFF_WT_IN  = 0;
constexpr size_t OFF_WT_GLU = OFF_WT_IN + 10485760;
constexpr size_t OFF_WT_OUT = OFF_WT_GLU + 2097152;
constexpr size_t OFF_WT_F1  = OFF_WT_OUT + 8388608;
constexpr size_t OFF_WT_F2  = OFF_WT_F1 + 46137344;
constexpr size_t OFF_MOD    = OFF_WT_F2 + 23068672;
constexpr size_t OFF_BIAS1  = OFF_MOD + 786432;
constexpr size_t OFF_BIAS2  = OFF_BIAS1 + 163840;
constexpr size_t OFF_ROPE   = OFF_BIAS2 + 720896;
constexpr size_t OFF_SSMA   = OFF_ROPE + 8192;
constexpr size_t OFF_SSMBB  = OFF_SSMA + 262144;
constexpr size_t OFF_SSMCC  = OFF_SSMBB + 1048576;
constexpr size_t OFF_E      = OFF_SSMCC + 1048576;
constexpr size_t OFF_SSX    = OFF_E + 4194304;
constexpr size_t OFF_SSA    = OFF_SSX + 2097152;
constexpr size_t OFF_SSS    = OFF_SSA + 1048576;
constexpr size_t OFF_X      = OFF_SSS + 1048576;
constexpr size_t OFF_ACT    = OFF_X + 134217728;
constexpr size_t OFF_UNION  = OFF_ACT + 67108864;
constexpr size_t OFF_HID    = OFF_UNION;
constexpr size_t OFF_Q      = OFF_UNION;
constexpr size_t OFF_K      = OFF_Q + 33554432;
constexpr size_t OFF_VT     = OFF_K + 8388608;
constexpr size_t OFF_U2     = OFF_VT + 8388608;
constexpr size_t OFF_YG     = OFF_U2 + 33554432;
constexpr size_t OFF_OATT   = OFF_YG + 33554432;
constexpr size_t OFF_OSSM   = OFF_OATT + 33554432;
constexpr size_t OFF_BAR    = OFF_UNION + 184549376;
constexpr size_t WS_TOTAL   = OFF_BAR + 16384;

struct Params {
  const float *x, *c, *w_ada, *b_ada, *norm1, *w_in, *q_norm, *k_norm, *lam_re, *lam_im, *log_dt,
      *b_re, *b_im, *c_re, *c_im, *ssm_d, *w_glu, *b_glu, *attn_out_norm, *ssm_out_norm, *w_out, *norm2,
      *w_ffn_in, *w_ffn_out, *final_norm;
  float* out;
  char* ws;
  int ph_lo, ph_hi;
};

DI unsigned pk(float a, float b) {
  f2v v = {a, b};
  bf2v r = __builtin_convertvector(v, bf2v);
  return __builtin_bit_cast(unsigned, r);
}
DI int tidx() { int t = __builtin_amdgcn_workitem_id_x(); asm volatile("" : "+v"(t)); return t; }
typedef const Params __attribute__((address_space(4)))* KParamPtr;
DI Params kparams() {
#if defined(__HIP_DEVICE_COMPILE__)
  KParamPtr q = (KParamPtr)__builtin_amdgcn_kernarg_segment_ptr();
  asm volatile("" : "+s"(q));
  return *q;
#else
  return Params{};
#endif
}
DI int vtid() { return tidx() & 255; }
DI int vhalf() { return tidx() >> 8; }
DI float bf2f(unsigned short h) { return __uint_as_float(((unsigned)h) << 16); }
DI void st_bf4(u16* dst, float a, float b, float c, float d) {
  uint2 v; v.x = pk(a, b); v.y = pk(c, d);
  *(uint2*)dst = v;
}
DI float4 ld_bf4(const u16* src) {
  uint2 v = *(const uint2*)src;
  float4 r;
  r.x = __uint_as_float(v.x << 16); r.y = __uint_as_float(v.x & 0xffff0000u);
  r.z = __uint_as_float(v.y << 16); r.w = __uint_as_float(v.y & 0xffff0000u);
  return r;
}
DI float shfl_x32(float v, int hi) {
  auto r = __builtin_amdgcn_permlane32_swap(__float_as_uint(v), __float_as_uint(v), false, false);
  return __uint_as_float(hi ? r[0] : r[1]);
}
DI float row16_sum(float v) {
  v += __int_as_float(__builtin_amdgcn_update_dpp(0, __float_as_int(v), 0x121, 0xf, 0xf, false));
  v += __int_as_float(__builtin_amdgcn_update_dpp(0, __float_as_int(v), 0x122, 0xf, 0xf, false));
  v += __int_as_float(__builtin_amdgcn_update_dpp(0, __float_as_int(v), 0x124, 0xf, 0xf, false));
  v += __int_as_float(__builtin_amdgcn_update_dpp(0, __float_as_int(v), 0x128, 0xf, 0xf, false));
  return v;
}
DI float wave_sum(float v) {
  v = row16_sum(v);
  v += __int_as_float(__builtin_amdgcn_ds_swizzle(__float_as_int(v), 0x401F));
  const int hi = (tidx() >> 5) & 1;
  return v + shfl_x32(v, hi);
}
DI size_t tl_idx(int t, int n) { return ((size_t)(n >> 6) * T_TOK + t) * 64 + (n & 63); }
DI int crow(int r, int hf) { return (r & 3) + 8 * (r >> 2) + 4 * hf; }
DI int f1perm(int n) {
  int j = (n < 2816) ? n : n - 2816;
  return (j >> 5) * 64 + (j & 31) + ((n < 2816) ? 0 : 32);
}

DI void transpose_tile(const float* __restrict__ src, int N, u16* __restrict__ dst, int K, int k0, int n0,
                       int permmode, const float* __restrict__ kscale, float* tl) {
  const int tid = vtid();
  __syncthreads();
#pragma unroll 4
  for (int i = 0; i < 16; i++) {
    int r = (tid >> 6) + 4 * i;
    float v = src[(size_t)(k0 + r) * N + n0 + (tid & 63)];
    if (kscale) v *= kscale[k0 + r];
    tl[r * 65 + (tid & 63)] = v;
  }
  __syncthreads();
#pragma unroll 4
  for (int i = 0; i < 8; i++) {
    int n = (tid >> 5) + 8 * i;
    int kp = tid & 31;
    float a = tl[(2 * kp) * 65 + n], b = tl[(2 * kp + 1) * 65 + n];
    int nn = n0 + n;
    int no = permmode ? f1perm(nn) : nn;
    *(unsigned*)(dst + ((size_t)(k0 >> 6) * N + no) * 64 + 2 * kp) = pk(a, b);
  }
}

DI void gemv8_item(const float* vec, int vstride, bool do_silu, const float* __restrict__ W, int N, int j0,
                   const float* bias, float* out, int ostride, int permmode, float* sm) {
  const int tid = vtid();
  float* vs = sm;
  float* red = sm + 8192;
  __syncthreads();
  for (int i = tid; i < 8192; i += 256) {
    int b = i >> 10, k = i & 1023;
    float v = vec[(size_t)b * vstride + k];
    if (do_silu) v = v / (1.f + expf(-v));
    vs[i] = v;
  }
  __syncthreads();
  const int kq = tid >> 6, jj = tid & 63;
  float acc[8];
#pragma unroll
  for (int b = 0; b < 8; b++) acc[b] = 0.f;
#pragma unroll 4
  for (int k = kq * 256; k < kq * 256 + 256; k++) {
    float w = W[(size_t)k * N + j0 + jj];
#pragma unroll
    for (int b = 0; b < 8; b++) acc[b] += vs[b * 1024 + k] * w;
  }
#pragma unroll
  for (int b = 0; b < 8; b++) red[(kq * 8 + b) * 64 + jj] = acc[b];
  __syncthreads();
  for (int o = tid; o < 512; o += 256) {
    int b = o >> 6, j = o & 63;
    float s = red[(0 * 8 + b) * 64 + j] + red[(8 + b) * 64 + j] + red[(16 + b) * 64 + j] + red[(24 + b) * 64 + j];
    int jg = j0 + j;
    if (bias) s += bias[jg];
    int jo = permmode ? f1perm(jg) : jg;
    out[(size_t)b * ostride + jo] = s;
  }
}

DI void ssm_param_item(const Params& p, int idx) {
  const int tid = vtid();
  const int pp = tid & 63, cq = tid >> 6;
  float* SSMA = (float*)(p.ws + OFF_SSMA);
  u16* BB = (u16*)(p.ws + OFF_SSMBB);
  u16* CC = (u16*)(p.ws + OFF_SSMCC);
  double lr = (double)p.lam_re[idx * 64 + pp];
  if (lr > -1e-4) lr = (double)(-1e-4f);
  double li = (double)p.lam_im[idx * 64 + pp];
  double dt = exp((double)p.log_dt[idx]);
  double mag = exp(lr * dt);
  double ar = mag * cos(li * dt), ai = mag * sin(li * dt);
  double den = lr * lr + li * li;
  double nre = ar - 1.0;
  double kre = (nre * lr + ai * li) / den;
  double kim = (ai * lr - nre * li) / den;
  if (cq == 0) {
    double magL = exp(lr * dt * 256.0);
    float4 v;
    v.x = (float)ar; v.y = (float)ai;
    v.z = (float)(magL * cos(li * dt * 256.0)); v.w = (float)(magL * sin(li * dt * 256.0));
    *(float4*)(SSMA + (size_t)(idx * 64 + pp) * 4) = v;
  }
#pragma unroll
  for (int cc = 0; cc < 4; cc++) {
    int c = cq * 4 + cc;
    double br = (double)p.b_re[(size_t)(idx * 64 + pp) * 16 + c];
    double bi = (double)p.b_im[(size_t)(idx * 64 + pp) * 16 + c];
    float bbr = (float)(kre * br - kim * bi);
    float bbi = (float)(kre * bi + kim * br);
    BB[(size_t)(idx * 128 + pp) * 16 + c] = (u16)(pk(bbr, 0.f) & 0xffffu);
    BB[(size_t)(idx * 128 + 64 + pp) * 16 + c] = (u16)(pk(bbi, 0.f) & 0xffffu);
    float cr = p.c_re[(size_t)(idx * 16 + c) * 64 + pp];
    float ci = p.c_im[(size_t)(idx * 16 + c) * 64 + pp];
    *(unsigned*)(CC + (size_t)(idx * 16 + c) * 128 + 2 * pp) = pk(cr, -ci);
  }
}

DI void phase0(char* smem) {
  const Params p = kparams();
  float* sm = (float*)(smem + vhalf() * 40960);
  constexpr int N_TIN = 4 * 16 * 20, N_TGLU = 4 * 8 * 8, N_TOUT = 4 * 16 * 16, N_TF1 = 4 * 16 * 88, N_TF2 = 4 * 44 * 16;
  constexpr int N_MOD = 4 * 96, N_SSM = 256, N_ROPE = 1;
  constexpr int S0 = N_MOD, S1 = S0 + N_TIN, S2 = S1 + N_TGLU, S3 = S2 + N_TOUT, S4 = S3 + N_TF1, S5 = S4 + N_TF2,
                S6 = S5 + N_SSM, S7 = S6 + N_ROPE;
  for (int it = blockIdx.x * 2 + vhalf(); it < S7 + 1; it += gridDim.x * 2) {
    if (it < S0) {
      int l = it / 96, jb = it % 96;
      gemv8_item(p.c, 1024, true, p.w_ada + (size_t)l * 1024 * 6144, 6144, jb * 64, p.b_ada + l * 6144,
                 (float*)(p.ws + OFF_MOD) + (size_t)l * 8 * 6144, 6144, 0, sm);
    } else if (it < S1) {
      int r = it - S0; int l = r / 320; r %= 320; int kt = r / 20, ntile = r % 20;
      transpose_tile(p.w_in + (size_t)l * 1024 * 1280, 1280, (u16*)(p.ws + OFF_WT_IN) + (size_t)l * 1280 * 1024, 1024,
                     kt * 64, ntile * 64, 0, nullptr, sm);
    } else if (it < S2) {
      int r = it - S1; int l = r / 64; r %= 64; int kt = r / 8, ntile = r % 8;
      transpose_tile(p.w_glu + (size_t)l * 512 * 512, 512, (u16*)(p.ws + OFF_WT_GLU) + (size_t)l * 512 * 512, 512,
                     kt * 64, ntile * 64, 0, nullptr, sm);
    } else if (it < S3) {
      int r = it - S2; int l = r / 256; r %= 256; int kt = r / 16, ntile = r % 16;
      const float* ks = (kt < 8) ? (p.attn_out_norm + l * 512) : (p.ssm_out_norm + l * 512 - 512);
      transpose_tile(p.w_out + (size_t)l * 1024 * 1024, 1024, (u16*)(p.ws + OFF_WT_OUT) + (size_t)l * 1024 * 1024, 1024,
                     kt * 64, ntile * 64, 0, ks, sm);
    } else if (it < S4) {
      int r = it - S3; int l = r / 1408; r %= 1408; int kt = r / 88, ntile = r % 88;
      transpose_tile(p.w_ffn_in + (size_t)l * 1024 * 5632, 5632, (u16*)(p.ws + OFF_WT_F1) + (size_t)l * 5632 * 1024, 1024,
                     kt * 64, ntile * 64, 1, nullptr, sm);
    } else if (it < S5) {
      int r = it - S4; int l = r / 704; r %= 704; int kt = r / 16, ntile = r % 16;
      transpose_tile(p.w_ffn_out + (size_t)l * 2816 * 1024, 1024, (u16*)(p.ws + OFF_WT_F2) + (size_t)l * 1024 * 2816, 2816,
                     kt * 64, ntile * 64, 0, nullptr, sm);
    } else if (it < S6) {
      ssm_param_item(p, it - S5);
    } else {
      float* rope = (float*)(p.ws + OFF_ROPE);
      for (int i = vtid(); i < 1024; i += 256) {
        int idx = i >> 4, f = i & 15;
        double ang = (double)idx * pow(10000.0, -(double)f / 16.0);
        rope[i] = (float)cos(ang);
        rope[1024 + i] = (float)sin(ang);
      }
    }
  }
}

DI void phase1(char* smem) {
  const Params p = kparams();
  float* sm = (float*)(smem + vhalf() * 40960);
  const float* MOD = (const float*)(p.ws + OFF_MOD);
  constexpr int N_B1 = 4 * 20, N_B2 = 4 * 88, N_PREP = T_TOK / 4;
  for (int it = blockIdx.x * 2 + vhalf(); it < N_B1 + N_B2 + N_PREP; it += gridDim.x * 2) {
    if (it < N_B1) {
      int l = it / 20, jb = it % 20;
      gemv8_item(MOD + (size_t)l * 8 * 6144 + 0, 6144, false, p.w_in + (size_t)l * 1024 * 1280, 1280, jb * 64, nullptr,
                 (float*)(p.ws + OFF_BIAS1) + (size_t)l * 8 * 1280, 1280, 0, sm);
    } else if (it < N_B1 + N_B2) {
      int r = it - N_B1; int l = r / 88, jb = r % 88;
      gemv8_item(MOD + (size_t)l * 8 * 6144 + 3072, 6144, false, p.w_ffn_in + (size_t)l * 1024 * 5632, 5632, jb * 64, nullptr,
                 (float*)(p.ws + OFF_BIAS2) + (size_t)l * 8 * 5632, 5632, 1, sm);
    } else {
      int r = it - N_B1 - N_B2;
      const int lane = vtid() & 63, wave = vtid() >> 6;
      int t = r * 4 + wave;
      int b = t >> 12;
      const float4* xr = (const float4*)(p.x + (size_t)t * 1024);
      float4 v[4];
      float ss = 0.f;
#pragma unroll
      for (int i = 0; i < 4; i++) {
        v[i] = xr[lane + 64 * i];
        ss += v[i].x * v[i].x + v[i].y * v[i].y + v[i].z * v[i].z + v[i].w * v[i].w;
      }
      ss = wave_sum(ss);
      float* SSX = (float*)(p.ws + OFF_SSX);
      if (lane < 16) SSX[(size_t)t * 16 + lane] = (lane == 0) ? ss : 0.f;
      u16* ACT = (u16*)(p.ws + OFF_ACT);
      const float* sc1 = MOD + (size_t)(0 * 8 + b) * 6144 + 1024;
#pragma unroll
      for (int i = 0; i < 4; i++) {
        int k = (lane + 64 * i) * 4;
        float4 g = *(const float4*)(p.norm1 + k);
        float4 s = *(const float4*)(sc1 + k);
        st_bf4(ACT + tl_idx(t, k), v[i].x * g.x * (1.f + s.x), v[i].y * g.y * (1.f + s.y),
               v[i].z * g.z * (1.f + s.z), v[i].w * g.w * (1.f + s.w));
      }
    }
  }
}

enum { EPI_IN = 0, EPI_GLU = 1, EPI_OUT = 2, EPI_F1 = 3, EPI_F2 = 4 };

DI float row_rinv16(const float* ssx, int t, float invn) {
  const float4* q = (const float4*)(ssx + (size_t)t * 16);
  float4 a = q[0], b = q[1], c = q[2], d = q[3];
  float s = ((a.x + a.y) + (a.z + a.w)) + ((b.x + b.y) + (b.z + b.w)) + ((c.x + c.y) + (c.z + c.w)) + ((d.x + d.y) + (d.z + d.w));
  return rsqrtf(s * invn + 1e-6f);
}
DI float row_rinv8(const float* ss8, int t, float invn) {
  const float4* q = (const float4*)(ss8 + (size_t)t * 8);
  float4 a = q[0], b = q[1];
  float s = ((a.x + a.y) + (a.z + a.w)) + ((b.x + b.y) + (b.z + b.w));
  return rsqrtf(s * invn + 1e-6f);
}

template <int EPI>
DI void gemm_tile(const Params& p, const int l, const int mt, const int nt, char* smem, uint4& ra0, uint4& ra1, uint4& ra2, uint4& ra3,
               uint4& rb0, uint4& rb1, uint4& rb2, uint4& rb3, const bool first, const bool has_next, const int mt_next, const int nt_next) {
  constexpr int TJ = 4;
  constexpr int K = (EPI == EPI_GLU) ? 512 : (EPI == EPI_F2 ? 2816 : 1024);
  constexpr int KT = K / 64;
  u16* As = (u16*)smem;
  u16* Bs = As + 256 * 72;
  const int tid = tidx(), lane = tid & 63, wave = tid >> 6;
  const int wm = wave >> 2, wn = wave & 3;
  const int hf = lane >> 5, li = lane & 31;
  const int m0 = mt * 256, n0 = nt * 256;

  const u16* A0;
  const u16* A1 = nullptr;
  const u16* W;
  if (EPI == EPI_IN) { A0 = (const u16*)(p.ws + OFF_ACT); W = (const u16*)(p.ws + OFF_WT_IN) + (size_t)l * 1280 * 1024; }
  else if (EPI == EPI_GLU) { A0 = (const u16*)(p.ws + OFF_YG); W = (const u16*)(p.ws + OFF_WT_GLU) + (size_t)l * 512 * 512; }
  else if (EPI == EPI_OUT) { A0 = (const u16*)(p.ws + OFF_OATT); A1 = (const u16*)(p.ws + OFF_OSSM); W = (const u16*)(p.ws + OFF_WT_OUT) + (size_t)l * 1024 * 1024; }
  else if (EPI == EPI_F1) { A0 = (const u16*)(p.ws + OFF_ACT); W = (const u16*)(p.ws + OFF_WT_F1) + (size_t)l * 5632 * 1024; }
  else { A0 = (const u16*)(p.ws + OFF_HID); W = (const u16*)(p.ws + OFF_WT_F2) + (size_t)l * 1024 * 2816; }

  const int lrow = tid >> 3, lc8 = tid & 7;
  constexpr int NW = (EPI == EPI_IN) ? 1280 : (EPI == EPI_GLU ? 512 : (EPI == EPI_F1 ? 5632 : 1024));
  constexpr size_t AKT = (size_t)T_TOK * 64, WKT = (size_t)NW * 64;
  const u16* ag0 = A0 + (size_t)(m0 + lrow) * 64 + lc8 * 8;
  const u16* ag1 = (EPI == EPI_OUT) ? (A1 + (size_t)(m0 + lrow) * 64 + lc8 * 8) : nullptr;
  const u16* wg = W + (size_t)(n0 + lrow) * 64 + lc8 * 8;

  f32x16 acc[2][TJ];
#pragma unroll
  for (int i = 0; i < 2; i++)
#pragma unroll
    for (int j = 0; j < TJ; j++)
#pragma unroll
      for (int r = 0; r < 16; r++) acc[i][j][r] = 0.f;

#define GEMM_GLOAD_R(kt_, A0_, A1_, A2_, A3_, B0_, B1_, B2_, B3_)                                 \
  {                                                                                              \
    const u16* ap;                                                                               \
    if (EPI == EPI_OUT) ap = ((kt_) < 8) ? (ag0 + (kt_) * AKT) : (ag1 + (long)((kt_) - 8) * (long)AKT);      \
    else ap = ag0 + (kt_) * AKT;                                                                 \
    const u16* wp = wg + (kt_) * WKT;                                                            \
    A0_ = *(const uint4*)(ap);                                                                   \
    A1_ = *(const uint4*)(ap + 64 * 64);                                                         \
    A2_ = *(const uint4*)(ap + 128 * 64);                                                        \
    A3_ = *(const uint4*)(ap + 192 * 64);                                                        \
    B0_ = *(const uint4*)(wp);                                                                   \
    B1_ = *(const uint4*)(wp + 64 * 64);                                                         \
    B2_ = *(const uint4*)(wp + 128 * 64);                                                        \
    B3_ = *(const uint4*)(wp + 192 * 64);                                                        \
  }
#define GEMM_LSTORE_R(boff_, A0_, A1_, A2_, A3_, B0_, B1_, B2_, B3_) \
  {                                                                \
    u16* a_ = As + (boff_) + lrow * 72 + lc8 * 8;                  \
    u16* b_ = Bs + (boff_) + lrow * 72 + lc8 * 8;                  \
    *(uint4*)(a_) = A0_;                                           \
    *(uint4*)(a_ + 64 * 72) = A1_;                                 \
    *(uint4*)(a_ + 128 * 72) = A2_;                                \
    *(uint4*)(a_ + 192 * 72) = A3_;                                \
    *(uint4*)(b_) = B0_;                                           \
    *(uint4*)(b_ + 64 * 72) = B1_;                                 \
    *(uint4*)(b_ + 128 * 72) = B2_;                                \
    *(uint4*)(b_ + 192 * 72) = B3_;                                \
  }
#define GEMM_COMPUTE(cur_, DOST_, oth_, A0_, A1_, A2_, A3_, B0_, B1_, B2_, B3_)                                          \
  {                                                                                                                     \
    u16* a_ = As + (oth_) + lrow * 72 + lc8 * 8;                                                                        \
    u16* b_ = Bs + (oth_) + lrow * 72 + lc8 * 8;                                                                        \
    _Pragma("unroll") for (int s = 0; s < 4; s++) {                                                                     \
      bf16x8 wf[2], af[TJ];                                                                                             \
      _Pragma("unroll") for (int i = 0; i < 2; i++)                                                                     \
        wf[i] = *(const bf16x8*)(Bs + (cur_) + (wn * 64 + i * 32 + li) * 72 + s * 16 + hf * 8);                         \
      _Pragma("unroll") for (int j = 0; j < TJ; j++)                                                                    \
        af[j] = *(const bf16x8*)(As + (cur_) + (wm * 128 + j * 32 + li) * 72 + s * 16 + hf * 8);                        \
      _Pragma("unroll") for (int i = 0; i < 2; i++)                                                                     \
        _Pragma("unroll") for (int j = 0; j < TJ; j++) acc[i][j] = MFMA(wf[i], af[j], acc[i][j]);                       \
        \
      if (DOST_) {                                                                                                      \
        if (s == 0) { *(uint4*)(a_) = A0_; *(uint4*)(a_ + 64 * 72) = A1_; }                                             \
        if (s == 1) { *(uint4*)(a_ + 128 * 72) = A2_; *(uint4*)(a_ + 192 * 72) = A3_; }                                 \
        if (s == 2) { *(uint4*)(b_) = B0_; *(uint4*)(b_ + 64 * 72) = B1_; }                                             \
        if (s == 3) { *(uint4*)(b_ + 128 * 72) = B2_; *(uint4*)(b_ + 192 * 72) = B3_; }                                 \
      }                                                                                                                 \
    }                                                                                                                   \
  }
  constexpr int BUF = 2 * 256 * 72;
  uint4 sa0, sa1, sa2, sa3, sb0, sb1, sb2, sb3;
  if (first) GEMM_GLOAD_R(0, ra0, ra1, ra2, ra3, rb0, rb1, rb2, rb3);
  GEMM_GLOAD_R(1, sa0, sa1, sa2, sa3, sb0, sb1, sb2, sb3);
  int tok[TJ];
#pragma unroll
  for (int j = 0; j < TJ; j++) tok[j] = m0 + wm * 128 + j * 32 + li;

  __syncthreads();
  GEMM_LSTORE_R(0, ra0, ra1, ra2, ra3, rb0, rb1, rb2, rb3);
  GEMM_GLOAD_R(2, ra0, ra1, ra2, ra3, rb0, rb1, rb2, rb3);
  __syncthreads();
#pragma unroll 1
  for (int kt = 0; kt < KT; kt += 2) {
    if (EPI == EPI_OUT) {
      if (kt == 8) {
#pragma unroll
        for (int j = 0; j < TJ; j++) {
          const float ra_ = row_rinv8((const float*)(p.ws + OFF_SSA), tok[j], 1.f / 512.f);
          const float rs_ = row_rinv8((const float*)(p.ws + OFF_SSS), tok[j], 1.f / 512.f);
          const float mr = ra_ / rs_;
#pragma unroll
          for (int i = 0; i < 2; i++)
#pragma unroll
            for (int r = 0; r < 16; r++) acc[i][j][r] *= mr;
        }
      }
    }
    GEMM_COMPUTE(0, true, BUF, sa0, sa1, sa2, sa3, sb0, sb1, sb2, sb3);
    if (kt + 3 < KT) GEMM_GLOAD_R(kt + 3, sa0, sa1, sa2, sa3, sb0, sb1, sb2, sb3);
    __syncthreads();
    GEMM_COMPUTE(BUF, (kt + 2 < KT), 0, ra0, ra1, ra2, ra3, rb0, rb1, rb2, rb3);
    if (kt + 4 < KT) GEMM_GLOAD_R(kt + 4, ra0, ra1, ra2, ra3, rb0, rb1, rb2, rb3);
    __syncthreads();
  }
  if (has_next && EPI != EPI_OUT && EPI != EPI_F2) {
    const u16* ap = A0 + (size_t)(mt_next * 256 + lrow) * 64 + lc8 * 8;
    const u16* wp = W + (size_t)(nt_next * 256 + lrow) * 64 + lc8 * 8;
    ra0 = *(const uint4*)(ap);
    ra1 = *(const uint4*)(ap + 64 * 64);
    ra2 = *(const uint4*)(ap + 128 * 64);
    ra3 = *(const uint4*)(ap + 192 * 64);
    rb0 = *(const uint4*)(wp);
    rb1 = *(const uint4*)(wp + 64 * 64);
    rb2 = *(const uint4*)(wp + 128 * 64);
    rb3 = *(const uint4*)(wp + 192 * 64);
  }

  const int b = m0 >> 12;
  const int nbase = n0 + wn * 64;
  const float* MOD = (const float*)(p.ws + OFF_MOD);

  if (EPI == EPI_IN) {
    const float* bias = (const float*)(p.ws + OFF_BIAS1) + (size_t)(l * 8 + b) * 1280;
    const float* SSX = (const float*)(p.ws + OFF_SSX);
    float rinv[TJ];
#pragma unroll
    for (int j = 0; j < TJ; j++) rinv[j] = row_rinv16(SSX, tok[j], 1.f / 1024.f);
#pragma unroll
    for (int i = 0; i < 2; i++)
#pragma unroll
      for (int q4 = 0; q4 < 4; q4++) {
        float4 b4 = *(const float4*)(bias + nbase + i * 32 + 8 * q4 + 4 * hf);
#pragma unroll
        for (int j = 0; j < TJ; j++) {
          acc[i][j][4 * q4 + 0] = acc[i][j][4 * q4 + 0] * rinv[j] + b4.x;
          acc[i][j][4 * q4 + 1] = acc[i][j][4 * q4 + 1] * rinv[j] + b4.y;
          acc[i][j][4 * q4 + 2] = acc[i][j][4 * q4 + 2] * rinv[j] + b4.z;
          acc[i][j][4 * q4 + 3] = acc[i][j][4 * q4 + 3] * rinv[j] + b4.w;
        }
      }
    if (nbase < 640) {
#pragma unroll
      for (int j = 0; j < TJ; j++) {
        const int t = tok[j], pos = t & 4095;
#pragma unroll
        for (int i = 0; i < 2; i++)
#pragma unroll
          for (int q4 = 0; q4 < 4; q4++) {
            const int d0 = i * 32 + 8 * q4 + 4 * hf;
            u16* dst = (nbase < 512) ? ((u16*)(p.ws + OFF_Q) + (size_t)t * 512 + nbase + d0)
                                     : ((u16*)(p.ws + OFF_K) + ((size_t)(b * 2 + ((nbase - 512) >> 6)) * 4096 + pos) * 64 + d0);
            st_bf4(dst, acc[i][j][4 * q4 + 0], acc[i][j][4 * q4 + 1], acc[i][j][4 * q4 + 2], acc[i][j][4 * q4 + 3]);
          }
      }
    } else if (nbase < 768) {
      u16* VT = (u16*)(p.ws + OFF_VT);
      const int vh = (nbase - 640) >> 6;
#pragma unroll
      for (int j = 0; j < TJ; j++) {
        const int pos = tok[j] & 4095;
#pragma unroll
        for (int i = 0; i < 2; i++)
#pragma unroll
          for (int r = 0; r < 16; r++) {
            int d = i * 32 + crow(r, hf);
            VT[((size_t)(b * 2 + vh) * 64 + d) * 4096 + pos] = (u16)(pk(acc[i][j][r], 0.f) & 0xffffu);
          }
      }
    } else {
      u16* U2 = (u16*)(p.ws + OFF_U2);
      const int ch0 = nbase - 768;
#pragma unroll
      for (int j = 0; j < TJ; j++) {
        const int pos = tok[j] & 4095;
#pragma unroll
        for (int i = 0; i < 2; i++)
#pragma unroll
          for (int q4 = 0; q4 < 4; q4++) {
            int ch = ch0 + i * 32 + 8 * q4 + 4 * hf;
            int g = ch >> 4, c0 = ch & 15;
            st_bf4(U2 + (((size_t)(b * 32 + g)) * 4096 + pos) * 16 + c0, acc[i][j][4 * q4 + 0], acc[i][j][4 * q4 + 1],
                   acc[i][j][4 * q4 + 2], acc[i][j][4 * q4 + 3]);
          }
      }
    }
  } else if (EPI == EPI_GLU) {
    const float* bg = p.b_glu + l * 512;
    const u16* YG = (const u16*)(p.ws + OFF_YG);
    u16* OSSM = (u16*)(p.ws + OFF_OSSM);
    float* SSS = (float*)(p.ws + OFF_SSS);
#pragma unroll
    for (int j = 0; j < TJ; j++) {
      const int t = tok[j];
      float ss = 0.f;
#pragma unroll
      for (int i = 0; i < 2; i++)
#pragma unroll
        for (int q4 = 0; q4 < 4; q4++) {
          const int n = nbase + i * 32 + 8 * q4 + 4 * hf;
          float4 b4 = *(const float4*)(bg + n);
          float4 y = ld_bf4(YG + tl_idx(t, n));
          float o0 = y.x / (1.f + __expf(-(acc[i][j][4 * q4 + 0] + b4.x)));
          float o1 = y.y / (1.f + __expf(-(acc[i][j][4 * q4 + 1] + b4.y)));
          float o2 = y.z / (1.f + __expf(-(acc[i][j][4 * q4 + 2] + b4.z)));
          float o3 = y.w / (1.f + __expf(-(acc[i][j][4 * q4 + 3] + b4.w)));
          ss += o0 * o0 + o1 * o1 + o2 * o2 + o3 * o3;
          st_bf4(OSSM + tl_idx(t, n), o0, o1, o2, o3);
        }
      ss += shfl_x32(ss, hf);
      if (hf == 0) SSS[(size_t)t * 8 + (nbase >> 6)] = ss;
    }
  } else if (EPI == EPI_OUT || EPI == EPI_F2) {
    const float* gate = MOD + (size_t)(l * 8 + b) * 6144 + (EPI == EPI_OUT ? 2048 : 5120);
    const bool has_next = (EPI == EPI_OUT) || (l < 3);
    const float* nrm = (EPI == EPI_OUT) ? (p.norm2 + l * 1024) : (p.norm1 + (l + 1) * 1024);
    const float* scn = (EPI == EPI_OUT) ? (MOD + (size_t)(l * 8 + b) * 6144 + 4096) : (MOD + (size_t)((l + 1) * 8 + b) * 6144 + 1024);
    const float* xin = (EPI == EPI_OUT && l == 0) ? p.x : (const float*)(p.ws + OFF_X);
    float* X = (float*)(p.ws + OFF_X);
    u16* ACT = (u16*)(p.ws + OFF_ACT);
    float* SSX = (float*)(p.ws + OFF_SSX);
    float* stg = (float*)smem + wave * (32 * 68);
    const int rr = lane >> 4, c4 = (lane & 15) * 4;
    const int n = nbase + c4;
    const float4 g4 = *(const float4*)(gate + n);
    float4 nsc = make_float4(0.f, 0.f, 0.f, 0.f);
    if (has_next) {
      const float4 nr = *(const float4*)(nrm + n);
      const float4 sc = *(const float4*)(scn + n);
      nsc = make_float4(nr.x * (1.f + sc.x), nr.y * (1.f + sc.y), nr.z * (1.f + sc.z), nr.w * (1.f + sc.w));
    }
    float4 xi[8], xn[8];
    float fj[TJ];
#pragma unroll
    for (int j = 0; j < TJ; j++) fj[j] = (EPI == EPI_OUT) ? row_rinv8((const float*)(p.ws + OFF_SSS), tok[j], 1.f / 512.f) : 1.f;
#pragma unroll
    for (int it = 0; it < 8; it++) xi[it] = *(const float4*)(xin + (size_t)(m0 + wm * 128 + rr + 4 * it) * 1024 + n);
#pragma unroll
    for (int j = 0; j < TJ; j++) {
#pragma unroll
      for (int i = 0; i < 2; i++)
#pragma unroll
        for (int q4 = 0; q4 < 4; q4++)
          *(float4*)(stg + li * 68 + i * 32 + 8 * q4 + 4 * hf) =
              make_float4(acc[i][j][4 * q4 + 0] * fj[j], acc[i][j][4 * q4 + 1] * fj[j], acc[i][j][4 * q4 + 2] * fj[j], acc[i][j][4 * q4 + 3] * fj[j]);
      asm volatile("s_waitcnt lgkmcnt(0)" ::: "memory");
      if (j + 1 < TJ) {
#pragma unroll
        for (int it = 0; it < 8; it++) xn[it] = *(const float4*)(xin + (size_t)(m0 + wm * 128 + (j + 1) * 32 + rr + 4 * it) * 1024 + n);
      }
#pragma unroll
      for (int it = 0; it < 8; it++) {
        const int row = rr + 4 * it;
        const int t = m0 + wm * 128 + j * 32 + row;
        const float4 a = *(const float4*)(stg + row * 68 + c4);
        float4 y;
        y.x = xi[it].x + g4.x * a.x;
        y.y = xi[it].y + g4.y * a.y;
        y.z = xi[it].z + g4.z * a.z;
        y.w = xi[it].w + g4.w * a.w;
        *(float4*)(X + (size_t)t * 1024 + n) = y;
        float ss = y.x * y.x + y.y * y.y + y.z * y.z + y.w * y.w;
        ss = row16_sum(ss);
        if ((lane & 15) == 0) SSX[(size_t)t * 16 + (nbase >> 6)] = ss;
        if (has_next) st_bf4(ACT + tl_idx(t, n), y.x * nsc.x, y.y * nsc.y, y.z * nsc.z, y.w * nsc.w);
      }
      asm volatile("s_waitcnt lgkmcnt(0)" ::: "memory");
      if (j + 1 < TJ) {
#pragma unroll
        for (int it = 0; it < 8; it++) xi[it] = xn[it];
      }
    }
  } else {
    const float* bias = (const float*)(p.ws + OFF_BIAS2) + (size_t)(l * 8 + b) * 5632;
    const float* SSX = (const float*)(p.ws + OFF_SSX);
    u16* HID = (u16*)(p.ws + OFF_HID);
    const int jbase = nbase >> 1;
#pragma unroll
    for (int j = 0; j < TJ; j++) {
      const int t = tok[j];
      const float rv = row_rinv16(SSX, t, 1.f / 1024.f);
#pragma unroll
      for (int q4 = 0; q4 < 4; q4++) {
        const int ng = nbase + 8 * q4 + 4 * hf;
        float4 bg4 = *(const float4*)(bias + ng);
        float4 bu4 = *(const float4*)(bias + ng + 32);
        float zg0 = acc[0][j][4 * q4 + 0] * rv + bg4.x, zu0 = acc[1][j][4 * q4 + 0] * rv + bu4.x;
        float zg1 = acc[0][j][4 * q4 + 1] * rv + bg4.y, zu1 = acc[1][j][4 * q4 + 1] * rv + bu4.y;
        float zg2 = acc[0][j][4 * q4 + 2] * rv + bg4.z, zu2 = acc[1][j][4 * q4 + 2] * rv + bu4.z;
        float zg3 = acc[0][j][4 * q4 + 3] * rv + bg4.w, zu3 = acc[1][j][4 * q4 + 3] * rv + bu4.w;
        float h0 = zg0 / (1.f + __expf(-zg0)) * zu0;
        float h1 = zg1 / (1.f + __expf(-zg1)) * zu1;
        float h2 = zg2 / (1.f + __expf(-zg2)) * zu2;
        float h3 = zg3 / (1.f + __expf(-zg3)) * zu3;
        st_bf4(HID + tl_idx(t, jbase + 8 * q4 + 4 * hf), h0, h1, h2, h3);
      }
    }
  }
}

template <int EPI>
DI void gemm_phase(int l, char* smem) {
  const Params p = kparams();
  constexpr int NT = (EPI == EPI_IN) ? 5 : (EPI == EPI_GLU ? 2 : (EPI == EPI_F1 ? 22 : 4));
  const int g8 = gridDim.x >> 3;
  const int xg = blockIdx.x & 7, lb = blockIdx.x >> 3;
  uint4 ra0, ra1, ra2, ra3, rb0, rb1, rb2, rb3;
  bool first = true;
  for (int q = lb; q < 16 * NT; q += g8) {
    const int mg = q / (8 * NT);
    const int rem = q - mg * 8 * NT;
    const int qn = q + g8;
    const bool has_next = qn < 16 * NT;
    const int mgn = qn / (8 * NT);
    const int remn = qn - mgn * 8 * NT;
    gemm_tile<EPI>(p, l, xg * 16 + mg * 8 + (rem & 7), rem >> 3, smem, ra0, ra1, ra2, ra3, rb0, rb1, rb2, rb3, first, has_next,
                   xg * 16 + mgn * 8 + (remn & 7), remn >> 3);
    first = (EPI == EPI_OUT || EPI == EPI_F2);
  }
}

DI void attn_item(const Params& p, int item, char* smem) {
  u16* Ks = (u16*)smem;
  u16* Vs = Ks + 64 * 72;
  const int tid = tidx(), lane = tid & 63, wave = tid >> 6;
  const int hf = lane >> 5, li = lane & 31;
  const int xcd = item & 7, local = item >> 3;
  const int pair = xcd * 2 + (local >> 5);
  const int within = local & 31;
  const int hq = within >> 3, qb = within & 7;
  const int b = pair >> 1, kvh = pair & 1, h = kvh * 4 + hq;
  const int t0 = b * 4096 + qb * 512 + wave * 64 + li;

  const u16* Q = (const u16*)(p.ws + OFF_Q);
  bf16x8 qf[2][4];
#pragma unroll
  for (int u = 0; u < 2; u++)
#pragma unroll
    for (int s = 0; s < 4; s++) qf[u][s] = *(const bf16x8*)(Q + (size_t)(t0 + 32 * u) * 512 + h * 64 + 16 * s + 8 * hf);

  f32x16 o0[2], o1[2];
  float m_run[2], l_run[2];
#pragma unroll
  for (int u = 0; u < 2; u++) {
#pragma unroll
    for (int r = 0; r < 16; r++) { o0[u][r] = 0.f; o1[u][r] = 0.f; }
    m_run[u] = -1e30f; l_run[u] = 0.f;
  }

  const int lrow = tid >> 3, lc8 = tid & 7;
  const u16* Kg = (const u16*)(p.ws + OFF_K) + (size_t)pair * 4096 * 64 + (size_t)lrow * 64 + lc8 * 8;
  const u16* Vg = (const u16*)(p.ws + OFF_VT) + (size_t)pair * 64 * 4096 + (size_t)lrow * 4096 + lc8 * 8;
  uint4 rk0, rv0;
#define ATT_GLOAD(kt_)                                                   \
  {                                                                      \
    rk0 = *(const uint4*)(Kg + (size_t)((kt_) * 64) * 64);               \
    rv0 = *(const uint4*)(Vg + (kt_) * 64);                              \
  }
  ATT_GLOAD(0);
  const int kap = (li & 0x13) | ((li & 4) << 1) | ((li & 8) >> 1);

  for (int kt = 0; kt < 64; kt++) {
    __syncthreads();
    *(uint4*)(Ks + (lrow) * 72 + lc8 * 8) = rk0;
    *(uint4*)(Vs + (lrow) * 72 + lc8 * 8) = rv0;
    __syncthreads();
    if (kt + 1 < 64) ATT_GLOAD(kt + 1);

    f32x16 s0[2], s1[2];
#pragma unroll
    for (int u = 0; u < 2; u++)
#pragma unroll
      for (int r = 0; r < 16; r++) { s0[u][r] = 0.f; s1[u][r] = 0.f; }
#pragma unroll
    for (int s = 0; s < 4; s++) {
      const bf16x8 kf0 = *(const bf16x8*)(Ks + kap * 72 + 16 * s + 8 * hf);
      const bf16x8 kf1 = *(const bf16x8*)(Ks + (32 + kap) * 72 + 16 * s + 8 * hf);
#pragma unroll
      for (int u = 0; u < 2; u++) {
        s0[u] = MFMA(kf0, qf[u][s], s0[u]);
        s1[u] = MFMA(kf1, qf[u][s], s1[u]);
      }
    }
    bf16x8 pb[2][4];
#pragma unroll
    for (int u = 0; u < 2; u++) {
      float mx = s0[u][0];
#pragma unroll
      for (int r = 1; r < 16; r++) mx = fmaxf(mx, s0[u][r]);
#pragma unroll
      for (int r = 0; r < 16; r++) mx = fmaxf(mx, s1[u][r]);
      mx = fmaxf(mx, shfl_x32(mx, hf));
      const float mnew = fmaxf(m_run[u], mx);
      const float alpha = __builtin_amdgcn_exp2f(m_run[u] - mnew);
      m_run[u] = mnew;
      float ps = 0.f;
#pragma unroll
      for (int r = 0; r < 16; r++) { s0[u][r] = __builtin_amdgcn_exp2f(s0[u][r] - mnew); ps += s0[u][r]; }
#pragma unroll
      for (int r = 0; r < 16; r++) { s1[u][r] = __builtin_amdgcn_exp2f(s1[u][r] - mnew); ps += s1[u][r]; }
      l_run[u] = l_run[u] * alpha + ps;
#pragma unroll
      for (int r = 0; r < 16; r++) { o0[u][r] *= alpha; o1[u][r] *= alpha; }
#pragma unroll
      for (int sp = 0; sp < 2; sp++) {
        uint4 ua = make_uint4(pk(s0[u][8 * sp + 0], s0[u][8 * sp + 1]), pk(s0[u][8 * sp + 2], s0[u][8 * sp + 3]),
                              pk(s0[u][8 * sp + 4], s0[u][8 * sp + 5]), pk(s0[u][8 * sp + 6], s0[u][8 * sp + 7]));
        uint4 ub = make_uint4(pk(s1[u][8 * sp + 0], s1[u][8 * sp + 1]), pk(s1[u][8 * sp + 2], s1[u][8 * sp + 3]),
                              pk(s1[u][8 * sp + 4], s1[u][8 * sp + 5]), pk(s1[u][8 * sp + 6], s1[u][8 * sp + 7]));
        pb[u][sp] = __builtin_bit_cast(bf16x8, ua);
        pb[u][2 + sp] = __builtin_bit_cast(bf16x8, ub);
      }
    }
#pragma unroll
    for (int c = 0; c < 4; c++) {
      const bf16x8 vf0 = *(const bf16x8*)(Vs + li * 72 + 16 * c + 8 * hf);
      const bf16x8 vf1 = *(const bf16x8*)(Vs + (32 + li) * 72 + 16 * c + 8 * hf);
#pragma unroll
      for (int u = 0; u < 2; u++) {
        o0[u] = MFMA(vf0, pb[u][c], o0[u]);
        o1[u] = MFMA(vf1, pb[u][c], o1[u]);
      }
    }
  }
  u16* OATT = (u16*)(p.ws + OFF_OATT);
#pragma unroll
  for (int u = 0; u < 2; u++) {
    const int t = t0 + 32 * u;
    const float ltot = l_run[u] + shfl_x32(l_run[u], hf);
    const float inv = 1.f / ltot;
    float ss = 0.f;
#pragma unroll
    for (int q4 = 0; q4 < 4; q4++) {
      float a0 = o0[u][4 * q4 + 0] * inv, a1 = o0[u][4 * q4 + 1] * inv, a2 = o0[u][4 * q4 + 2] * inv, a3 = o0[u][4 * q4 + 3] * inv;
      float c0 = o1[u][4 * q4 + 0] * inv, c1 = o1[u][4 * q4 + 1] * inv, c2 = o1[u][4 * q4 + 2] * inv, c3 = o1[u][4 * q4 + 3] * inv;
      ss += a0 * a0 + a1 * a1 + a2 * a2 + a3 * a3 + c0 * c0 + c1 * c1 + c2 * c2 + c3 * c3;
      st_bf4(OATT + tl_idx(t, h * 64 + 8 * q4 + 4 * hf), a0, a1, a2, a3);
      st_bf4(OATT + tl_idx(t, h * 64 + 32 + 8 * q4 + 4 * hf), c0, c1, c2, c3);
    }
    ss += shfl_x32(ss, hf);
    if (hf == 0) ((float*)(p.ws + OFF_SSA))[(size_t)t * 8 + h] = ss;
  }
}

DI bf16x8 ssm_ufrag(const u16* U2, int bp, int g, int tb, int li, int hf) {
  const int seq = (li >> 2) & 1, step = ((li >> 3) << 2) | (li & 3);
  return *(const bf16x8*)(U2 + (((size_t)((2 * bp + seq) * 32 + g)) * 4096 + tb + step) * 16 + 8 * hf);
}

DI void ssm_scan16(const f32x16& x0, const f32x16& x1, const f32x16& x2, const f32x16& x3, const float4 a0, const float4 a1,
                   float& h0r, float& h0i, float& h1r, float& h1i, const int dir) {
  if (dir == 0) {
#pragma unroll
    for (int r = 0; r < 16; r++) {
      float nr = a0.x * h0r - a0.y * h0i + x0[r], ni = a0.x * h0i + a0.y * h0r + x2[r];
      h0r = nr; h0i = ni;
      float mr = a1.x * h1r - a1.y * h1i + x1[r], mi = a1.x * h1i + a1.y * h1r + x3[r];
      h1r = mr; h1i = mi;
    }
  } else {
#pragma unroll
    for (int r = 15; r >= 0; r--) {
      float nr = a0.x * h0r - a0.y * h0i + x0[r], ni = a0.x * h0i + a0.y * h0r + x2[r];
      h0r = nr; h0i = ni;
      float mr = a1.x * h1r - a1.y * h1i + x1[r], mi = a1.x * h1i + a1.y * h1r + x3[r];
      h1r = mr; h1i = mi;
    }
  }
}

DI void ssm1_item(const Params& p, int l, int item) {
  const int tid = vtid(), lane = tid & 63, wave = __builtin_amdgcn_readfirstlane(tid >> 6);
  const int hf = lane >> 5, li = lane & 31;
  const int w = item * 4 + wave;
  const int ch = w & 15, bp = (w >> 4) & 3, g = (w >> 6) & 31, dir = w >> 11;
  const int idx = (l * 2 + dir) * 32 + g;
  const u16* U2 = (const u16*)(p.ws + OFF_U2);
  const u16* BB = (const u16*)(p.ws + OFF_SSMBB) + (size_t)idx * 128 * 16;
  const float* SA = (const float*)(p.ws + OFF_SSMA) + (size_t)idx * 64 * 4;
  bf16x8 bbf[4];
#pragma unroll
  for (int j = 0; j < 4; j++) bbf[j] = *(const bf16x8*)(BB + (32 * j + li) * 16 + 8 * hf);
  const float4 a0 = *(const float4*)(SA + li * 4);
  const float4 a1 = *(const float4*)(SA + (li + 32) * 4);
  float h0r = 0.f, h0i = 0.f, h1r = 0.f, h1i = 0.f;
  f32x16 zero;
#pragma unroll
  for (int r = 0; r < 16; r++) zero[r] = 0.f;
#define SSM_TB(it_) (ch * 256 + (dir ? (15 - (it_)) : (it_)) * 16)
  bf16x8 q0 = ssm_ufrag(U2, bp, g, SSM_TB(0), li, hf), q1 = ssm_ufrag(U2, bp, g, SSM_TB(1), li, hf);
  bf16x8 q2 = ssm_ufrag(U2, bp, g, SSM_TB(2), li, hf), q3 = ssm_ufrag(U2, bp, g, SSM_TB(3), li, hf);
#pragma unroll 1
  for (int it = 0; it < 16; it++) {
    const bf16x8 uf = q0;
    q0 = q1; q1 = q2; q2 = q3;
    const int itn = (it + 4 < 16) ? (it + 4) : 15;
    q3 = ssm_ufrag(U2, bp, g, SSM_TB(itn), li, hf);
    f32x16 x0 = MFMA(uf, bbf[0], zero), x1 = MFMA(uf, bbf[1], zero), x2 = MFMA(uf, bbf[2], zero), x3 = MFMA(uf, bbf[3], zero);
    ssm_scan16(x0, x1, x2, x3, a0, a1, h0r, h0i, h1r, h1i, dir);
  }
  float* E = (float*)(p.ws + OFF_E) + ((((size_t)(dir * 32 + g) * 8 + (2 * bp + hf)) * 16 + ch) * 64) * 2;
  *(float2*)(E + li * 2) = make_float2(h0r, h0i);
  *(float2*)(E + (li + 32) * 2) = make_float2(h1r, h1i);
}

DI void ssm2_item(const Params& p, int l, int item, char* smem) {
  const int tid = vtid(), lane = tid & 63, wave = __builtin_amdgcn_readfirstlane(tid >> 6);
  const int hf = lane >> 5, li = lane & 31;
  const int w = item * 4 + wave;
  const int ch = w & 15, bp = (w >> 4) & 3, g = w >> 6;
  u16* Hs = (u16*)smem + wave * (32 * 136);
  const u16* U2 = (const u16*)(p.ws + OFF_U2);
  float* YF = (float*)(p.ws + OFF_ACT);
  u16* YG = (u16*)(p.ws + OFF_YG);
  f32x16 zero;
#pragma unroll
  for (int r = 0; r < 16; r++) zero[r] = 0.f;
  const int oseq = li >> 4, ostep = li & 15;
  const int ob = 2 * bp + oseq;

  for (int dir = 0; dir < 2; dir++) {
    const int idx = (l * 2 + dir) * 32 + g;
    const u16* BB = (const u16*)(p.ws + OFF_SSMBB) + (size_t)idx * 128 * 16;
    const u16* CC = (const u16*)(p.ws + OFF_SSMCC) + (size_t)idx * 16 * 128;
    const float* SA = (const float*)(p.ws + OFF_SSMA) + (size_t)idx * 64 * 4;
    bf16x8 bbf[4], ccf[8];
#pragma unroll
    for (int j = 0; j < 4; j++) bbf[j] = *(const bf16x8*)(BB + (32 * j + li) * 16 + 8 * hf);
#pragma unroll
    for (int s = 0; s < 8; s++) {
      bf16x8 v = *(const bf16x8*)(CC + (li & 15) * 128 + 16 * s + 8 * hf);
      if (li >= 16) {
#pragma unroll
        for (int e = 0; e < 8; e++) v[e] = 0;
      }
      ccf[s] = v;
    }
    const float4 a0 = *(const float4*)(SA + li * 4);
    const float4 a1 = *(const float4*)(SA + (li + 32) * 4);
    float h0r = 0.f, h0i = 0.f, h1r = 0.f, h1i = 0.f;
    {
      const float* E = (const float*)(p.ws + OFF_E) + ((((size_t)(dir * 32 + g) * 8 + (2 * bp + hf)) * 16) * 64) * 2;
      const int n = dir ? (15 - ch) : ch;
      for (int i0 = 0; i0 < n; i0 += 4) {
        float2 e0[4], e1[4];
#pragma unroll
        for (int u = 0; u < 4; u++) {
          int ii = i0 + u; if (ii > n - 1) ii = n - 1;
          const int ci = dir ? (15 - ii) : ii;
          e0[u] = *(const float2*)(E + (size_t)ci * 128 + li * 2);
          e1[u] = *(const float2*)(E + (size_t)ci * 128 + (li + 32) * 2);
        }
#pragma unroll
        for (int u = 0; u < 4; u++) {
          if (i0 + u < n) {
            float nr = a0.z * h0r - a0.w * h0i + e0[u].x, ni = a0.z * h0i + a0.w * h0r + e0[u].y;
            h0r = nr; h0i = ni;
            float mr = a1.z * h1r - a1.w * h1i + e1[u].x, mi = a1.z * h1i + a1.w * h1r + e1[u].y;
            h1r = mr; h1i = mi;
          }
        }
      }
    }
    bf16x8 ufn = ssm_ufrag(U2, bp, g, ch * 256 + (dir ? 15 : 0) * 16, li, hf);
    for (int it = 0; it < 16; it++) {
      const int tb = ch * 256 + (dir ? (15 - it) : it) * 16;
      const bf16x8 uf = ufn;
      f32x16 x0 = MFMA(uf, bbf[0], zero), x1 = MFMA(uf, bbf[1], zero), x2 = MFMA(uf, bbf[2], zero), x3 = MFMA(uf, bbf[3], zero);
      if (it + 1 < 16) ufn = ssm_ufrag(U2, bp, g, ch * 256 + (dir ? (14 - it) : (it + 1)) * 16, li, hf);
      const int tt = tb + ostep;
      const size_t yoff = (((size_t)(ob * 32 + g)) * 4096 + tt) * 16;
      float4 f0 = make_float4(0.f, 0.f, 0.f, 0.f), f1 = f0, u0 = f0, u1 = f0;
      if (dir) {
        f0 = *(const float4*)(YF + yoff + 4 * hf);
        f1 = *(const float4*)(YF + yoff + 8 + 4 * hf);
        u0 = ld_bf4(U2 + yoff + 4 * hf);
        u1 = ld_bf4(U2 + yoff + 8 + 4 * hf);
      }
      asm volatile("s_waitcnt lgkmcnt(0)" ::: "memory");
      if (dir == 0) {
#pragma unroll
        for (int r = 0; r < 16; r++) {
          float nr = a0.x * h0r - a0.y * h0i + x0[r], ni = a0.x * h0i + a0.y * h0r + x2[r];
          h0r = nr; h0i = ni;
          float mr = a1.x * h1r - a1.y * h1i + x1[r], mi = a1.x * h1i + a1.y * h1r + x3[r];
          h1r = mr; h1i = mi;
          *(unsigned*)(Hs + (hf * 16 + r) * 136 + 2 * li) = pk(h0r, h0i);
          *(unsigned*)(Hs + (hf * 16 + r) * 136 + 2 * (li + 32)) = pk(h1r, h1i);
        }
      } else {
#pragma unroll
        for (int r = 15; r >= 0; r--) {
          float nr = a0.x * h0r - a0.y * h0i + x0[r], ni = a0.x * h0i + a0.y * h0r + x2[r];
          h0r = nr; h0i = ni;
          float mr = a1.x * h1r - a1.y * h1i + x1[r], mi = a1.x * h1i + a1.y * h1r + x3[r];
          h1r = mr; h1i = mi;
          *(unsigned*)(Hs + (hf * 16 + r) * 136 + 2 * li) = pk(h0r, h0i);
          *(unsigned*)(Hs + (hf * 16 + r) * 136 + 2 * (li + 32)) = pk(h1r, h1i);
        }
      }
      asm volatile("s_waitcnt lgkmcnt(0)" ::: "memory");
      f32x16 y = zero;
#pragma unroll
      for (int s = 0; s < 8; s++) {
        bf16x8 hfv = *(const bf16x8*)(Hs + li * 136 + 16 * s + 8 * hf);
        y = MFMA(ccf[s], hfv, y);
      }
      if (dir == 0) {
        *(float4*)(YF + yoff + 4 * hf) = make_float4(y[0], y[1], y[2], y[3]);
        *(float4*)(YF + yoff + 8 + 4 * hf) = make_float4(y[4], y[5], y[6], y[7]);
      } else {
        float4 d0 = *(const float4*)(p.ssm_d + l * 512 + g * 16 + 4 * hf);
        float4 d1 = *(const float4*)(p.ssm_d + l * 512 + g * 16 + 8 + 4 * hf);
        float v[8];
        v[0] = f0.x + y[0] + d0.x * u0.x; v[1] = f0.y + y[1] + d0.y * u0.y;
        v[2] = f0.z + y[2] + d0.z * u0.z; v[3] = f0.w + y[3] + d0.w * u0.w;
        v[4] = f1.x + y[4] + d1.x * u1.x; v[5] = f1.y + y[5] + d1.y * u1.y;
        v[6] = f1.z + y[6] + d1.z * u1.z; v[7] = f1.w + y[7] + d1.w * u1.w;
#pragma unroll
        for (int e = 0; e < 8; e++) {
          float xx = v[e];
          float z = 0.7978845608028654f * (xx + 0.044715f * xx * xx * xx);
          float th = 1.f - 2.f / (__expf(2.f * z) + 1.f);
          v[e] = 0.5f * xx * (1.f + th);
        }
        u16* yg = YG + tl_idx(ob * 4096 + tt, g * 16);
        st_bf4(yg + 4 * hf, v[0], v[1], v[2], v[3]);
        st_bf4(yg + 8 + 4 * hf, v[4], v[5], v[6], v[7]);
      }
    }
    asm volatile("s_waitcnt lgkmcnt(0)" ::: "memory");
  }
}

DI void qkpost_phase(int l) {
  const Params p = kparams();
  const float* ROPE = (const float*)(p.ws + OFF_ROPE);
  const int nrows = T_TOK * 8 + T_TOK * 2;
  for (int r = blockIdx.x * 512 + tidx(); r < nrows; r += gridDim.x * 512) {
    const bool isq = r < T_TOK * 8;
    const int rk = r - T_TOK * 8;
    u16* row = isq ? ((u16*)(p.ws + OFF_Q) + (size_t)r * 64) : ((u16*)(p.ws + OFF_K) + (size_t)rk * 64);
    const int pos = isq ? ((r >> 3) & 4095) : (rk & 4095);
    const float* gn = isq ? (p.q_norm + l * 64) : (p.k_norm + l * 64);
    const float osc = isq ? QSCALE : 1.f;
    float v[64];
#pragma unroll
    for (int c = 0; c < 8; c++) {
      uint4 raw = ((const uint4*)row)[c];
      v[8 * c + 0] = __uint_as_float(raw.x << 16); v[8 * c + 1] = __uint_as_float(raw.x & 0xffff0000u);
      v[8 * c + 2] = __uint_as_float(raw.y << 16); v[8 * c + 3] = __uint_as_float(raw.y & 0xffff0000u);
      v[8 * c + 4] = __uint_as_float(raw.z << 16); v[8 * c + 5] = __uint_as_float(raw.z & 0xffff0000u);
      v[8 * c + 6] = __uint_as_float(raw.w << 16); v[8 * c + 7] = __uint_as_float(raw.w & 0xffff0000u);
    }
    float ss = 0.f;
#pragma unroll
    for (int e = 0; e < 64; e++) ss += v[e] * v[e];
    const float rn = rsqrtf(ss * (1.f / 64.f) + 1e-6f) * osc;
    const int irow = pos >> 6, icol = pos & 63;
    float tc[32], ts[32];
#pragma unroll
    for (int q = 0; q < 4; q++) {
      const float4 c0 = *(const float4*)(ROPE + irow * 16 + 4 * q), s0 = *(const float4*)(ROPE + 1024 + irow * 16 + 4 * q);
      const float4 c1 = *(const float4*)(ROPE + icol * 16 + 4 * q), s1 = *(const float4*)(ROPE + 1024 + icol * 16 + 4 * q);
      tc[4 * q + 0] = c0.x; tc[4 * q + 1] = c0.y; tc[4 * q + 2] = c0.z; tc[4 * q + 3] = c0.w;
      ts[4 * q + 0] = s0.x; ts[4 * q + 1] = s0.y; ts[4 * q + 2] = s0.z; ts[4 * q + 3] = s0.w;
      tc[16 + 4 * q + 0] = c1.x; tc[16 + 4 * q + 1] = c1.y; tc[16 + 4 * q + 2] = c1.z; tc[16 + 4 * q + 3] = c1.w;
      ts[16 + 4 * q + 0] = s1.x; ts[16 + 4 * q + 1] = s1.y; ts[16 + 4 * q + 2] = s1.z; ts[16 + 4 * q + 3] = s1.w;
    }
#pragma unroll
    for (int c = 0; c < 8; c++) {
      float o[8];
#pragma unroll
      for (int e = 0; e < 4; e++) {
        const int pi = 4 * c + e;
        const float cs = tc[pi], sn = ts[pi];
        const float y0 = v[2 * pi] * rn * gn[2 * pi], y1 = v[2 * pi + 1] * rn * gn[2 * pi + 1];
        o[2 * e] = y0 * cs - y1 * sn;
        o[2 * e + 1] = y0 * sn + y1 * cs;
      }
      uint4 w;
      w.x = pk(o[0], o[1]); w.y = pk(o[2], o[3]); w.z = pk(o[4], o[5]); w.w = pk(o[6], o[7]);
      ((uint4*)row)[c] = w;
    }
  }
}

DI void attn_phase(char* smem) {
  const Params p = kparams();
  for (int lq = blockIdx.x >> 3; lq < 64; lq += (gridDim.x >> 3)) attn_item(p, (blockIdx.x & 7) + 8 * lq, smem);
}
DI void ssm1_phase(int l) {
  const Params p = kparams();
  for (int it = blockIdx.x * 2 + vhalf(); it < 1024; it += gridDim.x * 2) ssm1_item(p, l, it);
}
DI void ssm2_phase(int l, char* smem) {
  const Params p = kparams();
  char* sm = smem + vhalf() * 40960;
  for (int it = blockIdx.x * 2 + vhalf(); it < 512; it += gridDim.x * 2) ssm2_item(p, l, it, sm);
}

DI void final_phase() {
  const Params p = kparams();
  const float* X = (const float*)(p.ws + OFF_X);
  const float* SSX = (const float*)(p.ws + OFF_SSX);
  const int total = T_TOK * 256;
  for (int i = blockIdx.x * 512 + tidx(); i < total; i += gridDim.x * 512) {
    int t = i >> 8, n = (i & 255) * 4;
    float rv = row_rinv16(SSX, t, 1.f / 1024.f);
    float4 x = *(const float4*)(X + (size_t)t * 1024 + n);
    float4 g = *(const float4*)(p.final_norm + n);
    float4 o;
    o.x = x.x * rv * g.x; o.y = x.y * rv * g.y; o.z = x.z * rv * g.z; o.w = x.w * rv * g.w;
    *(float4*)(p.out + (size_t)t * 1024 + n) = o;
  }
}

#define XB_TMO      128
#define XB_XCNT(j)  (256  + 64 * (j))
#define XB_XSUB(j)  (1280 + 64 * (j))
#define XB_XGEN(j)  (2304 + 64 * (j))
#define XB_TOP      3328
#define XB_TOPGEN   3392
#define XCD_BAR_WORDS 3456
#define XB_SPIN_CAP (1u << 18)
#define LAS __attribute__((address_space(3)))

__device__ __forceinline__ unsigned xb_ld(unsigned* p)              { return __hip_atomic_load(p, __ATOMIC_RELAXED, __HIP_MEMORY_SCOPE_AGENT); }
__device__ __forceinline__ unsigned xb_add(unsigned* p, unsigned v) { return __hip_atomic_fetch_add(p, v, __ATOMIC_RELAXED, __HIP_MEMORY_SCOPE_AGENT); }
__device__ __forceinline__ unsigned xb_xcc_id() { return (unsigned)__builtin_amdgcn_s_getreg((3 << 11) | 20) & 0xFu; }
#define XB_SPIN(cond, bar) do { unsigned _sp = 0; while (cond) { __builtin_amdgcn_s_sleep(1); \
    if ((++_sp & 255u) == 0u) { if (xb_ld(&(bar)[XB_TMO])) break; if (_sp > XB_SPIN_CAP) { atomicAdd(&(bar)[XB_TMO], 1u); break; } } } } while (0)

struct XcdBarrier {
    unsigned* bar; unsigned x;
    volatile LAS unsigned* st;
};

__device__ __forceinline__ XcdBarrier xcd_barrier_post(unsigned* bar, volatile LAS unsigned* st) {
    XcdBarrier b; b.bar = bar; b.x = xb_xcc_id(); b.st = st;
    if (threadIdx.x == 0) (void)xb_add(&bar[XB_XCNT(b.x)], 1u);
    return b;
}
__device__ __forceinline__ void xcd_barrier_complete(unsigned* bar, unsigned x, unsigned& nloc, unsigned& nx) {
    const unsigned G = gridDim.x * gridDim.y * gridDim.z;
    unsigned sum, cnt, mine, sp = 0u;
    for (;;) {
        sum = 0u; cnt = 0u; mine = 0u;
#pragma unroll
        for (unsigned j = 0; j < 16; ++j) { const unsigned c = xb_ld(&bar[XB_XCNT(j)]); sum += c; cnt += (c > 0u) ? 1u : 0u; mine = (j == x) ? c : mine; }
        if (sum == G) break;
        __builtin_amdgcn_s_sleep(1);
        if ((++sp & 255u) == 0u) { if (xb_ld(&bar[XB_TMO])) break; if (sp > XB_SPIN_CAP) { atomicAdd(&bar[XB_TMO], 1u); break; } }
    }
    nloc = mine > 0u ? mine : 1u; nx = cnt > 0u ? cnt : 1u;
}

__device__ __forceinline__ void xcd_barrier(const XcdBarrier& b) {
    asm volatile("s_waitcnt vmcnt(0)" ::: "memory");
    __syncthreads();
    if (threadIdx.x == 0) {
        unsigned* bar = b.bar;
        __builtin_amdgcn_s_waitcnt(0);
        unsigned nloc = b.st[0], nx = b.st[1];
        if (nloc == 0u) { xcd_barrier_complete(bar, b.x, nloc, nx); b.st[0] = nloc; b.st[1] = nx; }
        const unsigned old = xb_add(&bar[XB_XSUB(b.x)], 1u);
        const unsigned gen = old / nloc;
        if (old + 1u == (gen + 1u) * nloc) {
            __builtin_amdgcn_fence(__ATOMIC_RELEASE, "agent");
            asm volatile("s_waitcnt vmcnt(0)" ::: "memory");
            const unsigned og = xb_add(&bar[XB_TOP], 1u);
            const unsigned tg = og / nx;
            if (og + 1u == (tg + 1u) * nx) xb_add(&bar[XB_TOPGEN], 1u);
            else XB_SPIN(xb_ld(&bar[XB_TOPGEN]) == tg, bar);
            __builtin_amdgcn_fence(__ATOMIC_ACQUIRE, "agent");
            xb_add(&bar[XB_XGEN(b.x)], 1u);
            asm volatile("s_waitcnt vmcnt(0)" ::: "memory");
        } else {
            XB_SPIN(xb_ld(&bar[XB_XGEN(b.x)]) == gen, bar);
            __builtin_amdgcn_fence(__ATOMIC_ACQUIRE, "agent");
            asm volatile("s_waitcnt vmcnt(0)" ::: "memory");
        }
    }
    __syncthreads();
}
#define GSYNC() do { XcdBarrier xb_; xb_.bar = (unsigned*)(kparams().ws + OFF_BAR); xb_.x = xb_xcc_id(); xb_.st = (volatile LAS unsigned*)xb_words; xcd_barrier(xb_); } while (0)

__global__ void __launch_bounds__(512) mega(Params p_) {
  __shared__ __attribute__((aligned(16))) char smem[147456];
  cg::grid_group grid = cg::this_grid();
  __shared__ __attribute__((aligned(16))) unsigned xb_words[4];
  if (tidx() < 4) xb_words[tidx()] = 0u;
  __syncthreads();
  if (p_.ph_lo < 0) grid.sync();
  (void)xcd_barrier_post((unsigned*)(p_.ws + OFF_BAR), (volatile LAS unsigned*)xb_words);
  int ph = p_.ph_lo;
  const int ph_hi = p_.ph_hi;
  if (ph == 0 && ph < ph_hi) {
    phase0(smem);
    ph++;
    if (ph < ph_hi) GSYNC();
  }
  if (ph == 1 && ph < ph_hi) {
    phase1(smem);
    ph++;
    if (ph < ph_hi) GSYNC();
  }
  for (; ph < ph_hi && ph < NPHASE - 1; ph++) {
    const int l = (ph - 2) / 7, k = (ph - 2) % 7;
    if (k == 0) gemm_phase<EPI_IN>(l, smem);
    else if (k == 1) { qkpost_phase(l); ssm1_phase(l); }
    else if (k == 2) {
      const int first = (blockIdx.x >> 3) & 1;
      for (int s2 = 0; s2 < 2; s2++) {
        __syncthreads();
        if ((s2 ^ first) == 0) attn_phase(smem);
        else ssm2_phase(l, smem);
      }
    }
    else if (k == 3) gemm_phase<EPI_GLU>(l, smem);
    else if (k == 4) gemm_phase<EPI_OUT>(l, smem);
    else if (k == 5) gemm_phase<EPI_F1>(l, smem);
    else gemm_phase<EPI_F2>(l, smem);
    if (ph + 1 < ph_hi) GSYNC();
  }
  if (ph == NPHASE - 1 && ph < ph_hi) final_phase();
}

extern "C" void kernel_launch(void* const* d_in, const int* in_sizes, int n_in, void* d_out, int out_size, void* d_ws,
                              size_t ws_size, hipStream_t stream) {
  static int grid_blocks = 0;
  if (!grid_blocks) {
    int dev = 0, cus = 0;
    (void)hipGetDevice(&dev);
    (void)hipDeviceGetAttribute(&cus, hipDeviceAttributeMultiprocessorCount, dev);
    grid_blocks = cus;
    if (grid_blocks < 8 || (grid_blocks & 7)) grid_blocks = 256;
    if (ws_size < WS_TOTAL) fprintf(stderr, "kernel_launch: workspace too small: %zu < %zu\n", ws_size, (size_t)WS_TOTAL);
  }
  if (ws_size < WS_TOTAL) return;
  Params p{};
  const float** pp = (const float**)&p;
  for (int i = 0; i < 25; i++) pp[i] = (const float*)d_in[i];
  p.out = (float*)d_out;
  p.ws = (char*)d_ws;
  p.ph_lo = 0;
  p.ph_hi = NPHASE;
  (void)hipMemsetAsync((char*)d_ws + OFF_BAR, 0, 16384, stream);
  void* args[] = {&p};
  hipError_t e = hipLaunchCooperativeKernel((void*)mega, dim3(grid_blocks), dim3(512), args, 0, stream);
  if (e != hipSuccess) fprintf(stderr, "cooperative launch failed: %s (grid %d)\n", hipGetErrorString(e), grid_blocks);
}
```

```cpp
#include <hip/hip_runtime.h>
#include <hip/hip_cooperative_groups.h>
#include <cstdio>
namespace cg = cooperative_groups;

typedef __attribute__((ext_vector_type(8))) short bf16x8;
typedef __attribute__((ext_vector_type(16))) float f32x16;
typedef __attribute__((ext_vector_type(2))) __bf16 bf2v;
typedef __attribute__((ext_vector_type(2))) float f2v;
typedef unsigned short u16;

#define DI __device__ __forceinline__
#define MFMA(a, b, c) __builtin_amdgcn_mfma_f32_32x32x16_bf16((a), (b), (c), 0, 0, 0)

constexpr int T_TOK = 32768;
constexpr int NPHASE = 31;
constexpr float QSCALE = 0.125f * 1.4426950408889634f;

constexpr size_t OFF_WT_IN  = 0;
constexpr size_t OFF_WT_GLU = OFF_WT_IN + 10485760;
constexpr size_t OFF_WT_OUT = OFF_WT_GLU + 2097152;
constexpr size_t OFF_WT_F1  = OFF_WT_OUT + 8388608;
constexpr size_t OFF_WT_F2  = OFF_WT_F1 + 46137344;
constexpr size_t OFF_MOD    = OFF_WT_F2 + 23068672;
constexpr size_t OFF_BIAS1  = OFF_MOD + 786432;
constexpr size_t OFF_BIAS2  = OFF_BIAS1 + 163840;
constexpr size_t OFF_ROPE   = OFF_BIAS2 + 720896;
constexpr size_t OFF_SSMA   = OFF_ROPE + 8192;
constexpr size_t OFF_SSMBB  = OFF_SSMA + 262144;
constexpr size_t OFF_SSMCC  = OFF_SSMBB + 1048576;
constexpr size_t OFF_E      = OFF_SSMCC + 1048576;
constexpr size_t OFF_SSX    = OFF_E + 4194304;
constexpr size_t OFF_SSA    = OFF_SSX + 2097152;
constexpr size_t OFF_SSS    = OFF_SSA + 1048576;
constexpr size_t OFF_X      = OFF_SSS + 1048576;
constexpr size_t OFF_ACT    = OFF_X + 134217728;
constexpr size_t OFF_UNION  = OFF_ACT + 67108864;
constexpr size_t OFF_HID    = OFF_UNION;
constexpr size_t OFF_Q      = OFF_UNION;
constexpr size_t OFF_K      = OFF_Q + 33554432;
constexpr size_t OFF_VT     = OFF_K + 8388608;
constexpr size_t OFF_U2     = OFF_VT + 8388608;
constexpr size_t OFF_YG     = OFF_U2 + 33554432;
constexpr size_t OFF_OATT   = OFF_YG + 33554432;
constexpr size_t OFF_OSSM   = OFF_OATT + 33554432;
constexpr size_t OFF_BAR    = OFF_UNION + 184549376;
constexpr size_t WS_TOTAL   = OFF_BAR + 16384;

struct Params {
  const float *x, *c, *w_ada, *b_ada, *norm1, *w_in, *q_norm, *k_norm, *lam_re, *lam_im, *log_dt,
      *b_re, *b_im, *c_re, *c_im, *ssm_d, *w_glu, *b_glu, *attn_out_norm, *ssm_out_norm, *w_out, *norm2,
      *w_ffn_in, *w_ffn_out, *final_norm;
  float* out;
  char* ws;
  int ph_lo, ph_hi;
};

DI unsigned pk(float a, float b) {
  f2v v = {a, b};
  bf2v r = __builtin_convertvector(v, bf2v);
  return __builtin_bit_cast(unsigned, r);
}
DI int tidx() { int t = __builtin_amdgcn_workitem_id_x(); asm volatile("" : "+v"(t)); return t; }
typedef const Params __attribute__((address_space(4)))* KParamPtr;
DI Params kparams() {
#if defined(__HIP_DEVICE_COMPILE__)
  KParamPtr q = (KParamPtr)__builtin_amdgcn_kernarg_segment_ptr();
  asm volatile("" : "+s"(q));
  return *q;
#else
  return Params{};
#endif
}
DI int vtid() { return tidx() & 255; }
DI int vhalf() { return tidx() >> 8; }
DI float bf2f(unsigned short h) { return __uint_as_float(((unsigned)h) << 16); }
DI void st_bf4(u16* dst, float a, float b, float c, float d) {
  uint2 v; v.x = pk(a, b); v.y = pk(c, d);
  *(uint2*)dst = v;
}
DI float4 ld_bf4(const u16* src) {
  uint2 v = *(const uint2*)src;
  float4 r;
  r.x = __uint_as_float(v.x << 16); r.y = __uint_as_float(v.x & 0xffff0000u);
  r.z = __uint_as_float(v.y << 16); r.w = __uint_as_float(v.y & 0xffff0000u);
  return r;
}
DI float shfl_x32(float v, int hi) {
  auto r = __builtin_amdgcn_permlane32_swap(__float_as_uint(v), __float_as_uint(v), false, false);
  return __uint_as_float(hi ? r[0] : r[1]);
}
DI float row16_sum(float v) {
  v += __int_as_float(__builtin_amdgcn_update_dpp(0, __float_as_int(v), 0x121, 0xf, 0xf, false));
  v += __int_as_float(__builtin_amdgcn_update_dpp(0, __float_as_int(v), 0x122, 0xf, 0xf, false));
  v += __int_as_float(__builtin_amdgcn_update_dpp(0, __float_as_int(v), 0x124, 0xf, 0xf, false));
  v += __int_as_float(__builtin_amdgcn_update_dpp(0, __float_as_int(v), 0x128, 0xf, 0xf, false));
  return v;
}
DI float wave_sum(float v) {
  v = row16_sum(v);
  v += __int_as_float(__builtin_amdgcn_ds_swizzle(__float_as_int(v), 0x401F));
  const int hi = (tidx() >> 5) & 1;
  return v + shfl_x32(v, hi);
}
DI size_t tl_idx(int t, int n) { return ((size_t)(n >> 6) * T_TOK + t) * 64 + (n & 63); }
DI int crow(int r, int hf) { return (r & 3) + 8 * (r >> 2) + 4 * hf; }
DI int f1perm(int n) {
  int j = (n < 2816) ? n : n - 2816;
  return (j >> 5) * 64 + (j & 31) + ((n < 2816) ? 0 : 32);
}

DI void transpose_tile(const float* __restrict__ src, int N, u16* __restrict__ dst, int K, int k0, int n0,
                       int permmode, const float* __restrict__ kscale, float* tl) {
  const int tid = vtid();
  __syncthreads();
#pragma unroll 4
  for (int i = 0; i < 16; i++) {
    int r = (tid >> 6) + 4 * i;
    float v = src[(size_t)(k0 + r) * N + n0 + (tid & 63)];
    if (kscale) v *= kscale[k0 + r];
    tl[r * 65 + (tid & 63)] = v;
  }
  __syncthreads();
#pragma unroll 4
  for (int i = 0; i < 8; i++) {
    int n = (tid >> 5) + 8 * i;
    int kp = tid & 31;
    float a = tl[(2 * kp) * 65 + n], b = tl[(2 * kp + 1) * 65 + n];
    int nn = n0 + n;
    int no = permmode ? f1perm(nn) : nn;
    *(unsigned*)(dst + ((size_t)(k0 >> 6) * N + no) * 64 + 2 * kp) = pk(a, b);
  }
}

DI void gemv8_item(const float* vec, int vstride, bool do_silu, const float* __restrict__ W, int N, int j0,
                   const float* bias, float* out, int ostride, int permmode, float* sm) {
  const int tid = vtid();
  float* vs = sm;
  float* red = sm + 8192;
  __syncthreads();
  for (int i = tid; i < 8192; i += 256) {
    int b = i >> 10, k = i & 1023;
    float v = vec[(size_t)b * vstride + k];
    if (do_silu) v = v / (1.f + expf(-v));
    vs[i] = v;
  }
  __syncthreads();
  const int kq = tid >> 6, jj = tid & 63;
  float acc[8];
#pragma unroll
  for (int b = 0; b < 8; b++) acc[b] = 0.f;
#pragma unroll 4
  for (int k = kq * 256; k < kq * 256 + 256; k++) {
    float w = W[(size_t)k * N + j0 + jj];
#pragma unroll
    for (int b = 0; b < 8; b++) acc[b] += vs[b * 1024 + k] * w;
  }
#pragma unroll
  for (int b = 0; b < 8; b++) red[(kq * 8 + b) * 64 + jj] = acc[b];
  __syncthreads();
  for (int o = tid; o < 512; o += 256) {
    int b = o >> 6, j = o & 63;
    float s = red[(0 * 8 + b) * 64 + j] + red[(8 + b) * 64 + j] + red[(16 + b) * 64 + j] + red[(24 + b) * 64 + j];
    int jg = j0 + j;
    if (bias) s += bias[jg];
    int jo = permmode ? f1perm(jg) : jg;
    out[(size_t)b * ostride + jo] = s;
  }
}

DI void ssm_param_item(const Params& p, int idx) {
  const int tid = vtid();
  const int pp = tid & 63, cq = tid >> 6;
  float* SSMA = (float*)(p.ws + OFF_SSMA);
  u16* BB = (u16*)(p.ws + OFF_SSMBB);
  u16* CC = (u16*)(p.ws + OFF_SSMCC);
  double lr = (double)p.lam_re[idx * 64 + pp];
  if (lr > -1e-4) lr = (double)(-1e-4f);
  double li = (double)p.lam_im[idx * 64 + pp];
  double dt = exp((double)p.log_dt[idx]);
  double mag = exp(lr * dt);
  double ar = mag * cos(li * dt), ai = mag * sin(li * dt);
  double den = lr * lr + li * li;
  double nre = ar - 1.0;
  double kre = (nre * lr + ai * li) / den;
  double kim = (ai * lr - nre * li) / den;
  if (cq == 0) {
    double magL = exp(lr * dt * 256.0);
    float4 v;
    v.x = (float)ar; v.y = (float)ai;
    v.z = (float)(magL * cos(li * dt * 256.0)); v.w = (float)(magL * sin(li * dt * 256.0));
    *(float4*)(SSMA + (size_t)(idx * 64 + pp) * 4) = v;
  }
#pragma unroll
  for (int cc = 0; cc < 4; cc++) {
    int c = cq * 4 + cc;
    double br = (double)p.b_re[(size_t)(idx * 64 + pp) * 16 + c];
    double bi = (double)p.b_im[(size_t)(idx * 64 + pp) * 16 + c];
    float bbr = (float)(kre * br - kim * bi);
    float bbi = (float)(kre * bi + kim * br);
    BB[(size_t)(idx * 128 + pp) * 16 + c] = (u16)(pk(bbr, 0.f) & 0xffffu);
    BB[(size_t)(idx * 128 + 64 + pp) * 16 + c] = (u16)(pk(bbi, 0.f) & 0xffffu);
    float cr = p.c_re[(size_t)(idx * 16 + c) * 64 + pp];
    float ci = p.c_im[(size_t)(idx * 16 + c) * 64 + pp];
    *(unsigned*)(CC + (size_t)(idx * 16 + c) * 128 + 2 * pp) = pk(cr, -ci);
  }
}

DI void phase0(char* smem) {
  const Params p = kparams();
  float* sm = (float*)(smem + vhalf() * 40960);
  constexpr int N_TIN = 4 * 16 * 20, N_TGLU = 4 * 8 * 8, N_TOUT = 4 * 16 * 16, N_TF1 = 4 * 16 * 88, N_TF2 = 4 * 44 * 16;
  constexpr int N_MOD = 4 * 96, N_SSM = 256, N_ROPE = 1;
  constexpr int S0 = N_MOD, S1 = S0 + N_TIN, S2 = S1 + N_TGLU, S3 = S2 + N_TOUT, S4 = S3 + N_TF1, S5 = S4 + N_TF2,
                S6 = S5 + N_SSM, S7 = S6 + N_ROPE;
  for (int it = blockIdx.x * 2 + vhalf(); it < S7 + 1; it += gridDim.x * 2) {
    if (it < S0) {
      int l = it / 96, jb = it % 96;
      gemv8_item(p.c, 1024, true, p.w_ada + (size_t)l * 1024 * 6144, 6144, jb * 64, p.b_ada + l * 6144,
                 (float*)(p.ws + OFF_MOD) + (size_t)l * 8 * 6144, 6144, 0, sm);
    } else if (it < S1) {
      int r = it - S0; int l = r / 320; r %= 320; int kt = r / 20, ntile = r % 20;
      transpose_tile(p.w_in + (size_t)l * 1024 * 1280, 1280, (u16*)(p.ws + OFF_WT_IN) + (size_t)l * 1280 * 1024, 1024,
                     kt * 64, ntile * 64, 0, nullptr, sm);
    } else if (it < S2) {
      int r = it - S1; int l = r / 64; r %= 64; int kt = r / 8, ntile = r % 8;
      transpose_tile(p.w_glu + (size_t)l * 512 * 512, 512, (u16*)(p.ws + OFF_WT_GLU) + (size_t)l * 512 * 512, 512,
                     kt * 64, ntile * 64, 0, nullptr, sm);
    } else if (it < S3) {
      int r = it - S2; int l = r / 256; r %= 256; int kt = r / 16, ntile = r % 16;
      const float* ks = (kt < 8) ? (p.attn_out_norm + l * 512) : (p.ssm_out_norm + l * 512 - 512);
      transpose_tile(p.w_out + (size_t)l * 1024 * 1024, 1024, (u16*)(p.ws + OFF_WT_OUT) + (size_t)l * 1024 * 1024, 1024,
                     kt * 64, ntile * 64, 0, ks, sm);
    } else if (it < S4) {
      int r = it - S3; int l = r / 1408; r %= 1408; int kt = r / 88, ntile = r % 88;
      transpose_tile(p.w_ffn_in + (size_t)l * 1024 * 5632, 5632, (u16*)(p.ws + OFF_WT_F1) + (size_t)l * 5632 * 1024, 1024,
                     kt * 64, ntile * 64, 1, nullptr, sm);
    } else if (it < S5) {
      int r = it - S4; int l = r / 704; r %= 704; int kt = r / 16, ntile = r % 16;
      transpose_tile(p.w_ffn_out + (size_t)l * 2816 * 1024, 1024, (u16*)(p.ws + OFF_WT_F2) + (size_t)l * 1024 * 2816, 2816,
                     kt * 64, ntile * 64, 0, nullptr, sm);
    } else if (it < S6) {
      ssm_param_item(p, it - S5);
    } else {
      float* rope = (float*)(p.ws + OFF_ROPE);
      for (int i = vtid(); i < 1024; i += 256) {
        int idx = i >> 4, f = i & 15;
        double ang = (double)idx * pow(10000.0, -(double)f / 16.0);
        rope[i] = (float)cos(ang);
        rope[1024 + i] = (float)sin(ang);
      }
    }
  }
}

DI void phase1(char* smem) {
  const Params p = kparams();
  float* sm = (float*)(smem + vhalf() * 40960);
  const float* MOD = (const float*)(p.ws + OFF_MOD);
  constexpr int N_B1 = 4 * 20, N_B2 = 4 * 88, N_PREP = T_TOK / 4;
  for (int it = blockIdx.x * 2 + vhalf(); it < N_B1 + N_B2 + N_PREP; it += gridDim.x * 2) {
    if (it < N_B1) {
      int l = it / 20, jb = it % 20;
      gemv8_item(MOD + (size_t)l * 8 * 6144 + 0, 6144, false, p.w_in + (size_t)l * 1024 * 1280, 1280, jb * 64, nullptr,
                 (float*)(p.ws + OFF_BIAS1) + (size_t)l * 8 * 1280, 1280, 0, sm);
    } else if (it < N_B1 + N_B2) {
      int r = it - N_B1; int l = r / 88, jb = r % 88;
      gemv8_item(MOD + (size_t)l * 8 * 6144 + 3072, 6144, false, p.w_ffn_in + (size_t)l * 1024 * 5632, 5632, jb * 64, nullptr,
                 (float*)(p.ws + OFF_BIAS2) + (size_t)l * 8 * 5632, 5632, 1, sm);
    } else {
      int r = it - N_B1 - N_B2;
      const int lane = vtid() & 63, wave = vtid() >> 6;
      int t = r * 4 + wave;
      int b = t >> 12;
      const float4* xr = (const float4*)(p.x + (size_t)t * 1024);
      float4 v[4];
      float ss = 0.f;
#pragma unroll
      for (int i = 0; i < 4; i++) {
        v[i] = xr[lane + 64 * i];
        ss += v[i].x * v[i].x + v[i].y * v[i].y + v[i].z * v[i].z + v[i].w * v[i].w;
      }
      ss = wave_sum(ss);
      float* SSX = (float*)(p.ws + OFF_SSX);
      if (lane < 16) SSX[(size_t)t * 16 + lane] = (lane == 0) ? ss : 0.f;
      u16* ACT = (u16*)(p.ws + OFF_ACT);
      const float* sc1 = MOD + (size_t)(0 * 8 + b) * 6144 + 1024;
#pragma unroll
      for (int i = 0; i < 4; i++) {
        int k = (lane + 64 * i) * 4;
        float4 g = *(const float4*)(p.norm1 + k);
        float4 s = *(const float4*)(sc1 + k);
        st_bf4(ACT + tl_idx(t, k), v[i].x * g.x * (1.f + s.x), v[i].y * g.y * (1.f + s.y),
               v[i].z * g.z * (1.f + s.z), v[i].w * g.w * (1.f + s.w));
      }
    }
  }
}

enum { EPI_IN = 0, EPI_GLU = 1, EPI_OUT = 2, EPI_F1 = 3, EPI_F2 = 4 };

DI float row_rinv16(const float* ssx, int t, float invn) {
  const float4* q = (const float4*)(ssx + (size_t)t * 16);
  float4 a = q[0], b = q[1], c = q[2], d = q[3];
  float s = ((a.x + a.y) + (a.z + a.w)) + ((b.x + b.y) + (b.z + b.w)) + ((c.x + c.y) + (c.z + c.w)) + ((d.x + d.y) + (d.z + d.w));
  return rsqrtf(s * invn + 1e-6f);
}
DI float row_rinv8(const float* ss8, int t, float invn) {
  const float4* q = (const float4*)(ss8 + (size_t)t * 8);
  float4 a = q[0], b = q[1];
  float s = ((a.x + a.y) + (a.z + a.w)) + ((b.x + b.y) + (b.z + b.w));
  return rsqrtf(s * invn + 1e-6f);
}

template <int EPI>
DI void gemm_tile(const Params& p, const int l, const int mt, const int nt, char* smem, uint4& ra0, uint4& ra1, uint4& ra2, uint4& ra3,
               uint4& rb0, uint4& rb1, uint4& rb2, uint4& rb3, const bool first, const bool has_next, const int mt_next, const int nt_next) {
  constexpr int TJ = 4;
  constexpr int K = (EPI == EPI_GLU) ? 512 : (EPI == EPI_F2 ? 2816 : 1024);
  constexpr int KT = K / 64;
  u16* As = (u16*)smem;
  u16* Bs = As + 256 * 72;
  const int tid = tidx(), lane = tid & 63, wave = tid >> 6;
  const int wm = wave >> 2, wn = wave & 3;
  const int hf = lane >> 5, li = lane & 31;
  const int m0 = mt * 256, n0 = nt * 256;

  const u16* A0;
  const u16* A1 = nullptr;
  const u16* W;
  if (EPI == EPI_IN) { A0 = (const u16*)(p.ws + OFF_ACT); W = (const u16*)(p.ws + OFF_WT_IN) + (size_t)l * 1280 * 1024; }
  else if (EPI == EPI_GLU) { A0 = (const u16*)(p.ws + OFF_YG); W = (const u16*)(p.ws + OFF_WT_GLU) + (size_t)l * 512 * 512; }
  else if (EPI == EPI_OUT) { A0 = (const u16*)(p.ws + OFF_OATT); A1 = (const u16*)(p.ws + OFF_OSSM); W = (const u16*)(p.ws + OFF_WT_OUT) + (size_t)l * 1024 * 1024; }
  else if (EPI == EPI_F1) { A0 = (const u16*)(p.ws + OFF_ACT); W = (const u16*)(p.ws + OFF_WT_F1) + (size_t)l * 5632 * 1024; }
  else { A0 = (const u16*)(p.ws + OFF_HID); W = (const u16*)(p.ws + OFF_WT_F2) + (size_t)l * 1024 * 2816; }

  const int lrow = tid >> 3, lc8 = tid & 7;
  constexpr int NW = (EPI == EPI_IN) ? 1280 : (EPI == EPI_GLU ? 512 : (EPI == EPI_F1 ? 5632 : 1024));
  constexpr size_t AKT = (size_t)T_TOK * 64, WKT = (size_t)NW * 64;
  const u16* ag0 = A0 + (size_t)(m0 + lrow) * 64 + lc8 * 8;
  const u16* ag1 = (EPI == EPI_OUT) ? (A1 + (size_t)(m0 + lrow) * 64 + lc8 * 8) : nullptr;
  const u16* wg = W + (size_t)(n0 + lrow) * 64 + lc8 * 8;

  f32x16 acc[2][TJ];
#pragma unroll
  for (int i = 0; i < 2; i++)
#pragma unroll
    for (int j = 0; j < TJ; j++)
#pragma unroll
      for (int r = 0; r < 16; r++) acc[i][j][r] = 0.f;

#define GEMM_GLOAD_R(kt_, A0_, A1_, A2_, A3_, B0_, B1_, B2_, B3_)                                 \
  {                                                                                              \
    const u16* ap;                                                                               \
    if (EPI == EPI_OUT) ap = ((kt_) < 8) ? (ag0 + (kt_) * AKT) : (ag1 + (long)((kt_) - 8) * (long)AKT);      \
    else ap = ag0 + (kt_) * AKT;                                                                 \
    const u16* wp = wg + (kt_) * WKT;                                                            \
    A0_ = *(const uint4*)(ap);                                                                   \
    A1_ = *(const uint4*)(ap + 64 * 64);                                                         \
    A2_ = *(const uint4*)(ap + 128 * 64);                                                        \
    A3_ = *(const uint4*)(ap + 192 * 64);                                                        \
    B0_ = *(const uint4*)(wp);                                                                   \
    B1_ = *(const uint4*)(wp + 64 * 64);                                                         \
    B2_ = *(const uint4*)(wp + 128 * 64);                                                        \
    B3_ = *(const uint4*)(wp + 192 * 64);                                                        \
  }
#define GEMM_LSTORE_R(boff_, A0_, A1_, A2_, A3_, B0_, B1_, B2_, B3_) \
  {                                                                \
    u16* a_ = As + (boff_) + lrow * 72 + lc8 * 8;                  \
    u16* b_ = Bs + (boff_) + lrow * 72 + lc8 * 8;                  \
    *(uint4*)(a_) = A0_;                                           \
    *(uint4*)(a_ + 64 * 72) = A1_;                                 \
    *(uint4*)(a_ + 128 * 72) = A2_;                                \
    *(uint4*)(a_ + 192 * 72) = A3_;                                \
    *(uint4*)(b_) = B0_;                                           \
    *(uint4*)(b_ + 64 * 72) = B1_;                                 \
    *(uint4*)(b_ + 128 * 72) = B2_;                                \
    *(uint4*)(b_ + 192 * 72) = B3_;                                \
  }
#define GEMM_COMPUTE(cur_, DOST_, oth_, A0_, A1_, A2_, A3_, B0_, B1_, B2_, B3_)                                          \
  {                                                                                                                     \
    u16* a_ = As + (oth_) + lrow * 72 + lc8 * 8;                                                                        \
    u16* b_ = Bs + (oth_) + lrow * 72 + lc8 * 8;                                                                        \
    _Pragma("unroll") for (int s = 0; s < 4; s++) {                                                                     \
      bf16x8 wf[2], af[TJ];                                                                                             \
      _Pragma("unroll") for (int i = 0; i < 2; i++)                                                                     \
        wf[i] = *(const bf16x8*)(Bs + (cur_) + (wn * 64 + i * 32 + li) * 72 + s * 16 + hf * 8);                         \
      _Pragma("unroll") for (int j = 0; j < TJ; j++)                                                                    \
        af[j] = *(const bf16x8*)(As + (cur_) + (wm * 128 + j * 32 + li) * 72 + s * 16 + hf * 8);                        \
      _Pragma("unroll") for (int i = 0; i < 2; i++)                                                                     \
        _Pragma("unroll") for (int j = 0; j < TJ; j++) acc[i][j] = MFMA(wf[i], af[j], acc[i][j]);                       \
        \
      if (DOST_) {                                                                                                      \
        if (s == 0) { *(uint4*)(a_) = A0_; *(uint4*)(a_ + 64 * 72) = A1_; }                                             \
        if (s == 1) { *(uint4*)(a_ + 128 * 72) = A2_; *(uint4*)(a_ + 192 * 72) = A3_; }                                 \
        if (s == 2) { *(uint4*)(b_) = B0_; *(uint4*)(b_ + 64 * 72) = B1_; }                                             \
        if (s == 3) { *(uint4*)(b_ + 128 * 72) = B2_; *(uint4*)(b_ + 192 * 72) = B3_; }                                 \
      }                                                                                                                 \
    }                                                                                                                   \
  }
  constexpr int BUF = 2 * 256 * 72;
  uint4 sa0, sa1, sa2, sa3, sb0, sb1, sb2, sb3;
  if (first) GEMM_GLOAD_R(0, ra0, ra1, ra2, ra3, rb0, rb1, rb2, rb3);
  GEMM_GLOAD_R(1, sa0, sa1, sa2, sa3, sb0, sb1, sb2, sb3);
  int tok[TJ];
#pragma unroll
  for (int j = 0; j < TJ; j++) tok[j] = m0 + wm * 128 + j * 32 + li;

  __syncthreads();
  GEMM_LSTORE_R(0, ra0, ra1, ra2, ra3, rb0, rb1, rb2, rb3);
  GEMM_GLOAD_R(2, ra0, ra1, ra2, ra3, rb0, rb1, rb2, rb3);
  __syncthreads();
#pragma unroll 1
  for (int kt = 0; kt < KT; kt += 2) {
    if (EPI == EPI_OUT) {
      if (kt == 8) {
#pragma unroll
        for (int j = 0; j < TJ; j++) {
          const float ra_ = row_rinv8((const float*)(p.ws + OFF_SSA), tok[j], 1.f / 512.f);
          const float rs_ = row_rinv8((const float*)(p.ws + OFF_SSS), tok[j], 1.f / 512.f);
          const float mr = ra_ / rs_;
#pragma unroll
          for (int i = 0; i < 2; i++)
#pragma unroll
            for (int r = 0; r < 16; r++) acc[i][j][r] *= mr;
        }
      }
    }
    GEMM_COMPUTE(0, true, BUF, sa0, sa1, sa2, sa3, sb0, sb1, sb2, sb3);
    if (kt + 3 < KT) GEMM_GLOAD_R(kt + 3, sa0, sa1, sa2, sa3, sb0, sb1, sb2, sb3);
    __syncthreads();
    GEMM_COMPUTE(BUF, (kt + 2 < KT), 0, ra0, ra1, ra2, ra3, rb0, rb1, rb2, rb3);
    if (kt + 4 < KT) GEMM_GLOAD_R(kt + 4, ra0, ra1, ra2, ra3, rb0, rb1, rb2, rb3);
    __syncthreads();
  }
  if (has_next && EPI != EPI_OUT && EPI != EPI_F2) {
    const u16* ap = A0 + (size_t)(mt_next * 256 + lrow) * 64 + lc8 * 8;
    const u16* wp = W + (size_t)(nt_next * 256 + lrow) * 64 + lc8 * 8;
    ra0 = *(const uint4*)(ap);
    ra1 = *(const uint4*)(ap + 64 * 64);
    ra2 = *(const uint4*)(ap + 128 * 64);
    ra3 = *(const uint4*)(ap + 192 * 64);
    rb0 = *(const uint4*)(wp);
    rb1 = *(const uint4*)(wp + 64 * 64);
    rb2 = *(const uint4*)(wp + 128 * 64);
    rb3 = *(const uint4*)(wp + 192 * 64);
  }

  const int b = m0 >> 12;
  const int nbase = n0 + wn * 64;
  const float* MOD = (const float*)(p.ws + OFF_MOD);

  if (EPI == EPI_IN) {
    const float* bias = (const float*)(p.ws + OFF_BIAS1) + (size_t)(l * 8 + b) * 1280;
    const float* SSX = (const float*)(p.ws + OFF_SSX);
    float rinv[TJ];
#pragma unroll
    for (int j = 0; j < TJ; j++) rinv[j] = row_rinv16(SSX, tok[j], 1.f / 1024.f);
#pragma unroll
    for (int i = 0; i < 2; i++)
#pragma unroll
      for (int q4 = 0; q4 < 4; q4++) {
        float4 b4 = *(const float4*)(bias + nbase + i * 32 + 8 * q4 + 4 * hf);
#pragma unroll
        for (int j = 0; j < TJ; j++) {
          acc[i][j][4 * q4 + 0] = acc[i][j][4 * q4 + 0] * rinv[j] + b4.x;
          acc[i][j][4 * q4 + 1] = acc[i][j][4 * q4 + 1] * rinv[j] + b4.y;
          acc[i][j][4 * q4 + 2] = acc[i][j][4 * q4 + 2] * rinv[j] + b4.z;
          acc[i][j][4 * q4 + 3] = acc[i][j][4 * q4 + 3] * rinv[j] + b4.w;
        }
      }
    if (nbase < 640) {
#pragma unroll
      for (int j = 0; j < TJ; j++) {
        const int t = tok[j], pos = t & 4095;
#pragma unroll
        for (int i = 0; i < 2; i++)
#pragma unroll
          for (int q4 = 0; q4 < 4; q4++) {
            const int d0 = i * 32 + 8 * q4 + 4 * hf;
            u16* dst = (nbase < 512) ? ((u16*)(p.ws + OFF_Q) + (size_t)t * 512 + nbase + d0)
                                     : ((u16*)(p.ws + OFF_K) + ((size_t)(b * 2 + ((nbase - 512) >> 6)) * 4096 + pos) * 64 + d0);
            st_bf4(dst, acc[i][j][4 * q4 + 0], acc[i][j][4 * q4 + 1], acc[i][j][4 * q4 + 2], acc[i][j][4 * q4 + 3]);
          }
      }
    } else if (nbase < 768) {
      u16* VT = (u16*)(p.ws + OFF_VT);
      const int vh = (nbase - 640) >> 6;
#pragma unroll
      for (int j = 0; j < TJ; j++) {
        const int pos = tok[j] & 4095;
#pragma unroll
        for (int i = 0; i < 2; i++)
#pragma unroll
          for (int r = 0; r < 16; r++) {
            int d = i * 32 + crow(r, hf);
            VT[((size_t)(b * 2 + vh) * 64 + d) * 4096 + pos] = (u16)(pk(acc[i][j][r], 0.f) & 0xffffu);
          }
      }
    } else {
      u16* U2 = (u16*)(p.ws + OFF_U2);
      const int ch0 = nbase - 768;
#pragma unroll
      for (int j = 0; j < TJ; j++) {
        const int pos = tok[j] & 4095;
#pragma unroll
        for (int i = 0; i < 2; i++)
#pragma unroll
          for (int q4 = 0; q4 < 4; q4++) {
            int ch = ch0 + i * 32 + 8 * q4 + 4 * hf;
            int g = ch >> 4, c0 = ch & 15;
            st_bf4(U2 + (((size_t)(b * 32 + g)) * 4096 + pos) * 16 + c0, acc[i][j][4 * q4 + 0], acc[i][j][4 * q4 + 1],
                   acc[i][j][4 * q4 + 2], acc[i][j][4 * q4 + 3]);
          }
      }
    }
  } else if (EPI == EPI_GLU) {
    const float* bg = p.b_glu + l * 512;
    const u16* YG = (const u16*)(p.ws + OFF_YG);
    u16* OSSM = (u16*)(p.ws + OFF_OSSM);
    float* SSS = (float*)(p.ws + OFF_SSS);
#pragma unroll
    for (int j = 0; j < TJ; j++) {
      const int t = tok[j];
      float ss = 0.f;
#pragma unroll
      for (int i = 0; i < 2; i++)
#pragma unroll
        for (int q4 = 0; q4 < 4; q4++) {
          const int n = nbase + i * 32 + 8 * q4 + 4 * hf;
          float4 b4 = *(const float4*)(bg + n);
          float4 y = ld_bf4(YG + tl_idx(t, n));
          float o0 = y.x / (1.f + __expf(-(acc[i][j][4 * q4 + 0] + b4.x)));
          float o1 = y.y / (1.f + __expf(-(acc[i][j][4 * q4 + 1] + b4.y)));
          float o2 = y.z / (1.f + __expf(-(acc[i][j][4 * q4 + 2] + b4.z)));
          float o3 = y.w / (1.f + __expf(-(acc[i][j][4 * q4 + 3] + b4.w)));
          ss += o0 * o0 + o1 * o1 + o2 * o2 + o3 * o3;
          st_bf4(OSSM + tl_idx(t, n), o0, o1, o2, o3);
        }
      ss += shfl_x32(ss, hf);
      if (hf == 0) SSS[(size_t)t * 8 + (nbase >> 6)] = ss;
    }
  } else if (EPI == EPI_OUT || EPI == EPI_F2) {
    const float* gate = MOD + (size_t)(l * 8 + b) * 6144 + (EPI == EPI_OUT ? 2048 : 5120);
    const bool has_next = (EPI == EPI_OUT) || (l < 3);
    const float* nrm = (EPI == EPI_OUT) ? (p.norm2 + l * 1024) : (p.norm1 + (l + 1) * 1024);
    const float* scn = (EPI == EPI_OUT) ? (MOD + (size_t)(l * 8 + b) * 6144 + 4096) : (MOD + (size_t)((l + 1) * 8 + b) * 6144 + 1024);
    const float* xin = (EPI == EPI_OUT && l == 0) ? p.x : (const float*)(p.ws + OFF_X);
    float* X = (float*)(p.ws + OFF_X);
    u16* ACT = (u16*)(p.ws + OFF_ACT);
    float* SSX = (float*)(p.ws + OFF_SSX);
    float* stg = (float*)smem + wave * (32 * 68);
    const int rr = lane >> 4, c4 = (lane & 15) * 4;
    const int n = nbase + c4;
    const float4 g4 = *(const float4*)(gate + n);
    float4 nsc = make_float4(0.f, 0.f, 0.f, 0.f);
    if (has_next) {
      const float4 nr = *(const float4*)(nrm + n);
      const float4 sc = *(const float4*)(scn + n);
      nsc = make_float4(nr.x * (1.f + sc.x), nr.y * (1.f + sc.y), nr.z * (1.f + sc.z), nr.w * (1.f + sc.w));
    }
    float4 xi[8], xn[8];
    float fj[TJ];
#pragma unroll
    for (int j = 0; j < TJ; j++) fj[j] = (EPI == EPI_OUT) ? row_rinv8((const float*)(p.ws + OFF_SSS), tok[j], 1.f / 512.f) : 1.f;
#pragma unroll
    for (int it = 0; it < 8; it++) xi[it] = *(const float4*)(xin + (size_t)(m0 + wm * 128 + rr + 4 * it) * 1024 + n);
#pragma unroll
    for (int j = 0; j < TJ; j++) {
#pragma unroll
      for (int i = 0; i < 2; i++)
#pragma unroll
        for (int q4 = 0; q4 < 4; q4++)
          *(float4*)(stg + li * 68 + i * 32 + 8 * q4 + 4 * hf) =
              make_float4(acc[i][j][4 * q4 + 0] * fj[j], acc[i][j][4 * q4 + 1] * fj[j], acc[i][j][4 * q4 + 2] * fj[j], acc[i][j][4 * q4 + 3] * fj[j]);
      asm volatile("s_waitcnt lgkmcnt(0)" ::: "memory");
      if (j + 1 < TJ) {
#pragma unroll
        for (int it = 0; it < 8; it++) xn[it] = *(const float4*)(xin + (size_t)(m0 + wm * 128 + (j + 1) * 32 + rr + 4 * it) * 1024 + n);
      }
#pragma unroll
      for (int it = 0; it < 8; it++) {
        const int row = rr + 4 * it;
        const int t = m0 + wm * 128 + j * 32 + row;
        const float4 a = *(const float4*)(stg + row * 68 + c4);
        float4 y;
        y.x = xi[it].x + g4.x * a.x;
        y.y = xi[it].y + g4.y * a.y;
        y.z = xi[it].z + g4.z * a.z;
        y.w = xi[it].w + g4.w * a.w;
        *(float4*)(X + (size_t)t * 1024 + n) = y;
        float ss = y.x * y.x + y.y * y.y + y.z * y.z + y.w * y.w;
        ss = row16_sum(ss);
        if ((lane & 15) == 0) SSX[(size_t)t * 16 + (nbase >> 6)] = ss;
        if (has_next) st_bf4(ACT + tl_idx(t, n), y.x * nsc.x, y.y * nsc.y, y.z * nsc.z, y.w * nsc.w);
      }
      asm volatile("s_waitcnt lgkmcnt(0)" ::: "memory");
      if (j + 1 < TJ) {
#pragma unroll
        for (int it = 0; it < 8; it++) xi[it] = xn[it];
      }
    }
  } else {
    const float* bias = (const float*)(p.ws + OFF_BIAS2) + (size_t)(l * 8 + b) * 5632;
    const float* SSX = (const float*)(p.ws + OFF_SSX);
    u16* HID = (u16*)(p.ws + OFF_HID);
    const int jbase = nbase >> 1;
#pragma unroll
    for (int j = 0; j < TJ; j++) {
      const int t = tok[j];
      const float rv = row_rinv16(SSX, t, 1.f / 1024.f);
#pragma unroll
      for (int q4 = 0; q4 < 4; q4++) {
        const int ng = nbase + 8 * q4 + 4 * hf;
        float4 bg4 = *(const float4*)(bias + ng);
        float4 bu4 = *(const float4*)(bias + ng + 32);
        float zg0 = acc[0][j][4 * q4 + 0] * rv + bg4.x, zu0 = acc[1][j][4 * q4 + 0] * rv + bu4.x;
        float zg1 = acc[0][j][4 * q4 + 1] * rv + bg4.y, zu1 = acc[1][j][4 * q4 + 1] * rv + bu4.y;
        float zg2 = acc[0][j][4 * q4 + 2] * rv + bg4.z, zu2 = acc[1][j][4 * q4 + 2] * rv + bu4.z;
        float zg3 = acc[0][j][4 * q4 + 3] * rv + bg4.w, zu3 = acc[1][j][4 * q4 + 3] * rv + bu4.w;
        float h0 = zg0 / (1.f + __expf(-zg0)) * zu0;
        float h1 = zg1 / (1.f + __expf(-zg1)) * zu1;
        float h2 = zg2 / (1.f + __expf(-zg2)) * zu2;
        float h3 = zg3 / (1.f + __expf(-zg3)) * zu3;
        st_bf4(HID + tl_idx(t, jbase + 8 * q4 + 4 * hf), h0, h1, h2, h3);
      }
    }
  }
}

template <int EPI>
DI void gemm_phase(int l, char* smem) {
  const Params p = kparams();
  constexpr int NT = (EPI == EPI_IN) ? 5 : (EPI == EPI_GLU ? 2 : (EPI == EPI_F1 ? 22 : 4));
  const int g8 = gridDim.x >> 3;
  const int xg = blockIdx.x & 7, lb = blockIdx.x >> 3;
  uint4 ra0, ra1, ra2, ra3, rb0, rb1, rb2, rb3;
  bool first = true;
  for (int q = lb; q < 16 * NT; q += g8) {
    const int mg = q / (8 * NT);
    const int rem = q - mg * 8 * NT;
    const int qn = q + g8;
    const bool has_next = qn < 16 * NT;
    const int mgn = qn / (8 * NT);
    const int remn = qn - mgn * 8 * NT;
    gemm_tile<EPI>(p, l, xg * 16 + mg * 8 + (rem & 7), rem >> 3, smem, ra0, ra1, ra2, ra3, rb0, rb1, rb2, rb3, first, has_next,
                   xg * 16 + mgn * 8 + (remn & 7), remn >> 3);
    first = (EPI == EPI_OUT || EPI == EPI_F2);
  }
}

DI void attn_item(const Params& p, int item, char* smem) {
  u16* Ks = (u16*)smem;
  u16* Vs = Ks + 2 * 64 * 72;
  constexpr int ABUF = 64 * 72;
  const int tid = tidx(), lane = tid & 63, wave = tid >> 6;
  const int hf = lane >> 5, li = lane & 31;
  const int xcd = item & 7, local = item >> 3;
  const int pair = xcd * 2 + (local >> 5);
  const int within = local & 31;
  const int hq = within >> 3, qb = within & 7;
  const int b = pair >> 1, kvh = pair & 1, h = kvh * 4 + hq;
  const int t0 = b * 4096 + qb * 512 + wave * 64 + li;

  const u16* Q = (const u16*)(p.ws + OFF_Q);
  bf16x8 qf[2][4];
#pragma unroll
  for (int u = 0; u < 2; u++)
#pragma unroll
    for (int s = 0; s < 4; s++) qf[u][s] = *(const bf16x8*)(Q + (size_t)(t0 + 32 * u) * 512 + h * 64 + 16 * s + 8 * hf);

  f32x16 o0[2], o1[2];
  float m_run[2], l_run[2];
#pragma unroll
  for (int u = 0; u < 2; u++) {
#pragma unroll
    for (int r = 0; r < 16; r++) { o0[u][r] = 0.f; o1[u][r] = 0.f; }
    m_run[u] = -1e30f; l_run[u] = 0.f;
  }

  const int lrow = tid >> 3, lc8 = tid & 7;
  const u16* Kg = (const u16*)(p.ws + OFF_K) + (size_t)pair * 4096 * 64 + (size_t)lrow * 64 + lc8 * 8;
  const u16* Vg = (const u16*)(p.ws + OFF_VT) + (size_t)pair * 64 * 4096 + (size_t)lrow * 4096 + lc8 * 8;
  uint4 rk0, rv0;
#define ATT_GLOAD(kt_)                                                   \
  {                                                                      \
    rk0 = *(const uint4*)(Kg + (size_t)((kt_) * 64) * 64);               \
    rv0 = *(const uint4*)(Vg + (kt_) * 64);                              \
  }
  ATT_GLOAD(0);
  const int kap = (li & 0x13) | ((li & 4) << 1) | ((li & 8) >> 1);
  __syncthreads();
  *(uint4*)(Ks + (lrow) * 72 + lc8 * 8) = rk0;
  *(uint4*)(Vs + (lrow) * 72 + lc8 * 8) = rv0;
  ATT_GLOAD(1);
  __syncthreads();

  for (int kt = 0; kt < 64; kt++) {
    const int cur = (kt & 1) * ABUF;
    if (kt + 1 < 64) {
      *(uint4*)(Ks + (ABUF - cur) + (lrow) * 72 + lc8 * 8) = rk0;
      *(uint4*)(Vs + (ABUF - cur) + (lrow) * 72 + lc8 * 8) = rv0;
    }
    if (kt + 2 < 64) ATT_GLOAD(kt + 2);

    f32x16 s0[2], s1[2];
#pragma unroll
    for (int u = 0; u < 2; u++)
#pragma unroll
      for (int r = 0; r < 16; r++) { s0[u][r] = 0.f; s1[u][r] = 0.f; }
#pragma unroll
    for (int s = 0; s < 4; s++) {
      const bf16x8 kf0 = *(const bf16x8*)(Ks + cur + kap * 72 + 16 * s + 8 * hf);
      const bf16x8 kf1 = *(const bf16x8*)(Ks + cur + (32 + kap) * 72 + 16 * s + 8 * hf);
#pragma unroll
      for (int u = 0; u < 2; u++) {
        s0[u] = MFMA(kf0, qf[u][s], s0[u]);
        s1[u] = MFMA(kf1, qf[u][s], s1[u]);
      }
    }
    bf16x8 pb[2][4];
#pragma unroll
    for (int u = 0; u < 2; u++) {
      float mx = s0[u][0];
#pragma unroll
      for (int r = 1; r < 16; r++) mx = fmaxf(mx, s0[u][r]);
#pragma unroll
      for (int r = 0; r < 16; r++) mx = fmaxf(mx, s1[u][r]);
      mx = fmaxf(mx, shfl_x32(mx, hf));
      const float mnew = fmaxf(m_run[u], mx);
      const float alpha = __builtin_amdgcn_exp2f(m_run[u] - mnew);
      m_run[u] = mnew;
      float ps = 0.f;
#pragma unroll
      for (int r = 0; r < 16; r++) { s0[u][r] = __builtin_amdgcn_exp2f(s0[u][r] - mnew); ps += s0[u][r]; }
#pragma unroll
      for (int r = 0; r < 16; r++) { s1[u][r] = __builtin_amdgcn_exp2f(s1[u][r] - mnew); ps += s1[u][r]; }
      l_run[u] = l_run[u] * alpha + ps;
#pragma unroll
      for (int r = 0; r < 16; r++) { o0[u][r] *= alpha; o1[u][r] *= alpha; }
#pragma unroll
      for (int sp = 0; sp < 2; sp++) {
        uint4 ua = make_uint4(pk(s0[u][8 * sp + 0], s0[u][8 * sp + 1]), pk(s0[u][8 * sp + 2], s0[u][8 * sp + 3]),
                              pk(s0[u][8 * sp + 4], s0[u][8 * sp + 5]), pk(s0[u][8 * sp + 6], s0[u][8 * sp + 7]));
        uint4 ub = make_uint4(pk(s1[u][8 * sp + 0], s1[u][8 * sp + 1]), pk(s1[u][8 * sp + 2], s1[u][8 * sp + 3]),
                              pk(s1[u][8 * sp + 4], s1[u][8 * sp + 5]), pk(s1[u][8 * sp + 6], s1[u][8 * sp + 7]));
        pb[u][sp] = __builtin_bit_cast(bf16x8, ua);
        pb[u][2 + sp] = __builtin_bit_cast(bf16x8, ub);
      }
    }
#pragma unroll
    for (int c = 0; c < 4; c++) {
      const bf16x8 vf0 = *(const bf16x8*)(Vs + cur + li * 72 + 16 * c + 8 * hf);
      const bf16x8 vf1 = *(const bf16x8*)(Vs + cur + (32 + li) * 72 + 16 * c + 8 * hf);
#pragma unroll
      for (int u = 0; u < 2; u++) {
        o0[u] = MFMA(vf0, pb[u][c], o0[u]);
        o1[u] = MFMA(vf1, pb[u][c], o1[u]);
      }
    }
    __syncthreads();
  }
  u16* OATT = (u16*)(p.ws + OFF_OATT);
#pragma unroll
  for (int u = 0; u < 2; u++) {
    const int t = t0 + 32 * u;
    const float ltot = l_run[u] + shfl_x32(l_run[u], hf);
    const float inv = 1.f / ltot;
    float ss = 0.f;
#pragma unroll
    for (int q4 = 0; q4 < 4; q4++) {
      float a0 = o0[u][4 * q4 + 0] * inv, a1 = o0[u][4 * q4 + 1] * inv, a2 = o0[u][4 * q4 + 2] * inv, a3 = o0[u][4 * q4 + 3] * inv;
      float c0 = o1[u][4 * q4 + 0] * inv, c1 = o1[u][4 * q4 + 1] * inv, c2 = o1[u][4 * q4 + 2] * inv, c3 = o1[u][4 * q4 + 3] * inv;
      ss += a0 * a0 + a1 * a1 + a2 * a2 + a3 * a3 + c0 * c0 + c1 * c1 + c2 * c2 + c3 * c3;
      st_bf4(OATT + tl_idx(t, h * 64 + 8 * q4 + 4 * hf), a0, a1, a2, a3);
      st_bf4(OATT + tl_idx(t, h * 64 + 32 + 8 * q4 + 4 * hf), c0, c1, c2, c3);
    }
    ss += shfl_x32(ss, hf);
    if (hf == 0) ((float*)(p.ws + OFF_SSA))[(size_t)t * 8 + h] = ss;
  }
}

DI bf16x8 ssm_ufrag(const u16* U2, int bp, int g, int tb, int li, int hf) {
  const int seq = (li >> 2) & 1, step = ((li >> 3) << 2) | (li & 3);
  return *(const bf16x8*)(U2 + (((size_t)((2 * bp + seq) * 32 + g)) * 4096 + tb + step) * 16 + 8 * hf);
}

DI void ssm_scan16(const f32x16& x0, const f32x16& x1, const f32x16& x2, const f32x16& x3, const float4 a0, const float4 a1,
                   float& h0r, float& h0i, float& h1r, float& h1i, const int dir) {
  if (dir == 0) {
#pragma unroll
    for (int r = 0; r < 16; r++) {
      float nr = a0.x * h0r - a0.y * h0i + x0[r], ni = a0.x * h0i + a0.y * h0r + x2[r];
      h0r = nr; h0i = ni;
      float mr = a1.x * h1r - a1.y * h1i + x1[r], mi = a1.x * h1i + a1.y * h1r + x3[r];
      h1r = mr; h1i = mi;
    }
  } else {
#pragma unroll
    for (int r = 15; r >= 0; r--) {
      float nr = a0.x * h0r - a0.y * h0i + x0[r], ni = a0.x * h0i + a0.y * h0r + x2[r];
      h0r = nr; h0i = ni;
      float mr = a1.x * h1r - a1.y * h1i + x1[r], mi = a1.x * h1i + a1.y * h1r + x3[r];
      h1r = mr; h1i = mi;
    }
  }
}

DI void ssm1_item(const Params& p, int l, int item) {
  const int tid = vtid(), lane = tid & 63, wave = __builtin_amdgcn_readfirstlane(tid >> 6);
  const int hf = lane >> 5, li = lane & 31;
  const int w = item * 4 + wave;
  const int ch = w & 15, bp = (w >> 4) & 3, g = (w >> 6) & 31, dir = w >> 11;
  const int idx = (l * 2 + dir) * 32 + g;
  const u16* U2 = (const u16*)(p.ws + OFF_U2);
  const u16* BB = (const u16*)(p.ws + OFF_SSMBB) + (size_t)idx * 128 * 16;
  const float* SA = (const float*)(p.ws + OFF_SSMA) + (size_t)idx * 64 * 4;
  bf16x8 bbf[4];
#pragma unroll
  for (int j = 0; j < 4; j++) bbf[j] = *(const bf16x8*)(BB + (32 * j + li) * 16 + 8 * hf);
  const float4 a0 = *(const float4*)(SA + li * 4);
  const float4 a1 = *(const float4*)(SA + (li + 32) * 4);
  float h0r = 0.f, h0i = 0.f, h1r = 0.f, h1i = 0.f;
  f32x16 zero;
#pragma unroll
  for (int r = 0; r < 16; r++) zero[r] = 0.f;
#define SSM_TB(it_) (ch * 256 + (dir ? (15 - (it_)) : (it_)) * 16)
  bf16x8 q0 = ssm_ufrag(U2, bp, g, SSM_TB(0), li, hf), q1 = ssm_ufrag(U2, bp, g, SSM_TB(1), li, hf);
  bf16x8 q2 = ssm_ufrag(U2, bp, g, SSM_TB(2), li, hf), q3 = ssm_ufrag(U2, bp, g, SSM_TB(3), li, hf);
#pragma unroll 1
  for (int it = 0; it < 16; it++) {
    const bf16x8 uf = q0;
    q0 = q1; q1 = q2; q2 = q3;
    const int itn = (it + 4 < 16) ? (it + 4) : 15;
    q3 = ssm_ufrag(U2, bp, g, SSM_TB(itn), li, hf);
    f32x16 x0 = MFMA(uf, bbf[0], zero), x1 = MFMA(uf, bbf[1], zero), x2 = MFMA(uf, bbf[2], zero), x3 = MFMA(uf, bbf[3], zero);
    ssm_scan16(x0, x1, x2, x3, a0, a1, h0r, h0i, h1r, h1i, dir);
  }
  float* E = (float*)(p.ws + OFF_E) + ((((size_t)(dir * 32 + g) * 8 + (2 * bp + hf)) * 16 + ch) * 64) * 2;
  *(float2*)(E + li * 2) = make_float2(h0r, h0i);
  *(float2*)(E + (li + 32) * 2) = make_float2(h1r, h1i);
}

DI void ssm2_item(const Params& p, int l, int item, char* smem) {
  const int tid = vtid(), lane = tid & 63, wave = __builtin_amdgcn_readfirstlane(tid >> 6);
  const int hf = lane >> 5, li = lane & 31;
  const int w = item * 4 + wave;
  const int ch = w & 15, bp = (w >> 4) & 3, g = w >> 6;
  u16* Hs = (u16*)smem + wave * (32 * 136);
  const u16* U2 = (const u16*)(p.ws + OFF_U2);
  float* YF = (float*)(p.ws + OFF_ACT);
  u16* YG = (u16*)(p.ws + OFF_YG);
  f32x16 zero;
#pragma unroll
  for (int r = 0; r < 16; r++) zero[r] = 0.f;
  const int oseq = li >> 4, ostep = li & 15;
  const int ob = 2 * bp + oseq;

  for (int dir = 0; dir < 2; dir++) {
    const int idx = (l * 2 + dir) * 32 + g;
    const u16* BB = (const u16*)(p.ws + OFF_SSMBB) + (size_t)idx * 128 * 16;
    const u16* CC = (const u16*)(p.ws + OFF_SSMCC) + (size_t)idx * 16 * 128;
    const float* SA = (const float*)(p.ws + OFF_SSMA) + (size_t)idx * 64 * 4;
    bf16x8 bbf[4], ccf[8];
#pragma unroll
    for (int j = 0; j < 4; j++) bbf[j] = *(const bf16x8*)(BB + (32 * j + li) * 16 + 8 * hf);
#pragma unroll
    for (int s = 0; s < 8; s++) {
      bf16x8 v = *(const bf16x8*)(CC + (li & 15) * 128 + 16 * s + 8 * hf);
      if (li >= 16) {
#pragma unroll
        for (int e = 0; e < 8; e++) v[e] = 0;
      }
      ccf[s] = v;
    }
    const float4 a0 = *(const float4*)(SA + li * 4);
    const float4 a1 = *(const float4*)(SA + (li + 32) * 4);
    float h0r = 0.f, h0i = 0.f, h1r = 0.f, h1i = 0.f;
    {
      const float* E = (const float*)(p.ws + OFF_E) + ((((size_t)(dir * 32 + g) * 8 + (2 * bp + hf)) * 16) * 64) * 2;
      const int n = dir ? (15 - ch) : ch;
      for (int i0 = 0; i0 < n; i0 += 4) {
        float2 e0[4], e1[4];
#pragma unroll
        for (int u = 0; u < 4; u++) {
          int ii = i0 + u; if (ii > n - 1) ii = n - 1;
          const int ci = dir ? (15 - ii) : ii;
          e0[u] = *(const float2*)(E + (size_t)ci * 128 + li * 2);
          e1[u] = *(const float2*)(E + (size_t)ci * 128 + (li + 32) * 2);
        }
#pragma unroll
        for (int u = 0; u < 4; u++) {
          if (i0 + u < n) {
            float nr = a0.z * h0r - a0.w * h0i + e0[u].x, ni = a0.z * h0i + a0.w * h0r + e0[u].y;
            h0r = nr; h0i = ni;
            float mr = a1.z * h1r - a1.w * h1i + e1[u].x, mi = a1.z * h1i + a1.w * h1r + e1[u].y;
            h1r = mr; h1i = mi;
          }
        }
      }
    }
    bf16x8 ufn = ssm_ufrag(U2, bp, g, ch * 256 + (dir ? 15 : 0) * 16, li, hf);
    for (int it = 0; it < 16; it++) {
      const int tb = ch * 256 + (dir ? (15 - it) : it) * 16;
      const bf16x8 uf = ufn;
      f32x16 x0 = MFMA(uf, bbf[0], zero), x1 = MFMA(uf, bbf[1], zero), x2 = MFMA(uf, bbf[2], zero), x3 = MFMA(uf, bbf[3], zero);
      if (it + 1 < 16) ufn = ssm_ufrag(U2, bp, g, ch * 256 + (dir ? (14 - it) : (it + 1)) * 16, li, hf);
      const int tt = tb + ostep;
      const size_t yoff = (((size_t)(ob * 32 + g)) * 4096 + tt) * 16;
      float4 f0 = make_float4(0.f, 0.f, 0.f, 0.f), f1 = f0, u0 = f0, u1 = f0;
      if (dir) {
        f0 = *(const float4*)(YF + yoff + 4 * hf);
        f1 = *(const float4*)(YF + yoff + 8 + 4 * hf);
        u0 = ld_bf4(U2 + yoff + 4 * hf);
        u1 = ld_bf4(U2 + yoff + 8 + 4 * hf);
      }
      asm volatile("s_waitcnt lgkmcnt(0)" ::: "memory");
      if (dir == 0) {
#pragma unroll
        for (int r = 0; r < 16; r++) {
          float nr = a0.x * h0r - a0.y * h0i + x0[r], ni = a0.x * h0i + a0.y * h0r + x2[r];
          h0r = nr; h0i = ni;
          float mr = a1.x * h1r - a1.y * h1i + x1[r], mi = a1.x * h1i + a1.y * h1r + x3[r];
          h1r = mr; h1i = mi;
          *(unsigned*)(Hs + (hf * 16 + r) * 136 + 2 * li) = pk(h0r, h0i);
          *(unsigned*)(Hs + (hf * 16 + r) * 136 + 2 * (li + 32)) = pk(h1r, h1i);
        }
      } else {
#pragma unroll
        for (int r = 15; r >= 0; r--) {
          float nr = a0.x * h0r - a0.y * h0i + x0[r], ni = a0.x * h0i + a0.y * h0r + x2[r];
          h0r = nr; h0i = ni;
          float mr = a1.x * h1r - a1.y * h1i + x1[r], mi = a1.x * h1i + a1.y * h1r + x3[r];
          h1r = mr; h1i = mi;
          *(unsigned*)(Hs + (hf * 16 + r) * 136 + 2 * li) = pk(h0r, h0i);
          *(unsigned*)(Hs + (hf * 16 + r) * 136 + 2 * (li + 32)) = pk(h1r, h1i);
        }
      }
      asm volatile("s_waitcnt lgkmcnt(0)" ::: "memory");
      f32x16 y = zero;
#pragma unroll
      for (int s = 0; s < 8; s++) {
        bf16x8 hfv = *(const bf16x8*)(Hs + li * 136 + 16 * s + 8 * hf);
        y = MFMA(ccf[s], hfv, y);
      }
      if (dir == 0) {
        *(float4*)(YF + yoff + 4 * hf) = make_float4(y[0], y[1], y[2], y[3]);
        *(float4*)(YF + yoff + 8 + 4 * hf) = make_float4(y[4], y[5], y[6], y[7]);
      } else {
        float4 d0 = *(const float4*)(p.ssm_d + l * 512 + g * 16 + 4 * hf);
        float4 d1 = *(const float4*)(p.ssm_d + l * 512 + g * 16 + 8 + 4 * hf);
        float v[8];
        v[0] = f0.x + y[0] + d0.x * u0.x; v[1] = f0.y + y[1] + d0.y * u0.y;
        v[2] = f0.z + y[2] + d0.z * u0.z; v[3] = f0.w + y[3] + d0.w * u0.w;
        v[4] = f1.x + y[4] + d1.x * u1.x; v[5] = f1.y + y[5] + d1.y * u1.y;
        v[6] = f1.z + y[6] + d1.z * u1.z; v[7] = f1.w + y[7] + d1.w * u1.w;
#pragma unroll
        for (int e = 0; e < 8; e++) {
          float xx = v[e];
          float z = 0.7978845608028654f * (xx + 0.044715f * xx * xx * xx);
          float th = 1.f - 2.f / (__expf(2.f * z) + 1.f);
          v[e] = 0.5f * xx * (1.f + th);
        }
        u16* yg = YG + tl_idx(ob * 4096 + tt, g * 16);
        st_bf4(yg + 4 * hf, v[0], v[1], v[2], v[3]);
        st_bf4(yg + 8 + 4 * hf, v[4], v[5], v[6], v[7]);
      }
    }
    asm volatile("s_waitcnt lgkmcnt(0)" ::: "memory");
  }
}

DI void qkpost_phase(int l) {
  const Params p = kparams();
  const float* ROPE = (const float*)(p.ws + OFF_ROPE);
  const int nrows = T_TOK * 8 + T_TOK * 2;
  for (int r = blockIdx.x * 512 + tidx(); r < nrows; r += gridDim.x * 512) {
    const bool isq = r < T_TOK * 8;
    const int rk = r - T_TOK * 8;
    u16* row = isq ? ((u16*)(p.ws + OFF_Q) + (size_t)r * 64) : ((u16*)(p.ws + OFF_K) + (size_t)rk * 64);
    const int pos = isq ? ((r >> 3) & 4095) : (rk & 4095);
    const float* gn = isq ? (p.q_norm + l * 64) : (p.k_norm + l * 64);
    const float osc = isq ? QSCALE : 1.f;
    float v[64];
#pragma unroll
    for (int c = 0; c < 8; c++) {
      uint4 raw = ((const uint4*)row)[c];
      v[8 * c + 0] = __uint_as_float(raw.x << 16); v[8 * c + 1] = __uint_as_float(raw.x & 0xffff0000u);
      v[8 * c + 2] = __uint_as_float(raw.y << 16); v[8 * c + 3] = __uint_as_float(raw.y & 0xffff0000u);
      v[8 * c + 4] = __uint_as_float(raw.z << 16); v[8 * c + 5] = __uint_as_float(raw.z & 0xffff0000u);
      v[8 * c + 6] = __uint_as_float(raw.w << 16); v[8 * c + 7] = __uint_as_float(raw.w & 0xffff0000u);
    }
    float ss = 0.f;
#pragma unroll
    for (int e = 0; e < 64; e++) ss += v[e] * v[e];
    const float rn = rsqrtf(ss * (1.f / 64.f) + 1e-6f) * osc;
    const int irow = pos >> 6, icol = pos & 63;
    float tc[32], ts[32];
#pragma unroll
    for (int q = 0; q < 4; q++) {
      const float4 c0 = *(const float4*)(ROPE + irow * 16 + 4 * q), s0 = *(const float4*)(ROPE + 1024 + irow * 16 + 4 * q);
      const float4 c1 = *(const float4*)(ROPE + icol * 16 + 4 * q), s1 = *(const float4*)(ROPE + 1024 + icol * 16 + 4 * q);
      tc[4 * q + 0] = c0.x; tc[4 * q + 1] = c0.y; tc[4 * q + 2] = c0.z; tc[4 * q + 3] = c0.w;
      ts[4 * q + 0] = s0.x; ts[4 * q + 1] = s0.y; ts[4 * q + 2] = s0.z; ts[4 * q + 3] = s0.w;
      tc[16 + 4 * q + 0] = c1.x; tc[16 + 4 * q + 1] = c1.y; tc[16 + 4 * q + 2] = c1.z; tc[16 + 4 * q + 3] = c1.w;
      ts[16 + 4 * q + 0] = s1.x; ts[16 + 4 * q + 1] = s1.y; ts[16 + 4 * q + 2] = s1.z; ts[16 + 4 * q + 3] = s1.w;
    }
#pragma unroll
    for (int c = 0; c < 8; c++) {
      float o[8];
#pragma unroll
      for (int e = 0; e < 4; e++) {
        const int pi = 4 * c + e;
        const float cs = tc[pi], sn = ts[pi];
        const float y0 = v[2 * pi] * rn * gn[2 * pi], y1 = v[2 * pi + 1] * rn * gn[2 * pi + 1];
        o[2 * e] = y0 * cs - y1 * sn;
        o[2 * e + 1] = y0 * sn + y1 * cs;
      }
      uint4 w;
      w.x = pk(o[0], o[1]); w.y = pk(o[2], o[3]); w.z = pk(o[4], o[5]); w.w = pk(o[6], o[7]);
      ((uint4*)row)[c] = w;
    }
  }
}

DI void attn_phase(char* smem) {
  const Params p = kparams();
  for (int lq = blockIdx.x >> 3; lq < 64; lq += (gridDim.x >> 3)) attn_item(p, (blockIdx.x & 7) + 8 * lq, smem);
}
DI void ssm1_phase(int l) {
  const Params p = kparams();
  for (int it = blockIdx.x * 2 + vhalf(); it < 1024; it += gridDim.x * 2) ssm1_item(p, l, it);
}
DI void ssm2_phase(int l, char* smem) {
  const Params p = kparams();
  char* sm = smem + vhalf() * 40960;
  for (int it = blockIdx.x * 2 + vhalf(); it < 512; it += gridDim.x * 2) ssm2_item(p, l, it, sm);
}

DI void final_phase() {
  const Params p = kparams();
  const float* X = (const float*)(p.ws + OFF_X);
  const float* SSX = (const float*)(p.ws + OFF_SSX);
  const int total = T_TOK * 256;
  for (int i = blockIdx.x * 512 + tidx(); i < total; i += gridDim.x * 512) {
    int t = i >> 8, n = (i & 255) * 4;
    float rv = row_rinv16(SSX, t, 1.f / 1024.f);
    float4 x = *(const float4*)(X + (size_t)t * 1024 + n);
    float4 g = *(const float4*)(p.final_norm + n);
    float4 o;
    o.x = x.x * rv * g.x; o.y = x.y * rv * g.y; o.z = x.z * rv * g.z; o.w = x.w * rv * g.w;
    *(float4*)(p.out + (size_t)t * 1024 + n) = o;
  }
}

#define XB_TMO      128
#define XB_XCNT(j)  (256  + 64 * (j))
#define XB_XSUB(j)  (1280 + 64 * (j))
#define XB_XGEN(j)  (2304 + 64 * (j))
#define XB_TOP      3328
#define XB_TOPGEN   3392
#define XCD_BAR_WORDS 3456
#define XB_SPIN_CAP (1u << 18)
#define LAS __attribute__((address_space(3)))

__device__ __forceinline__ unsigned xb_ld(unsigned* p)              { return __hip_atomic_load(p, __ATOMIC_RELAXED, __HIP_MEMORY_SCOPE_AGENT); }
__device__ __forceinline__ unsigned xb_add(unsigned* p, unsigned v) { return __hip_atomic_fetch_add(p, v, __ATOMIC_RELAXED, __HIP_MEMORY_SCOPE_AGENT); }
__device__ __forceinline__ unsigned xb_xcc_id() { return (unsigned)__builtin_amdgcn_s_getreg((3 << 11) | 20) & 0xFu; }
#define XB_SPIN(cond, bar) do { unsigned _sp = 0; while (cond) { __builtin_amdgcn_s_sleep(1); \
    if ((++_sp & 255u) == 0u) { if (xb_ld(&(bar)[XB_TMO])) break; if (_sp > XB_SPIN_CAP) { atomicAdd(&(bar)[XB_TMO], 1u); break; } } } } while (0)

struct XcdBarrier {
    unsigned* bar; unsigned x;
    volatile LAS unsigned* st;
};

__device__ __forceinline__ XcdBarrier xcd_barrier_post(unsigned* bar, volatile LAS unsigned* st) {
    XcdBarrier b; b.bar = bar; b.x = xb_xcc_id(); b.st = st;
    if (threadIdx.x == 0) (void)xb_add(&bar[XB_XCNT(b.x)], 1u);
    return b;
}
__device__ __forceinline__ void xcd_barrier_complete(unsigned* bar, unsigned x, unsigned& nloc, unsigned& nx) {
    const unsigned G = gridDim.x * gridDim.y * gridDim.z;
    unsigned sum, cnt, mine, sp = 0u;
    for (;;) {
        sum = 0u; cnt = 0u; mine = 0u;
#pragma unroll
        for (unsigned j = 0; j < 16; ++j) { const unsigned c = xb_ld(&bar[XB_XCNT(j)]); sum += c; cnt += (c > 0u) ? 1u : 0u; mine = (j == x) ? c : mine; }
        if (sum == G) break;
        __builtin_amdgcn_s_sleep(1);
        if ((++sp & 255u) == 0u) { if (xb_ld(&bar[XB_TMO])) break; if (sp > XB_SPIN_CAP) { atomicAdd(&bar[XB_TMO], 1u); break; } }
    }
    nloc = mine > 0u ? mine : 1u; nx = cnt > 0u ? cnt : 1u;
}

__device__ __forceinline__ void xcd_barrier(const XcdBarrier& b) {
    asm volatile("s_waitcnt vmcnt(0)" ::: "memory");
    __syncthreads();
    if (threadIdx.x == 0) {
        unsigned* bar = b.bar;
        __builtin_amdgcn_s_waitcnt(0);
        unsigned nloc = b.st[0], nx = b.st[1];
        if (nloc == 0u) { xcd_barrier_complete(bar, b.x, nloc, nx); b.st[0] = nloc; b.st[1] = nx; }
        const unsigned old = xb_add(&bar[XB_XSUB(b.x)], 1u);
        const unsigned gen = old / nloc;
        if (old + 1u == (gen + 1u) * nloc) {
            __builtin_amdgcn_fence(__ATOMIC_RELEASE, "agent");
            asm volatile("s_waitcnt vmcnt(0)" ::: "memory");
            const unsigned og = xb_add(&bar[XB_TOP], 1u);
            const unsigned tg = og / nx;
            if (og + 1u == (tg + 1u) * nx) xb_add(&bar[XB_TOPGEN], 1u);
            else XB_SPIN(xb_ld(&bar[XB_TOPGEN]) == tg, bar);
            __builtin_amdgcn_fence(__ATOMIC_ACQUIRE, "agent");
            xb_add(&bar[XB_XGEN(b.x)], 1u);
            asm volatile("s_waitcnt vmcnt(0)" ::: "memory");
        } else {
            XB_SPIN(xb_ld(&bar[XB_XGEN(b.x)]) == gen, bar);
            __builtin_amdgcn_fence(__ATOMIC_ACQUIRE, "agent");
            asm volatile("s_waitcnt vmcnt(0)" ::: "memory");
        }
    }
    __syncthreads();
}
#define GSYNC() do { XcdBarrier xb_; xb_.bar = (unsigned*)(kparams().ws + OFF_BAR); xb_.x = xb_xcc_id(); xb_.st = (volatile LAS unsigned*)xb_words; xcd_barrier(xb_); } while (0)

__global__ void __launch_bounds__(512) mega(Params p_) {
  __shared__ __attribute__((aligned(16))) char smem[147456];
  cg::grid_group grid = cg::this_grid();
  __shared__ __attribute__((aligned(16))) unsigned xb_words[4];
  if (tidx() < 4) xb_words[tidx()] = 0u;
  __syncthreads();
  if (p_.ph_lo < 0) grid.sync();
  (void)xcd_barrier_post((unsigned*)(p_.ws + OFF_BAR), (volatile LAS unsigned*)xb_words);
  int ph = p_.ph_lo;
  const int ph_hi = p_.ph_hi;
  if (ph == 0 && ph < ph_hi) {
    phase0(smem);
    ph++;
    if (ph < ph_hi) GSYNC();
  }
  if (ph == 1 && ph < ph_hi) {
    phase1(smem);
    ph++;
    if (ph < ph_hi) GSYNC();
  }
  for (; ph < ph_hi && ph < NPHASE - 1; ph++) {
    const int l = (ph - 2) / 7, k = (ph - 2) % 7;
    if (k == 0) gemm_phase<EPI_IN>(l, smem);
    else if (k == 1) { qkpost_phase(l); ssm1_phase(l); }
    else if (k == 2) {
      const int first = (blockIdx.x >> 3) & 1;
      for (int s2 = 0; s2 < 2; s2++) {
        __syncthreads();
        if ((s2 ^ first) == 0) attn_phase(smem);
        else ssm2_phase(l, smem);
      }
    }
    else if (k == 3) gemm_phase<EPI_GLU>(l, smem);
    else if (k == 4) gemm_phase<EPI_OUT>(l, smem);
    else if (k == 5) gemm_phase<EPI_F1>(l, smem);
    else gemm_phase<EPI_F2>(l, smem);
    if (ph + 1 < ph_hi) GSYNC();
  }
  if (ph == NPHASE - 1 && ph < ph_hi) final_phase();
}

extern "C" void kernel_launch(void* const* d_in, const int* in_sizes, int n_in, void* d_out, int out_size, void* d_ws,
                              size_t ws_size, hipStream_t stream) {
  static int grid_blocks = 0;
  if (!grid_blocks) {
    int dev = 0, cus = 0;
    (void)hipGetDevice(&dev);
    (void)hipDeviceGetAttribute(&cus, hipDeviceAttributeMultiprocessorCount, dev);
    grid_blocks = cus;
    if (grid_blocks < 8 || (grid_blocks & 7)) grid_blocks = 256;
    if (ws_size < WS_TOTAL) fprintf(stderr, "kernel_launch: workspace too small: %zu < %zu\n", ws_size, (size_t)WS_TOTAL);
  }
  if (ws_size < WS_TOTAL) return;
  Params p{};
  const float** pp = (const float**)&p;
  for (int i = 0; i < 25; i++) pp[i] = (const float*)d_in[i];
  p.out = (float*)d_out;
  p.ws = (char*)d_ws;
  p.ph_lo = 0;
  p.ph_hi = NPHASE;
  (void)hipMemsetAsync((char*)d_ws + OFF_BAR, 0, 16384, stream);
  void* args[] = {&p};
  hipError_t e = hipLaunchCooperativeKernel((void*)mega, dim3(grid_blocks), dim3(512), args, 0, stream);
  if (e != hipSuccess) fprintf(stderr, "cooperative launch failed: %s (grid %d)\n", hipGetErrorString(e), grid_blocks);
}
```

```cpp
#include <hip/hip_runtime.h>
#include <hip/hip_cooperative_groups.h>
#include <cstdio>
namespace cg = cooperative_groups;

typedef __attribute__((ext_vector_type(8))) short bf16x8;
typedef __attribute__((ext_vector_type(16))) float f32x16;
typedef __attribute__((ext_vector_type(2))) __bf16 bf2v;
typedef __attribute__((ext_vector_type(2))) float f2v;
typedef unsigned short u16;

#define DI __device__ __forceinline__
#define MFMA(a, b, c) __builtin_amdgcn_mfma_f32_32x32x16_bf16((a), (b), (c), 0, 0, 0)

constexpr int T_TOK = 32768;
constexpr int NPHASE = 31;
constexpr float QSCALE = 0.125f * 1.4426950408889634f;

constexpr size_t OFF_WT_IN  = 0;
constexpr size_t OFF_WT_GLU = OFF_WT_IN + 10485760;
constexpr size_t OFF_WT_OUT = OFF_WT_GLU + 2097152;
constexpr size_t OFF_WT_F1  = OFF_WT_OUT + 8388608;
constexpr size_t OFF_WT_F2  = OFF_WT_F1 + 46137344;
constexpr size_t OFF_MOD    = OFF_WT_F2 + 23068672;
constexpr size_t OFF_BIAS1  = OFF_MOD + 786432;
constexpr size_t OFF_BIAS2  = OFF_BIAS1 + 163840;
constexpr size_t OFF_ROPE   = OFF_BIAS2 + 720896;
constexpr size_t OFF_SSMA   = OFF_ROPE + 8192;
constexpr size_t OFF_SSMBB  = OFF_SSMA + 262144;
constexpr size_t OFF_SSMCC  = OFF_SSMBB + 1048576;
constexpr size_t OFF_E      = OFF_SSMCC + 1048576;
constexpr size_t OFF_SSX    = OFF_E + 4194304;
constexpr size_t OFF_SSA    = OFF_SSX + 2097152;
constexpr size_t OFF_SSS    = OFF_SSA + 1048576;
constexpr size_t OFF_X      = OFF_SSS + 1048576;
constexpr size_t OFF_ACT    = OFF_X + 134217728;
constexpr size_t OFF_UNION  = OFF_ACT + 67108864;
constexpr size_t OFF_HID    = OFF_UNION;
constexpr size_t OFF_Q      = OFF_UNION;
constexpr size_t OFF_K      = OFF_Q + 33554432;
constexpr size_t OFF_VT     = OFF_K + 8388608;
constexpr size_t OFF_U2     = OFF_VT + 8388608;
constexpr size_t OFF_YG     = OFF_U2 + 33554432;
constexpr size_t OFF_OATT   = OFF_YG + 33554432;
constexpr size_t OFF_OSSM   = OFF_OATT + 33554432;
constexpr size_t OFF_BAR    = OFF_UNION + 184549376;
constexpr size_t WS_TOTAL   = OFF_BAR + 16384;

struct Params {
  const float *x, *c, *w_ada, *b_ada, *norm1, *w_in, *q_norm, *k_norm, *lam_re, *lam_im, *log_dt,
      *b_re, *b_im, *c_re, *c_im, *ssm_d, *w_glu, *b_glu, *attn_out_norm, *ssm_out_norm, *w_out, *norm2,
      *w_ffn_in, *w_ffn_out, *final_norm;
  float* out;
  char* ws;
  int ph_lo, ph_hi;
};

DI unsigned pk(float a, float b) {
  f2v v = {a, b};
  bf2v r = __builtin_convertvector(v, bf2v);
  return __builtin_bit_cast(unsigned, r);
}
DI int tidx() { int t = __builtin_amdgcn_workitem_id_x(); asm volatile("" : "+v"(t)); return t; }
typedef const Params __attribute__((address_space(4)))* KParamPtr;
DI Params kparams() {
#if defined(__HIP_DEVICE_COMPILE__)
  KParamPtr q = (KParamPtr)__builtin_amdgcn_kernarg_segment_ptr();
  asm volatile("" : "+s"(q));
  return *q;
#else
  return Params{};
#endif
}
DI int vtid() { return tidx() & 255; }
DI int vhalf() { return tidx() >> 8; }
DI float bf2f(unsigned short h) { return __uint_as_float(((unsigned)h) << 16); }
DI void st_bf4(u16* dst, float a, float b, float c, float d) {
  uint2 v; v.x = pk(a, b); v.y = pk(c, d);
  *(uint2*)dst = v;
}
DI float4 ld_bf4(const u16* src) {
  uint2 v = *(const uint2*)src;
  float4 r;
  r.x = __uint_as_float(v.x << 16); r.y = __uint_as_float(v.x & 0xffff0000u);
  r.z = __uint_as_float(v.y << 16); r.w = __uint_as_float(v.y & 0xffff0000u);
  return r;
}
DI float shfl_x32(float v, int hi) {
  auto r = __builtin_amdgcn_permlane32_swap(__float_as_uint(v), __float_as_uint(v), false, false);
  return __uint_as_float(hi ? r[0] : r[1]);
}
DI float row16_sum(float v) {
  v += __int_as_float(__builtin_amdgcn_update_dpp(0, __float_as_int(v), 0x121, 0xf, 0xf, false));
  v += __int_as_float(__builtin_amdgcn_update_dpp(0, __float_as_int(v), 0x122, 0xf, 0xf, false));
  v += __int_as_float(__builtin_amdgcn_update_dpp(0, __float_as_int(v), 0x124, 0xf, 0xf, false));
  v += __int_as_float(__builtin_amdgcn_update_dpp(0, __float_as_int(v), 0x128, 0xf, 0xf, false));
  return v;
}
DI float wave_sum(float v) {
  v = row16_sum(v);
  v += __int_as_float(__builtin_amdgcn_ds_swizzle(__float_as_int(v), 0x401F));
  const int hi = (tidx() >> 5) & 1;
  return v + shfl_x32(v, hi);
}
DI size_t tl_idx(int t, int n) { return ((size_t)(n >> 6) * T_TOK + t) * 64 + (n & 63); }
DI int crow(int r, int hf) { return (r & 3) + 8 * (r >> 2) + 4 * hf; }
DI int f1perm(int n) {
  int j = (n < 2816) ? n : n - 2816;
  return (j >> 5) * 64 + (j & 31) + ((n < 2816) ? 0 : 32);
}

DI void transpose_tile(const float* __restrict__ src, int N, u16* __restrict__ dst, int K, int k0, int n0,
                       int permmode, const float* __restrict__ kscale, float* tl) {
  const int tid = vtid();
  __syncthreads();
#pragma unroll 4
  for (int i = 0; i < 16; i++) {
    int r = (tid >> 6) + 4 * i;
    float v = src[(size_t)(k0 + r) * N + n0 + (tid & 63)];
    if (kscale) v *= kscale[k0 + r];
    tl[r * 65 + (tid & 63)] = v;
  }
  __syncthreads();
#pragma unroll 4
  for (int i = 0; i < 8; i++) {
    int n = (tid >> 5) + 8 * i;
    int kp = tid & 31;
    float a = tl[(2 * kp) * 65 + n], b = tl[(2 * kp + 1) * 65 + n];
    int nn = n0 + n;
    int no = permmode ? f1perm(nn) : nn;
    *(unsigned*)(dst + ((size_t)(k0 >> 6) * N + no) * 64 + 2 * kp) = pk(a, b);
  }
}

DI void gemv8_item(const float* vec, int vstride, bool do_silu, const float* __restrict__ W, int N, int j0,
                   const float* bias, float* out, int ostride, int permmode, float* sm) {
  const int tid = vtid();
  float* vs = sm;
  float* red = sm + 8192;
  __syncthreads();
  for (int i = tid; i < 8192; i += 256) {
    int b = i >> 10, k = i & 1023;
    float v = vec[(size_t)b * vstride + k];
    if (do_silu) v = v / (1.f + expf(-v));
    vs[i] = v;
  }
  __syncthreads();
  const int kq = tid >> 6, jj = tid & 63;
  float acc[8];
#pragma unroll
  for (int b = 0; b < 8; b++) acc[b] = 0.f;
#pragma unroll 4
  for (int k = kq * 256; k < kq * 256 + 256; k++) {
    float w = W[(size_t)k * N + j0 + jj];
#pragma unroll
    for (int b = 0; b < 8; b++) acc[b] += vs[b * 1024 + k] * w;
  }
#pragma unroll
  for (int b = 0; b < 8; b++) red[(kq * 8 + b) * 64 + jj] = acc[b];
  __syncthreads();
  for (int o = tid; o < 512; o += 256) {
    int b = o >> 6, j = o & 63;
    float s = red[(0 * 8 + b) * 64 + j] + red[(8 + b) * 64 + j] + red[(16 + b) * 64 + j] + red[(24 + b) * 64 + j];
    int jg = j0 + j;
    if (bias) s += bias[jg];
    int jo = permmode ? f1perm(jg) : jg;
    out[(size_t)b * ostride + jo] = s;
  }
}

DI void ssm_param_item(const Params& p, int idx) {
  const int tid = vtid();
  const int pp = tid & 63, cq = tid >> 6;
  float* SSMA = (float*)(p.ws + OFF_SSMA);
  u16* BB = (u16*)(p.ws + OFF_SSMBB);
  u16* CC = (u16*)(p.ws + OFF_SSMCC);
  double lr = (double)p.lam_re[idx * 64 + pp];
  if (lr > -1e-4) lr = (double)(-1e-4f);
  double li = (double)p.lam_im[idx * 64 + pp];
  double dt = exp((double)p.log_dt[idx]);
  double mag = exp(lr * dt);
  double ar = mag * cos(li * dt), ai = mag * sin(li * dt);
  double den = lr * lr + li * li;
  double nre = ar - 1.0;
  double kre = (nre * lr + ai * li) / den;
  double kim = (ai * lr - nre * li) / den;
  if (cq == 0) {
    double magL = exp(lr * dt * 256.0);
    float4 v;
    v.x = (float)ar; v.y = (float)ai;
    v.z = (float)(magL * cos(li * dt * 256.0)); v.w = (float)(magL * sin(li * dt * 256.0));
    *(float4*)(SSMA + (size_t)(idx * 64 + pp) * 4) = v;
  }
#pragma unroll
  for (int cc = 0; cc < 4; cc++) {
    int c = cq * 4 + cc;
    double br = (double)p.b_re[(size_t)(idx * 64 + pp) * 16 + c];
    double bi = (double)p.b_im[(size_t)(idx * 64 + pp) * 16 + c];
    float bbr = (float)(kre * br - kim * bi);
    float bbi = (float)(kre * bi + kim * br);
    BB[(size_t)(idx * 128 + pp) * 16 + c] = (u16)(pk(bbr, 0.f) & 0xffffu);
    BB[(size_t)(idx * 128 + 64 + pp) * 16 + c] = (u16)(pk(bbi, 0.f) & 0xffffu);
    float cr = p.c_re[(size_t)(idx * 16 + c) * 64 + pp];
    float ci = p.c_im[(size_t)(idx * 16 + c) * 64 + pp];
    *(unsigned*)(CC + (size_t)(idx * 16 + c) * 128 + 2 * pp) = pk(cr, -ci);
  }
}

DI void phase0(char* smem) {
  const Params p = kparams();
  float* sm = (float*)(smem + vhalf() * 40960);
  constexpr int N_TIN = 4 * 16 * 20, N_TGLU = 4 * 8 * 8, N_TOUT = 4 * 16 * 16, N_TF1 = 4 * 16 * 88, N_TF2 = 4 * 44 * 16;
  constexpr int N_MOD = 4 * 96, N_SSM = 256, N_ROPE = 1;
  constexpr int S0 = N_MOD, S1 = S0 + N_TIN, S2 = S1 + N_TGLU, S3 = S2 + N_TOUT, S4 = S3 + N_TF1, S5 = S4 + N_TF2,
                S6 = S5 + N_SSM, S7 = S6 + N_ROPE;
  for (int it = blockIdx.x * 2 + vhalf(); it < S7 + 1; it += gridDim.x * 2) {
    if (it < S0) {
      int l = it / 96, jb = it % 96;
      gemv8_item(p.c, 1024, true, p.w_ada + (size_t)l * 1024 * 6144, 6144, jb * 64, p.b_ada + l * 6144,
                 (float*)(p.ws + OFF_MOD) + (size_t)l * 8 * 6144, 6144, 0, sm);
    } else if (it < S1) {
      int r = it - S0; int l = r / 320; r %= 320; int kt = r / 20, ntile = r % 20;
      transpose_tile(p.w_in + (size_t)l * 1024 * 1280, 1280, (u16*)(p.ws + OFF_WT_IN) + (size_t)l * 1280 * 1024, 1024,
                     kt * 64, ntile * 64, 0, nullptr, sm);
    } else if (it < S2) {
      int r = it - S1; int l = r / 64; r %= 64; int kt = r / 8, ntile = r % 8;
      transpose_tile(p.w_glu + (size_t)l * 512 * 512, 512, (u16*)(p.ws + OFF_WT_GLU) + (size_t)l * 512 * 512, 512,
                     kt * 64, ntile * 64, 0, nullptr, sm);
    } else if (it < S3) {
      int r = it - S2; int l = r / 256; r %= 256; int kt = r / 16, ntile = r % 16;
      const float* ks = (kt < 8) ? (p.attn_out_norm + l * 512) : (p.ssm_out_norm + l * 512 - 512);
      transpose_tile(p.w_out + (size_t)l * 1024 * 1024, 1024, (u16*)(p.ws + OFF_WT_OUT) + (size_t)l * 1024 * 1024, 1024,
                     kt * 64, ntile * 64, 0, ks, sm);
    } else if (it < S4) {
      int r = it - S3; int l = r / 1408; r %= 1408; int kt = r / 88, ntile = r % 88;
      transpose_tile(p.w_ffn_in + (size_t)l * 1024 * 5632, 5632, (u16*)(p.ws + OFF_WT_F1) + (size_t)l * 5632 * 1024, 1024,
                     kt * 64, ntile * 64, 1, nullptr, sm);
    } else if (it < S5) {
      int r = it - S4; int l = r / 704; r %= 704; int kt = r / 16, ntile = r % 16;
      transpose_tile(p.w_ffn_out + (size_t)l * 2816 * 1024, 1024, (u16*)(p.ws + OFF_WT_F2) + (size_t)l * 1024 * 2816, 2816,
                     kt * 64, ntile * 64, 0, nullptr, sm);
    } else if (it < S6) {
      ssm_param_item(p, it - S5);
    } else {
      float* rope = (float*)(p.ws + OFF_ROPE);
      for (int i = vtid(); i < 1024; i += 256) {
        int idx = i >> 4, f = i & 15;
        double ang = (double)idx * pow(10000.0, -(double)f / 16.0);
        rope[i] = (float)cos(ang);
        rope[1024 + i] = (float)sin(ang);
      }
    }
  }
}

DI void phase1(char* smem) {
  const Params p = kparams();
  float* sm = (float*)(smem + vhalf() * 40960);
  const float* MOD = (const float*)(p.ws + OFF_MOD);
  constexpr int N_B1 = 4 * 20, N_B2 = 4 * 88, N_PREP = T_TOK / 4;
  for (int it = blockIdx.x * 2 + vhalf(); it < N_B1 + N_B2 + N_PREP; it += gridDim.x * 2) {
    if (it < N_B1) {
      int l = it / 20, jb = it % 20;
      gemv8_item(MOD + (size_t)l * 8 * 6144 + 0, 6144, false, p.w_in + (size_t)l * 1024 * 1280, 1280, jb * 64, nullptr,
                 (float*)(p.ws + OFF_BIAS1) + (size_t)l * 8 * 1280, 1280, 0, sm);
    } else if (it < N_B1 + N_B2) {
      int r = it - N_B1; int l = r / 88, jb = r % 88;
      gemv8_item(MOD + (size_t)l * 8 * 6144 + 3072, 6144, false, p.w_ffn_in + (size_t)l * 1024 * 5632, 5632, jb * 64, nullptr,
                 (float*)(p.ws + OFF_BIAS2) + (size_t)l * 8 * 5632, 5632, 1, sm);
    } else {
      int r = it - N_B1 - N_B2;
      const int lane = vtid() & 63, wave = vtid() >> 6;
      int t = r * 4 + wave;
      int b = t >> 12;
      const float4* xr = (const float4*)(p.x + (size_t)t * 1024);
      float4 v[4];
      float ss = 0.f;
#pragma unroll
      for (int i = 0; i < 4; i++) {
        v[i] = xr[lane + 64 * i];
        ss += v[i].x * v[i].x + v[i].y * v[i].y + v[i].z * v[i].z + v[i].w * v[i].w;
      }
      ss = wave_sum(ss);
      float* SSX = (float*)(p.ws + OFF_SSX);
      if (lane < 16) SSX[(size_t)t * 16 + lane] = (lane == 0) ? ss : 0.f;
      u16* ACT = (u16*)(p.ws + OFF_ACT);
      const float* sc1 = MOD + (size_t)(0 * 8 + b) * 6144 + 1024;
#pragma unroll
      for (int i = 0; i < 4; i++) {
        int k = (lane + 64 * i) * 4;
        float4 g = *(const float4*)(p.norm1 + k);
        float4 s = *(const float4*)(sc1 + k);
        st_bf4(ACT + tl_idx(t, k), v[i].x * g.x * (1.f + s.x), v[i].y * g.y * (1.f + s.y),
               v[i].z * g.z * (1.f + s.z), v[i].w * g.w * (1.f + s.w));
      }
    }
  }
}

enum { EPI_IN = 0, EPI_GLU = 1, EPI_OUT = 2, EPI_F1 = 3, EPI_F2 = 4 };

DI float row_rinv16(const float* ssx, int t, float invn) {
  const float4* q = (const float4*)(ssx + (size_t)t * 16);
  float4 a = q[0], b = q[1], c = q[2], d = q[3];
  float s = ((a.x + a.y) + (a.z + a.w)) + ((b.x + b.y) + (b.z + b.w)) + ((c.x + c.y) + (c.z + c.w)) + ((d.x + d.y) + (d.z + d.w));
  return rsqrtf(s * invn + 1e-6f);
}
DI float row_rinv8(const float* ss8, int t, float invn) {
  const float4* q = (const float4*)(ss8 + (size_t)t * 8);
  float4 a = q[0], b = q[1];
  float s = ((a.x + a.y) + (a.z + a.w)) + ((b.x + b.y) + (b.z + b.w));
  return rsqrtf(s * invn + 1e-6f);
}

template <int EPI>
DI void gemm_tile(const Params& p, const int l, const int mt, const int nt, char* smem, uint4& ra0, uint4& ra1, uint4& ra2, uint4& ra3,
               uint4& rb0, uint4& rb1, uint4& rb2, uint4& rb3, const bool first, const bool has_next, const int mt_next, const int nt_next) {
  constexpr int TJ = 4;
  constexpr int K = (EPI == EPI_GLU) ? 512 : (EPI == EPI_F2 ? 2816 : 1024);
  constexpr int KT = K / 64;
  u16* As = (u16*)smem;
  u16* Bs = As + 256 * 72;
  const int tid = tidx(), lane = tid & 63, wave = tid >> 6;
  const int wm = wave >> 2, wn = wave & 3;
  const int hf = lane >> 5, li = lane & 31;
  const int m0 = mt * 256, n0 = nt * 256;

  const u16* A0;
  const u16* A1 = nullptr;
  const u16* W;
  if (EPI == EPI_IN) { A0 = (const u16*)(p.ws + OFF_ACT); W = (const u16*)(p.ws + OFF_WT_IN) + (size_t)l * 1280 * 1024; }
  else if (EPI == EPI_GLU) { A0 = (const u16*)(p.ws + OFF_YG); W = (const u16*)(p.ws + OFF_WT_GLU) + (size_t)l * 512 * 512; }
  else if (EPI == EPI_OUT) { A0 = (const u16*)(p.ws + OFF_OATT); A1 = (const u16*)(p.ws + OFF_OSSM); W = (const u16*)(p.ws + OFF_WT_OUT) + (size_t)l * 1024 * 1024; }
  else if (EPI == EPI_F1) { A0 = (const u16*)(p.ws + OFF_ACT); W = (const u16*)(p.ws + OFF_WT_F1) + (size_t)l * 5632 * 1024; }
  else { A0 = (const u16*)(p.ws + OFF_HID); W = (const u16*)(p.ws + OFF_WT_F2) + (size_t)l * 1024 * 2816; }

  const int lrow = tid >> 3, lc8 = tid & 7;
  constexpr int NW = (EPI == EPI_IN) ? 1280 : (EPI == EPI_GLU ? 512 : (EPI == EPI_F1 ? 5632 : 1024));
  constexpr size_t AKT = (size_t)T_TOK * 64, WKT = (size_t)NW * 64;
  const u16* ag0 = A0 + (size_t)(m0 + lrow) * 64 + lc8 * 8;
  const u16* ag1 = (EPI == EPI_OUT) ? (A1 + (size_t)(m0 + lrow) * 64 + lc8 * 8) : nullptr;
  const u16* wg = W + (size_t)(n0 + lrow) * 64 + lc8 * 8;

  f32x16 acc[2][TJ];
#pragma unroll
  for (int i = 0; i < 2; i++)
#pragma unroll
    for (int j = 0; j < TJ; j++)
#pragma unroll
      for (int r = 0; r < 16; r++) acc[i][j][r] = 0.f;

#define GEMM_GLOAD_R(kt_, A0_, A1_, A2_, A3_, B0_, B1_, B2_, B3_)                                 \
  {                                                                                              \
    const u16* ap;                                                                               \
    if (EPI == EPI_OUT) ap = ((kt_) < 8) ? (ag0 + (kt_) * AKT) : (ag1 + (long)((kt_) - 8) * (long)AKT);      \
    else ap = ag0 + (kt_) * AKT;                                                                 \
    const u16* wp = wg + (kt_) * WKT;                                                            \
    A0_ = *(const uint4*)(ap);                                                                   \
    A1_ = *(const uint4*)(ap + 64 * 64);                                                         \
    A2_ = *(const uint4*)(ap + 128 * 64);                                                        \
    A3_ = *(const uint4*)(ap + 192 * 64);                                                        \
    B0_ = *(const uint4*)(wp);                                                                   \
    B1_ = *(const uint4*)(wp + 64 * 64);                                                         \
    B2_ = *(const uint4*)(wp + 128 * 64);                                                        \
    B3_ = *(const uint4*)(wp + 192 * 64);                                                        \
  }
#define GEMM_LSTORE_R(boff_, A0_, A1_, A2_, A3_, B0_, B1_, B2_, B3_) \
  {                                                                \
    u16* a_ = As + (boff_) + lrow * 72 + lc8 * 8;                  \
    u16* b_ = Bs + (boff_) + lrow * 72 + lc8 * 8;                  \
    *(uint4*)(a_) = A0_;                                           \
    *(uint4*)(a_ + 64 * 72) = A1_;                                 \
    *(uint4*)(a_ + 128 * 72) = A2_;                                \
    *(uint4*)(a_ + 192 * 72) = A3_;                                \
    *(uint4*)(b_) = B0_;                                           \
    *(uint4*)(b_ + 64 * 72) = B1_;                                 \
    *(uint4*)(b_ + 128 * 72) = B2_;                                \
    *(uint4*)(b_ + 192 * 72) = B3_;                                \
  }
#define GEMM_COMPUTE(cur_, DOST_, oth_, A0_, A1_, A2_, A3_, B0_, B1_, B2_, B3_)                                          \
  {                                                                                                                     \
    u16* a_ = As + (oth_) + lrow * 72 + lc8 * 8;                                                                        \
    u16* b_ = Bs + (oth_) + lrow * 72 + lc8 * 8;                                                                        \
    _Pragma("unroll") for (int s = 0; s < 4; s++) {                                                                     \
      bf16x8 wf[2], af[TJ];                                                                                             \
      _Pragma("unroll") for (int i = 0; i < 2; i++)                                                                     \
        wf[i] = *(const bf16x8*)(Bs + (cur_) + (wn * 64 + i * 32 + li) * 72 + s * 16 + hf * 8);                         \
      _Pragma("unroll") for (int j = 0; j < TJ; j++)                                                                    \
        af[j] = *(const bf16x8*)(As + (cur_) + (wm * 128 + j * 32 + li) * 72 + s * 16 + hf * 8);                        \
      _Pragma("unroll") for (int i = 0; i < 2; i++)                                                                     \
        _Pragma("unroll") for (int j = 0; j < TJ; j++) acc[i][j] = MFMA(wf[i], af[j], acc[i][j]);                       \
        \
      if (DOST_) {                                                                                                      \
        if (s == 0) { *(uint4*)(a_) = A0_; *(uint4*)(a_ + 64 * 72) = A1_; }                                             \
        if (s == 1) { *(uint4*)(a_ + 128 * 72) = A2_; *(uint4*)(a_ + 192 * 72) = A3_; }                                 \
        if (s == 2) { *(uint4*)(b_) = B0_; *(uint4*)(b_ + 64 * 72) = B1_; }                                             \
        if (s == 3) { *(uint4*)(b_ + 128 * 72) = B2_; *(uint4*)(b_ + 192 * 72) = B3_; }                                 \
      }                                                                                                                 \
    }                                                                                                                   \
  }
  constexpr int BUF = 2 * 256 * 72;
  uint4 sa0, sa1, sa2, sa3, sb0, sb1, sb2, sb3;
  if (first) GEMM_GLOAD_R(0, ra0, ra1, ra2, ra3, rb0, rb1, rb2, rb3);
  GEMM_GLOAD_R(1, sa0, sa1, sa2, sa3, sb0, sb1, sb2, sb3);
  int tok[TJ];
#pragma unroll
  for (int j = 0; j < TJ; j++) tok[j] = m0 + wm * 128 + j * 32 + li;

  __syncthreads();
  GEMM_LSTORE_R(0, ra0, ra1, ra2, ra3, rb0, rb1, rb2, rb3);
  GEMM_GLOAD_R(2, ra0, ra1, ra2, ra3, rb0, rb1, rb2, rb3);
  __syncthreads();
#pragma unroll 1
  for (int kt = 0; kt < KT; kt += 2) {
    if (EPI == EPI_OUT) {
      if (kt == 8) {
#pragma unroll
        for (int j = 0; j < TJ; j++) {
          const float ra_ = row_rinv8((const float*)(p.ws + OFF_SSA), tok[j], 1.f / 512.f);
          const float rs_ = row_rinv8((const float*)(p.ws + OFF_SSS), tok[j], 1.f / 512.f);
          const float mr = ra_ / rs_;
#pragma unroll
          for (int i = 0; i < 2; i++)
#pragma unroll
            for (int r = 0; r < 16; r++) acc[i][j][r] *= mr;
        }
      }
    }
    GEMM_COMPUTE(0, true, BUF, sa0, sa1, sa2, sa3, sb0, sb1, sb2, sb3);
    if (kt + 3 < KT) GEMM_GLOAD_R(kt + 3, sa0, sa1, sa2, sa3, sb0, sb1, sb2, sb3);
    __syncthreads();
    GEMM_COMPUTE(BUF, (kt + 2 < KT), 0, ra0, ra1, ra2, ra3, rb0, rb1, rb2, rb3);
    if (kt + 4 < KT) GEMM_GLOAD_R(kt + 4, ra0, ra1, ra2, ra3, rb0, rb1, rb2, rb3);
    __syncthreads();
  }
  float rinv_all[TJ];
#pragma unroll
  for (int j = 0; j < TJ; j++) rinv_all[j] = (EPI == EPI_IN || EPI == EPI_F1) ? row_rinv16((const float*)(p.ws + OFF_SSX), tok[j], 1.f / 1024.f) : 1.f;
  if (has_next && EPI != EPI_OUT && EPI != EPI_F2) {
    const u16* ap = A0 + (size_t)(mt_next * 256 + lrow) * 64 + lc8 * 8;
    const u16* wp = W + (size_t)(nt_next * 256 + lrow) * 64 + lc8 * 8;
    ra0 = *(const uint4*)(ap);
    ra1 = *(const uint4*)(ap + 64 * 64);
    ra2 = *(const uint4*)(ap + 128 * 64);
    ra3 = *(const uint4*)(ap + 192 * 64);
    rb0 = *(const uint4*)(wp);
    rb1 = *(const uint4*)(wp + 64 * 64);
    rb2 = *(const uint4*)(wp + 128 * 64);
    rb3 = *(const uint4*)(wp + 192 * 64);
  }

  const int b = m0 >> 12;
  const int nbase = n0 + wn * 64;
  const float* MOD = (const float*)(p.ws + OFF_MOD);

  if (EPI == EPI_IN) {
    const float* bias = (const float*)(p.ws + OFF_BIAS1) + (size_t)(l * 8 + b) * 1280;
    const float* SSX = (const float*)(p.ws + OFF_SSX);
    float rinv[TJ];
#pragma unroll
    for (int j = 0; j < TJ; j++) rinv[j] = rinv_all[j];
#pragma unroll
    for (int i = 0; i < 2; i++)
#pragma unroll
      for (int q4 = 0; q4 < 4; q4++) {
        float4 b4 = *(const float4*)(bias + nbase + i * 32 + 8 * q4 + 4 * hf);
#pragma unroll
        for (int j = 0; j < TJ; j++) {
          acc[i][j][4 * q4 + 0] = acc[i][j][4 * q4 + 0] * rinv[j] + b4.x;
          acc[i][j][4 * q4 + 1] = acc[i][j][4 * q4 + 1] * rinv[j] + b4.y;
          acc[i][j][4 * q4 + 2] = acc[i][j][4 * q4 + 2] * rinv[j] + b4.z;
          acc[i][j][4 * q4 + 3] = acc[i][j][4 * q4 + 3] * rinv[j] + b4.w;
        }
      }
    if (nbase < 640) {
#pragma unroll
      for (int j = 0; j < TJ; j++) {
        const int t = tok[j], pos = t & 4095;
#pragma unroll
        for (int i = 0; i < 2; i++)
#pragma unroll
          for (int q4 = 0; q4 < 4; q4++) {
            const int d0 = i * 32 + 8 * q4 + 4 * hf;
            u16* dst = (nbase < 512) ? ((u16*)(p.ws + OFF_Q) + (size_t)t * 512 + nbase + d0)
                                     : ((u16*)(p.ws + OFF_K) + ((size_t)(b * 2 + ((nbase - 512) >> 6)) * 4096 + pos) * 64 + d0);
            st_bf4(dst, acc[i][j][4 * q4 + 0], acc[i][j][4 * q4 + 1], acc[i][j][4 * q4 + 2], acc[i][j][4 * q4 + 3]);
          }
      }
    } else if (nbase < 768) {
      u16* VT = (u16*)(p.ws + OFF_VT);
      const int vh = (nbase - 640) >> 6;
#pragma unroll
      for (int j = 0; j < TJ; j++) {
        const int pos = tok[j] & 4095;
#pragma unroll
        for (int i = 0; i < 2; i++)
#pragma unroll
          for (int r = 0; r < 16; r++) {
            int d = i * 32 + crow(r, hf);
            VT[((size_t)(b * 2 + vh) * 64 + d) * 4096 + pos] = (u16)(pk(acc[i][j][r], 0.f) & 0xffffu);
          }
      }
    } else {
      u16* U2 = (u16*)(p.ws + OFF_U2);
      const int ch0 = nbase - 768;
#pragma unroll
      for (int j = 0; j < TJ; j++) {
        const int pos = tok[j] & 4095;
#pragma unroll
        for (int i = 0; i < 2; i++)
#pragma unroll
          for (int q4 = 0; q4 < 4; q4++) {
            int ch = ch0 + i * 32 + 8 * q4 + 4 * hf;
            int g = ch >> 4, c0 = ch & 15;
            st_bf4(U2 + (((size_t)(b * 32 + g)) * 4096 + pos) * 16 + c0, acc[i][j][4 * q4 + 0], acc[i][j][4 * q4 + 1],
                   acc[i][j][4 * q4 + 2], acc[i][j][4 * q4 + 3]);
          }
      }
    }
  } else if (EPI == EPI_GLU) {
    const float* bg = p.b_glu + l * 512;
    const u16* YG = (const u16*)(p.ws + OFF_YG);
    u16* OSSM = (u16*)(p.ws + OFF_OSSM);
    float* SSS = (float*)(p.ws + OFF_SSS);
#pragma unroll
    for (int j = 0; j < TJ; j++) {
      const int t = tok[j];
      float ss = 0.f;
#pragma unroll
      for (int i = 0; i < 2; i++)
#pragma unroll
        for (int q4 = 0; q4 < 4; q4++) {
          const int n = nbase + i * 32 + 8 * q4 + 4 * hf;
          float4 b4 = *(const float4*)(bg + n);
          float4 y = ld_bf4(YG + tl_idx(t, n));
          float o0 = y.x / (1.f + __expf(-(acc[i][j][4 * q4 + 0] + b4.x)));
          float o1 = y.y / (1.f + __expf(-(acc[i][j][4 * q4 + 1] + b4.y)));
          float o2 = y.z / (1.f + __expf(-(acc[i][j][4 * q4 + 2] + b4.z)));
          float o3 = y.w / (1.f + __expf(-(acc[i][j][4 * q4 + 3] + b4.w)));
          ss += o0 * o0 + o1 * o1 + o2 * o2 + o3 * o3;
          st_bf4(OSSM + tl_idx(t, n), o0, o1, o2, o3);
        }
      ss += shfl_x32(ss, hf);
      if (hf == 0) SSS[(size_t)t * 8 + (nbase >> 6)] = ss;
    }
  } else if (EPI == EPI_OUT || EPI == EPI_F2) {
    const float* gate = MOD + (size_t)(l * 8 + b) * 6144 + (EPI == EPI_OUT ? 2048 : 5120);
    const bool has_next = (EPI == EPI_OUT) || (l < 3);
    const float* nrm = (EPI == EPI_OUT) ? (p.norm2 + l * 1024) : (p.norm1 + (l + 1) * 1024);
    const float* scn = (EPI == EPI_OUT) ? (MOD + (size_t)(l * 8 + b) * 6144 + 4096) : (MOD + (size_t)((l + 1) * 8 + b) * 6144 + 1024);
    const float* xin = (EPI == EPI_OUT && l == 0) ? p.x : (const float*)(p.ws + OFF_X);
    float* X = (float*)(p.ws + OFF_X);
    u16* ACT = (u16*)(p.ws + OFF_ACT);
    float* SSX = (float*)(p.ws + OFF_SSX);
    float* stg = (float*)smem + wave * (32 * 68);
    const int rr = lane >> 4, c4 = (lane & 15) * 4;
    const int n = nbase + c4;
    const float4 g4 = *(const float4*)(gate + n);
    float4 nsc = make_float4(0.f, 0.f, 0.f, 0.f);
    if (has_next) {
      const float4 nr = *(const float4*)(nrm + n);
      const float4 sc = *(const float4*)(scn + n);
      nsc = make_float4(nr.x * (1.f + sc.x), nr.y * (1.f + sc.y), nr.z * (1.f + sc.z), nr.w * (1.f + sc.w));
    }
    float4 xi[8], xn[8];
    float fj[TJ];
#pragma unroll
    for (int j = 0; j < TJ; j++) fj[j] = (EPI == EPI_OUT) ? row_rinv8((const float*)(p.ws + OFF_SSS), tok[j], 1.f / 512.f) : 1.f;
#pragma unroll
    for (int it = 0; it < 8; it++) xi[it] = *(const float4*)(xin + (size_t)(m0 + wm * 128 + rr + 4 * it) * 1024 + n);
#pragma unroll
    for (int j = 0; j < TJ; j++) {
#pragma unroll
      for (int i = 0; i < 2; i++)
#pragma unroll
        for (int q4 = 0; q4 < 4; q4++)
          *(float4*)(stg + li * 68 + i * 32 + 8 * q4 + 4 * hf) =
              make_float4(acc[i][j][4 * q4 + 0] * fj[j], acc[i][j][4 * q4 + 1] * fj[j], acc[i][j][4 * q4 + 2] * fj[j], acc[i][j][4 * q4 + 3] * fj[j]);
      asm volatile("s_waitcnt lgkmcnt(0)" ::: "memory");
      if (j + 1 < TJ) {
#pragma unroll
        for (int it = 0; it < 8; it++) xn[it] = *(const float4*)(xin + (size_t)(m0 + wm * 128 + (j + 1) * 32 + rr + 4 * it) * 1024 + n);
      }
#pragma unroll
      for (int it = 0; it < 8; it++) {
        const int row = rr + 4 * it;
        const int t = m0 + wm * 128 + j * 32 + row;
        const float4 a = *(const float4*)(stg + row * 68 + c4);
        float4 y;
        y.x = xi[it].x + g4.x * a.x;
        y.y = xi[it].y + g4.y * a.y;
        y.z = xi[it].z + g4.z * a.z;
        y.w = xi[it].w + g4.w * a.w;
        *(float4*)(X + (size_t)t * 1024 + n) = y;
        float ss = y.x * y.x + y.y * y.y + y.z * y.z + y.w * y.w;
        ss = row16_sum(ss);
        if ((lane & 15) == 0) SSX[(size_t)t * 16 + (nbase >> 6)] = ss;
        if (has_next) st_bf4(ACT + tl_idx(t, n), y.x * nsc.x, y.y * nsc.y, y.z * nsc.z, y.w * nsc.w);
      }
      asm volatile("s_waitcnt lgkmcnt(0)" ::: "memory");
      if (j + 1 < TJ) {
#pragma unroll
        for (int it = 0; it < 8; it++) xi[it] = xn[it];
      }
    }
  } else {
    const float* bias = (const float*)(p.ws + OFF_BIAS2) + (size_t)(l * 8 + b) * 5632;
    const float* SSX = (const float*)(p.ws + OFF_SSX);
    u16* HID = (u16*)(p.ws + OFF_HID);
    const int jbase = nbase >> 1;
#pragma unroll
    for (int j = 0; j < TJ; j++) {
      const int t = tok[j];
      const float rv = rinv_all[j];
#pragma unroll
      for (int q4 = 0; q4 < 4; q4++) {
        const int ng = nbase + 8 * q4 + 4 * hf;
        float4 bg4 = *(const float4*)(bias + ng);
        float4 bu4 = *(const float4*)(bias + ng + 32);
        float zg0 = acc[0][j][4 * q4 + 0] * rv + bg4.x, zu0 = acc[1][j][4 * q4 + 0] * rv + bu4.x;
        float zg1 = acc[0][j][4 * q4 + 1] * rv + bg4.y, zu1 = acc[1][j][4 * q4 + 1] * rv + bu4.y;
        float zg2 = acc[0][j][4 * q4 + 2] * rv + bg4.z, zu2 = acc[1][j][4 * q4 + 2] * rv + bu4.z;
        float zg3 = acc[0][j][4 * q4 + 3] * rv + bg4.w, zu3 = acc[1][j][4 * q4 + 3] * rv + bu4.w;
        float h0 = zg0 / (1.f + __expf(-zg0)) * zu0;
        float h1 = zg1 / (1.f + __expf(-zg1)) * zu1;
        float h2 = zg2 / (1.f + __expf(-zg2)) * zu2;
        float h3 = zg3 / (1.f + __expf(-zg3)) * zu3;
        st_bf4(HID + tl_idx(t, jbase + 8 * q4 + 4 * hf), h0, h1, h2, h3);
      }
    }
  }
}

template <int EPI>
DI void gemm_phase(int l, char* smem) {
  const Params p = kparams();
  constexpr int NT = (EPI == EPI_IN) ? 5 : (EPI == EPI_GLU ? 2 : (EPI == EPI_F1 ? 22 : 4));
  const int g8 = gridDim.x >> 3;
  const int xg = blockIdx.x & 7, lb = blockIdx.x >> 3;
  uint4 ra0, ra1, ra2, ra3, rb0, rb1, rb2, rb3;
  bool first = true;
  for (int q = lb; q < 16 * NT; q += g8) {
    const int mg = q / (8 * NT);
    const int rem = q - mg * 8 * NT;
    const int qn = q + g8;
    const bool has_next = qn < 16 * NT;
    const int mgn = qn / (8 * NT);
    const int remn = qn - mgn * 8 * NT;
    gemm_tile<EPI>(p, l, xg * 16 + mg * 8 + (rem & 7), rem >> 3, smem, ra0, ra1, ra2, ra3, rb0, rb1, rb2, rb3, first, has_next,
                   xg * 16 + mgn * 8 + (remn & 7), remn >> 3);
    first = (EPI == EPI_OUT || EPI == EPI_F2);
  }
}

DI void attn_item(const Params& p, int item, char* smem) {
  u16* Ks = (u16*)smem;
  u16* Vs = Ks + 2 * 64 * 72;
  constexpr int ABUF = 64 * 72;
  const int tid = tidx(), lane = tid & 63, wave = tid >> 6;
  const int hf = lane >> 5, li = lane & 31;
  const int xcd = item & 7, local = item >> 3;
  const int pair = xcd * 2 + (local >> 5);
  const int within = local & 31;
  const int hq = within >> 3, qb = within & 7;
  const int b = pair >> 1, kvh = pair & 1, h = kvh * 4 + hq;
  const int t0 = b * 4096 + qb * 512 + wave * 64 + li;

  const u16* Q = (const u16*)(p.ws + OFF_Q);
  bf16x8 qf[2][4];
#pragma unroll
  for (int u = 0; u < 2; u++)
#pragma unroll
    for (int s = 0; s < 4; s++) qf[u][s] = *(const bf16x8*)(Q + (size_t)(t0 + 32 * u) * 512 + h * 64 + 16 * s + 8 * hf);

  f32x16 o0[2], o1[2];
  float m_run[2], l_run[2];
#pragma unroll
  for (int u = 0; u < 2; u++) {
#pragma unroll
    for (int r = 0; r < 16; r++) { o0[u][r] = 0.f; o1[u][r] = 0.f; }
    m_run[u] = -1e30f; l_run[u] = 0.f;
  }

  const int lrow = tid >> 3, lc8 = tid & 7;
  const u16* Kg = (const u16*)(p.ws + OFF_K) + (size_t)pair * 4096 * 64 + (size_t)lrow * 64 + lc8 * 8;
  const u16* Vg = (const u16*)(p.ws + OFF_VT) + (size_t)pair * 64 * 4096 + (size_t)lrow * 4096 + lc8 * 8;
  uint4 rk0, rv0;
#define ATT_GLOAD(kt_)                                                   \
  {                                                                      \
    rk0 = *(const uint4*)(Kg + (size_t)((kt_) * 64) * 64);               \
    rv0 = *(const uint4*)(Vg + (kt_) * 64);                              \
  }
  ATT_GLOAD(0);
  const int kap = (li & 0x13) | ((li & 4) << 1) | ((li & 8) >> 1);
  __syncthreads();
  *(uint4*)(Ks + (lrow) * 72 + lc8 * 8) = rk0;
  *(uint4*)(Vs + (lrow) * 72 + lc8 * 8) = rv0;
  ATT_GLOAD(1);
  __syncthreads();

  for (int kt = 0; kt < 64; kt++) {
    const int cur = (kt & 1) * ABUF;
    if (kt + 1 < 64) {
      *(uint4*)(Ks + (ABUF - cur) + (lrow) * 72 + lc8 * 8) = rk0;
      *(uint4*)(Vs + (ABUF - cur) + (lrow) * 72 + lc8 * 8) = rv0;
    }
    if (kt + 2 < 64) ATT_GLOAD(kt + 2);

    f32x16 s0[2], s1[2];
#pragma unroll
    for (int u = 0; u < 2; u++)
#pragma unroll
      for (int r = 0; r < 16; r++) { s0[u][r] = 0.f; s1[u][r] = 0.f; }
#pragma unroll
    for (int s = 0; s < 4; s++) {
      const bf16x8 kf0 = *(const bf16x8*)(Ks + cur + kap * 72 + 16 * s + 8 * hf);
      const bf16x8 kf1 = *(const bf16x8*)(Ks + cur + (32 + kap) * 72 + 16 * s + 8 * hf);
#pragma unroll
      for (int u = 0; u < 2; u++) {
        s0[u] = MFMA(kf0, qf[u][s], s0[u]);
        s1[u] = MFMA(kf1, qf[u][s], s1[u]);
      }
    }
    bf16x8 pb[2][4];
#pragma unroll
    for (int u = 0; u < 2; u++) {
      float mx = s0[u][0];
#pragma unroll
      for (int r = 1; r < 16; r++) mx = fmaxf(mx, s0[u][r]);
#pragma unroll
      for (int r = 0; r < 16; r++) mx = fmaxf(mx, s1[u][r]);
      mx = fmaxf(mx, shfl_x32(mx, hf));
      const float mnew = fmaxf(m_run[u], mx);
      const float alpha = __builtin_amdgcn_exp2f(m_run[u] - mnew);
      m_run[u] = mnew;
      float ps = 0.f;
#pragma unroll
      for (int r = 0; r < 16; r++) { s0[u][r] = __builtin_amdgcn_exp2f(s0[u][r] - mnew); ps += s0[u][r]; }
#pragma unroll
      for (int r = 0; r < 16; r++) { s1[u][r] = __builtin_amdgcn_exp2f(s1[u][r] - mnew); ps += s1[u][r]; }
      l_run[u] = l_run[u] * alpha + ps;
#pragma unroll
      for (int r = 0; r < 16; r++) { o0[u][r] *= alpha; o1[u][r] *= alpha; }
#pragma unroll
      for (int sp = 0; sp < 2; sp++) {
        uint4 ua = make_uint4(pk(s0[u][8 * sp + 0], s0[u][8 * sp + 1]), pk(s0[u][8 * sp + 2], s0[u][8 * sp + 3]),
                              pk(s0[u][8 * sp + 4], s0[u][8 * sp + 5]), pk(s0[u][8 * sp + 6], s0[u][8 * sp + 7]));
        uint4 ub = make_uint4(pk(s1[u][8 * sp + 0], s1[u][8 * sp + 1]), pk(s1[u][8 * sp + 2], s1[u][8 * sp + 3]),
                              pk(s1[u][8 * sp + 4], s1[u][8 * sp + 5]), pk(s1[u][8 * sp + 6], s1[u][8 * sp + 7]));
        pb[u][sp] = __builtin_bit_cast(bf16x8, ua);
        pb[u][2 + sp] = __builtin_bit_cast(bf16x8, ub);
      }
    }
#pragma unroll
    for (int c = 0; c < 4; c++) {
      const bf16x8 vf0 = *(const bf16x8*)(Vs + cur + li * 72 + 16 * c + 8 * hf);
      const bf16x8 vf1 = *(const bf16x8*)(Vs + cur + (32 + li) * 72 + 16 * c + 8 * hf);
#pragma unroll
      for (int u = 0; u < 2; u++) {
        o0[u] = MFMA(vf0, pb[u][c], o0[u]);
        o1[u] = MFMA(vf1, pb[u][c], o1[u]);
      }
    }
    __syncthreads();
  }
  u16* OATT = (u16*)(p.ws + OFF_OATT);
#pragma unroll
  for (int u = 0; u < 2; u++) {
    const int t = t0 + 32 * u;
    const float ltot = l_run[u] + shfl_x32(l_run[u], hf);
    const float inv = 1.f / ltot;
    float ss = 0.f;
#pragma unroll
    for (int q4 = 0; q4 < 4; q4++) {
      float a0 = o0[u][4 * q4 + 0] * inv, a1 = o0[u][4 * q4 + 1] * inv, a2 = o0[u][4 * q4 + 2] * inv, a3 = o0[u][4 * q4 + 3] * inv;
      float c0 = o1[u][4 * q4 + 0] * inv, c1 = o1[u][4 * q4 + 1] * inv, c2 = o1[u][4 * q4 + 2] * inv, c3 = o1[u][4 * q4 + 3] * inv;
      ss += a0 * a0 + a1 * a1 + a2 * a2 + a3 * a3 + c0 * c0 + c1 * c1 + c2 * c2 + c3 * c3;
      st_bf4(OATT + tl_idx(t, h * 64 + 8 * q4 + 4 * hf), a0, a1, a2, a3);
      st_bf4(OATT + tl_idx(t, h * 64 + 32 + 8 * q4 + 4 * hf), c0, c1, c2, c3);
    }
    ss += shfl_x32(ss, hf);
    if (hf == 0) ((float*)(p.ws + OFF_SSA))[(size_t)t * 8 + h] = ss;
  }
}

DI bf16x8 ssm_ufrag(const u16* U2, int bp, int g, int tb, int li, int hf) {
  const int seq = (li >> 2) & 1, step = ((li >> 3) << 2) | (li & 3);
  return *(const bf16x8*)(U2 + (((size_t)((2 * bp + seq) * 32 + g)) * 4096 + tb + step) * 16 + 8 * hf);
}

DI void ssm_scan16(const f32x16& x0, const f32x16& x1, const f32x16& x2, const f32x16& x3, const float4 a0, const float4 a1,
                   float& h0r, float& h0i, float& h1r, float& h1i, const int dir) {
  if (dir == 0) {
#pragma unroll
    for (int r = 0; r < 16; r++) {
      float nr = a0.x * h0r - a0.y * h0i + x0[r], ni = a0.x * h0i + a0.y * h0r + x2[r];
      h0r = nr; h0i = ni;
      float mr = a1.x * h1r - a1.y * h1i + x1[r], mi = a1.x * h1i + a1.y * h1r + x3[r];
      h1r = mr; h1i = mi;
    }
  } else {
#pragma unroll
    for (int r = 15; r >= 0; r--) {
      float nr = a0.x * h0r - a0.y * h0i + x0[r], ni = a0.x * h0i + a0.y * h0r + x2[r];
      h0r = nr; h0i = ni;
      float mr = a1.x * h1r - a1.y * h1i + x1[r], mi = a1.x * h1i + a1.y * h1r + x3[r];
      h1r = mr; h1i = mi;
    }
  }
}

DI void ssm1_item(const Params& p, int l, int item) {
  const int tid = vtid(), lane = tid & 63, wave = __builtin_amdgcn_readfirstlane(tid >> 6);
  const int hf = lane >> 5, li = lane & 31;
  const int w = item * 4 + wave;
  const int ch = w & 15, bp = (w >> 4) & 3, g = (w >> 6) & 31, dir = w >> 11;
  const int idx = (l * 2 + dir) * 32 + g;
  const u16* U2 = (const u16*)(p.ws + OFF_U2);
  const u16* BB = (const u16*)(p.ws + OFF_SSMBB) + (size_t)idx * 128 * 16;
  const float* SA = (const float*)(p.ws + OFF_SSMA) + (size_t)idx * 64 * 4;
  bf16x8 bbf[4];
#pragma unroll
  for (int j = 0; j < 4; j++) bbf[j] = *(const bf16x8*)(BB + (32 * j + li) * 16 + 8 * hf);
  const float4 a0 = *(const float4*)(SA + li * 4);
  const float4 a1 = *(const float4*)(SA + (li + 32) * 4);
  float h0r = 0.f, h0i = 0.f, h1r = 0.f, h1i = 0.f;
  f32x16 zero;
#pragma unroll
  for (int r = 0; r < 16; r++) zero[r] = 0.f;
#define SSM_TB(it_) (ch * 256 + (dir ? (15 - (it_)) : (it_)) * 16)
  bf16x8 q0 = ssm_ufrag(U2, bp, g, SSM_TB(0), li, hf), q1 = ssm_ufrag(U2, bp, g, SSM_TB(1), li, hf);
  bf16x8 q2 = ssm_ufrag(U2, bp, g, SSM_TB(2), li, hf), q3 = ssm_ufrag(U2, bp, g, SSM_TB(3), li, hf);
#pragma unroll 1
  for (int it = 0; it < 16; it++) {
    const bf16x8 uf = q0;
    q0 = q1; q1 = q2; q2 = q3;
    const int itn = (it + 4 < 16) ? (it + 4) : 15;
    q3 = ssm_ufrag(U2, bp, g, SSM_TB(itn), li, hf);
    f32x16 x0 = MFMA(uf, bbf[0], zero), x1 = MFMA(uf, bbf[1], zero), x2 = MFMA(uf, bbf[2], zero), x3 = MFMA(uf, bbf[3], zero);
    ssm_scan16(x0, x1, x2, x3, a0, a1, h0r, h0i, h1r, h1i, dir);
  }
  float* E = (float*)(p.ws + OFF_E) + ((((size_t)(dir * 32 + g) * 8 + (2 * bp + hf)) * 16 + ch) * 64) * 2;
  *(float2*)(E + li * 2) = make_float2(h0r, h0i);
  *(float2*)(E + (li + 32) * 2) = make_float2(h1r, h1i);
}

DI void ssm2_item(const Params& p, int l, int item, char* smem) {
  const int tid = vtid(), lane = tid & 63, wave = __builtin_amdgcn_readfirstlane(tid >> 6);
  const int hf = lane >> 5, li = lane & 31;
  const int w = item * 4 + wave;
  const int ch = w & 15, bp = (w >> 4) & 3, g = w >> 6;
  u16* Hs = (u16*)smem + wave * (32 * 136);
  const u16* U2 = (const u16*)(p.ws + OFF_U2);
  float* YF = (float*)(p.ws + OFF_ACT);
  u16* YG = (u16*)(p.ws + OFF_YG);
  f32x16 zero;
#pragma unroll
  for (int r = 0; r < 16; r++) zero[r] = 0.f;
  const int oseq = li >> 4, ostep = li & 15;
  const int ob = 2 * bp + oseq;

  for (int dir = 0; dir < 2; dir++) {
    const int idx = (l * 2 + dir) * 32 + g;
    const u16* BB = (const u16*)(p.ws + OFF_SSMBB) + (size_t)idx * 128 * 16;
    const u16* CC = (const u16*)(p.ws + OFF_SSMCC) + (size_t)idx * 16 * 128;
    const float* SA = (const float*)(p.ws + OFF_SSMA) + (size_t)idx * 64 * 4;
    bf16x8 bbf[4], ccf[8];
#pragma unroll
    for (int j = 0; j < 4; j++) bbf[j] = *(const bf16x8*)(BB + (32 * j + li) * 16 + 8 * hf);
#pragma unroll
    for (int s = 0; s < 8; s++) {
      bf16x8 v = *(const bf16x8*)(CC + (li & 15) * 128 + 16 * s + 8 * hf);
      if (li >= 16) {
#pragma unroll
        for (int e = 0; e < 8; e++) v[e] = 0;
      }
      ccf[s] = v;
    }
    const float4 a0 = *(const float4*)(SA + li * 4);
    const float4 a1 = *(const float4*)(SA + (li + 32) * 4);
    float h0r = 0.f, h0i = 0.f, h1r = 0.f, h1i = 0.f;
    {
      const float* E = (const float*)(p.ws + OFF_E) + ((((size_t)(dir * 32 + g) * 8 + (2 * bp + hf)) * 16) * 64) * 2;
      const int n = dir ? (15 - ch) : ch;
      for (int i0 = 0; i0 < n; i0 += 4) {
        float2 e0[4], e1[4];
#pragma unroll
        for (int u = 0; u < 4; u++) {
          int ii = i0 + u; if (ii > n - 1) ii = n - 1;
          const int ci = dir ? (15 - ii) : ii;
          e0[u] = *(const float2*)(E + (size_t)ci * 128 + li * 2);
          e1[u] = *(const float2*)(E + (size_t)ci * 128 + (li + 32) * 2);
        }
#pragma unroll
        for (int u = 0; u < 4; u++) {
          if (i0 + u < n) {
            float nr = a0.z * h0r - a0.w * h0i + e0[u].x, ni = a0.z * h0i + a0.w * h0r + e0[u].y;
            h0r = nr; h0i = ni;
            float mr = a1.z * h1r - a1.w * h1i + e1[u].x, mi = a1.z * h1i + a1.w * h1r + e1[u].y;
            h1r = mr; h1i = mi;
          }
        }
      }
    }
    bf16x8 ufn = ssm_ufrag(U2, bp, g, ch * 256 + (dir ? 15 : 0) * 16, li, hf);
    for (int it = 0; it < 16; it++) {
      const int tb = ch * 256 + (dir ? (15 - it) : it) * 16;
      const bf16x8 uf = ufn;
      f32x16 x0 = MFMA(uf, bbf[0], zero), x1 = MFMA(uf, bbf[1], zero), x2 = MFMA(uf, bbf[2], zero), x3 = MFMA(uf, bbf[3], zero);
      if (it + 1 < 16) ufn = ssm_ufrag(U2, bp, g, ch * 256 + (dir ? (14 - it) : (it + 1)) * 16, li, hf);
      const int tt = tb + ostep;
      const size_t yoff = (((size_t)(ob * 32 + g)) * 4096 + tt) * 16;
      float4 f0 = make_float4(0.f, 0.f, 0.f, 0.f), f1 = f0, u0 = f0, u1 = f0;
      if (dir) {
        f0 = *(const float4*)(YF + yoff + 4 * hf);
        f1 = *(const float4*)(YF + yoff + 8 + 4 * hf);
        u0 = ld_bf4(U2 + yoff + 4 * hf);
        u1 = ld_bf4(U2 + yoff + 8 + 4 * hf);
      }
      asm volatile("s_waitcnt lgkmcnt(0)" ::: "memory");
      if (dir == 0) {
#pragma unroll
        for (int r = 0; r < 16; r++) {
          float nr = a0.x * h0r - a0.y * h0i + x0[r], ni = a0.x * h0i + a0.y * h0r + x2[r];
          h0r = nr; h0i = ni;
          float mr = a1.x * h1r - a1.y * h1i + x1[r], mi = a1.x * h1i + a1.y * h1r + x3[r];
          h1r = mr; h1i = mi;
          *(unsigned*)(Hs + (hf * 16 + r) * 136 + 2 * li) = pk(h0r, h0i);
          *(unsigned*)(Hs + (hf * 16 + r) * 136 + 2 * (li + 32)) = pk(h1r, h1i);
        }
      } else {
#pragma unroll
        for (int r = 15; r >= 0; r--) {
          float nr = a0.x * h0r - a0.y * h0i + x0[r], ni = a0.x * h0i + a0.y * h0r + x2[r];
          h0r = nr; h0i = ni;
          float mr = a1.x * h1r - a1.y * h1i + x1[r], mi = a1.x * h1i + a1.y * h1r + x3[r];
          h1r = mr; h1i = mi;
          *(unsigned*)(Hs + (hf * 16 + r) * 136 + 2 * li) = pk(h0r, h0i);
          *(unsigned*)(Hs + (hf * 16 + r) * 136 + 2 * (li + 32)) = pk(h1r, h1i);
        }
      }
      asm volatile("s_waitcnt lgkmcnt(0)" ::: "memory");
      f32x16 y = zero;
#pragma unroll
      for (int s = 0; s < 8; s++) {
        bf16x8 hfv = *(const bf16x8*)(Hs + li * 136 + 16 * s + 8 * hf);
        y = MFMA(ccf[s], hfv, y);
      }
      if (dir == 0) {
        *(float4*)(YF + yoff + 4 * hf) = make_float4(y[0], y[1], y[2], y[3]);
        *(float4*)(YF + yoff + 8 + 4 * hf) = make_float4(y[4], y[5], y[6], y[7]);
      } else {
        float4 d0 = *(const float4*)(p.ssm_d + l * 512 + g * 16 + 4 * hf);
        float4 d1 = *(const float4*)(p.ssm_d + l * 512 + g * 16 + 8 + 4 * hf);
        float v[8];
        v[0] = f0.x + y[0] + d0.x * u0.x; v[1] = f0.y + y[1] + d0.y * u0.y;
        v[2] = f0.z + y[2] + d0.z * u0.z; v[3] = f0.w + y[3] + d0.w * u0.w;
        v[4] = f1.x + y[4] + d1.x * u1.x; v[5] = f1.y + y[5] + d1.y * u1.y;
        v[6] = f1.z + y[6] + d1.z * u1.z; v[7] = f1.w + y[7] + d1.w * u1.w;
#pragma unroll
        for (int e = 0; e < 8; e++) {
          float xx = v[e];
          float z = 0.7978845608028654f * (xx + 0.044715f * xx * xx * xx);
          float th = 1.f - 2.f / (__expf(2.f * z) + 1.f);
          v[e] = 0.5f * xx * (1.f + th);
        }
        u16* yg = YG + tl_idx(ob * 4096 + tt, g * 16);
        st_bf4(yg + 4 * hf, v[0], v[1], v[2], v[3]);
        st_bf4(yg + 8 + 4 * hf, v[4], v[5], v[6], v[7]);
      }
    }
    asm volatile("s_waitcnt lgkmcnt(0)" ::: "memory");
  }
}

DI void qkpost_phase(int l) {
  const Params p = kparams();
  const float* ROPE = (const float*)(p.ws + OFF_ROPE);
  const int nrows = T_TOK * 8 + T_TOK * 2;
  for (int r = blockIdx.x * 512 + tidx(); r < nrows; r += gridDim.x * 512) {
    const bool isq = r < T_TOK * 8;
    const int rk = r - T_TOK * 8;
    u16* row = isq ? ((u16*)(p.ws + OFF_Q) + (size_t)r * 64) : ((u16*)(p.ws + OFF_K) + (size_t)rk * 64);
    const int pos = isq ? ((r >> 3) & 4095) : (rk & 4095);
    const float* gn = isq ? (p.q_norm + l * 64) : (p.k_norm + l * 64);
    const float osc = isq ? QSCALE : 1.f;
    float v[64];
#pragma unroll
    for (int c = 0; c < 8; c++) {
      uint4 raw = ((const uint4*)row)[c];
      v[8 * c + 0] = __uint_as_float(raw.x << 16); v[8 * c + 1] = __uint_as_float(raw.x & 0xffff0000u);
      v[8 * c + 2] = __uint_as_float(raw.y << 16); v[8 * c + 3] = __uint_as_float(raw.y & 0xffff0000u);
      v[8 * c + 4] = __uint_as_float(raw.z << 16); v[8 * c + 5] = __uint_as_float(raw.z & 0xffff0000u);
      v[8 * c + 6] = __uint_as_float(raw.w << 16); v[8 * c + 7] = __uint_as_float(raw.w & 0xffff0000u);
    }
    float ss = 0.f;
#pragma unroll
    for (int e = 0; e < 64; e++) ss += v[e] * v[e];
    const float rn = rsqrtf(ss * (1.f / 64.f) + 1e-6f) * osc;
    const int irow = pos >> 6, icol = pos & 63;
    float tc[32], ts[32];
#pragma unroll
    for (int q = 0; q < 4; q++) {
      const float4 c0 = *(const float4*)(ROPE + irow * 16 + 4 * q), s0 = *(const float4*)(ROPE + 1024 + irow * 16 + 4 * q);
      const float4 c1 = *(const float4*)(ROPE + icol * 16 + 4 * q), s1 = *(const float4*)(ROPE + 1024 + icol * 16 + 4 * q);
      tc[4 * q + 0] = c0.x; tc[4 * q + 1] = c0.y; tc[4 * q + 2] = c0.z; tc[4 * q + 3] = c0.w;
      ts[4 * q + 0] = s0.x; ts[4 * q + 1] = s0.y; ts[4 * q + 2] = s0.z; ts[4 * q + 3] = s0.w;
      tc[16 + 4 * q + 0] = c1.x; tc[16 + 4 * q + 1] = c1.y; tc[16 + 4 * q + 2] = c1.z; tc[16 + 4 * q + 3] = c1.w;
      ts[16 + 4 * q + 0] = s1.x; ts[16 + 4 * q + 1] = s1.y; ts[16 + 4 * q + 2] = s1.z; ts[16 + 4 * q + 3] = s1.w;
    }
#pragma unroll
    for (int c = 0; c < 8; c++) {
      float o[8];
#pragma unroll
      for (int e = 0; e < 4; e++) {
        const int pi = 4 * c + e;
        const float cs = tc[pi], sn = ts[pi];
        const float y0 = v[2 * pi] * rn * gn[2 * pi], y1 = v[2 * pi + 1] * rn * gn[2 * pi + 1];
        o[2 * e] = y0 * cs - y1 * sn;
        o[2 * e + 1] = y0 * sn + y1 * cs;
      }
      uint4 w;
      w.x = pk(o[0], o[1]); w.y = pk(o[2], o[3]); w.z = pk(o[4], o[5]); w.w = pk(o[6], o[7]);
      ((uint4*)row)[c] = w;
    }
  }
}

DI void attn_phase(char* smem) {
  const Params p = kparams();
  for (int lq = blockIdx.x >> 3; lq < 64; lq += (gridDim.x >> 3)) attn_item(p, (blockIdx.x & 7) + 8 * lq, smem);
}
DI void ssm1_phase(int l) {
  const Params p = kparams();
  for (int it = blockIdx.x * 2 + vhalf(); it < 1024; it += gridDim.x * 2) ssm1_item(p, l, it);
}
DI void ssm2_phase(int l, char* smem) {
  const Params p = kparams();
  char* sm = smem + vhalf() * 40960;
  for (int it = blockIdx.x * 2 + vhalf(); it < 512; it += gridDim.x * 2) ssm2_item(p, l, it, sm);
}

DI void final_phase() {
  const Params p = kparams();
  const float* X = (const float*)(p.ws + OFF_X);
  const float* SSX = (const float*)(p.ws + OFF_SSX);
  const int total = T_TOK * 256;
  for (int i = blockIdx.x * 512 + tidx(); i < total; i += gridDim.x * 512) {
    int t = i >> 8, n = (i & 255) * 4;
    float rv = row_rinv16(SSX, t, 1.f / 1024.f);
    float4 x = *(const float4*)(X + (size_t)t * 1024 + n);
    float4 g = *(const float4*)(p.final_norm + n);
    float4 o;
    o.x = x.x * rv * g.x; o.y = x.y * rv * g.y; o.z = x.z * rv * g.z; o.w = x.w * rv * g.w;
    *(float4*)(p.out + (size_t)t * 1024 + n) = o;
  }
}

#define XB_TMO      128
#define XB_XCNT(j)  (256  + 64 * (j))
#define XB_XSUB(j)  (1280 + 64 * (j))
#define XB_XGEN(j)  (2304 + 64 * (j))
#define XB_TOP      3328
#define XB_TOPGEN   3392
#define XCD_BAR_WORDS 3456
#define XB_SPIN_CAP (1u << 18)
#define LAS __attribute__((address_space(3)))

__device__ __forceinline__ unsigned xb_ld(unsigned* p)              { return __hip_atomic_load(p, __ATOMIC_RELAXED, __HIP_MEMORY_SCOPE_AGENT); }
__device__ __forceinline__ unsigned xb_add(unsigned* p, unsigned v) { return __hip_atomic_fetch_add(p, v, __ATOMIC_RELAXED, __HIP_MEMORY_SCOPE_AGENT); }
__device__ __forceinline__ unsigned xb_xcc_id() { return (unsigned)__builtin_amdgcn_s_getreg((3 << 11) | 20) & 0xFu; }
#define XB_SPIN(cond, bar) do { unsigned _sp = 0; while (cond) { __builtin_amdgcn_s_sleep(1); \
    if ((++_sp & 255u) == 0u) { if (xb_ld(&(bar)[XB_TMO])) break; if (_sp > XB_SPIN_CAP) { atomicAdd(&(bar)[XB_TMO], 1u); break; } } } } while (0)

struct XcdBarrier {
    unsigned* bar; unsigned x;
    volatile LAS unsigned* st;
};

__device__ __forceinline__ XcdBarrier xcd_barrier_post(unsigned* bar, volatile LAS unsigned* st) {
    XcdBarrier b; b.bar = bar; b.x = xb_xcc_id(); b.st = st;
    if (threadIdx.x == 0) (void)xb_add(&bar[XB_XCNT(b.x)], 1u);
    return b;
}
__device__ __forceinline__ void xcd_barrier_complete(unsigned* bar, unsigned x, unsigned& nloc, unsigned& nx) {
    const unsigned G = gridDim.x * gridDim.y * gridDim.z;
    unsigned sum, cnt, mine, sp = 0u;
    for (;;) {
        sum = 0u; cnt = 0u; mine = 0u;
#pragma unroll
        for (unsigned j = 0; j < 16; ++j) { const unsigned c = xb_ld(&bar[XB_XCNT(j)]); sum += c; cnt += (c > 0u) ? 1u : 0u; mine = (j == x) ? c : mine; }
        if (sum == G) break;
        __builtin_amdgcn_s_sleep(1);
        if ((++sp & 255u) == 0u) { if (xb_ld(&bar[XB_TMO])) break; if (sp > XB_SPIN_CAP) { atomicAdd(&bar[XB_TMO], 1u); break; } }
    }
    nloc = mine > 0u ? mine : 1u; nx = cnt > 0u ? cnt : 1u;
}

__device__ __forceinline__ void xcd_barrier(const XcdBarrier& b) {
    asm volatile("s_waitcnt vmcnt(0)" ::: "memory");
    __syncthreads();
    if (threadIdx.x == 0) {
        unsigned* bar = b.bar;
        __builtin_amdgcn_s_waitcnt(0);
        unsigned nloc = b.st[0], nx = b.st[1];
        if (nloc == 0u) { xcd_barrier_complete(bar, b.x, nloc, nx); b.st[0] = nloc; b.st[1] = nx; }
        const unsigned old = xb_add(&bar[XB_XSUB(b.x)], 1u);
        const unsigned gen = old / nloc;
        if (old + 1u == (gen + 1u) * nloc) {
            __builtin_amdgcn_fence(__ATOMIC_RELEASE, "agent");
            asm volatile("s_waitcnt vmcnt(0)" ::: "memory");
            const unsigned og = xb_add(&bar[XB_TOP], 1u);
            const unsigned tg = og / nx;
            if (og + 1u == (tg + 1u) * nx) xb_add(&bar[XB_TOPGEN], 1u);
            else XB_SPIN(xb_ld(&bar[XB_TOPGEN]) == tg, bar);
            __builtin_amdgcn_fence(__ATOMIC_ACQUIRE, "agent");
            xb_add(&bar[XB_XGEN(b.x)], 1u);
            asm volatile("s_waitcnt vmcnt(0)" ::: "memory");
        } else {
            XB_SPIN(xb_ld(&bar[XB_XGEN(b.x)]) == gen, bar);
            __builtin_amdgcn_fence(__ATOMIC_ACQUIRE, "agent");
            asm volatile("s_waitcnt vmcnt(0)" ::: "memory");
        }
    }
    __syncthreads();
}
#define GSYNC() do { XcdBarrier xb_; xb_.bar = (unsigned*)(kparams().ws + OFF_BAR); xb_.x = xb_xcc_id(); xb_.st = (volatile LAS unsigned*)xb_words; xcd_barrier(xb_); } while (0)

__global__ void __launch_bounds__(512) mega(Params p_) {
  __shared__ __attribute__((aligned(16))) char smem[147456];
  cg::grid_group grid = cg::this_grid();
  __shared__ __attribute__((aligned(16))) unsigned xb_words[4];
  if (tidx() < 4) xb_words[tidx()] = 0u;
  __syncthreads();
  if (p_.ph_lo < 0) grid.sync();
  (void)xcd_barrier_post((unsigned*)(p_.ws + OFF_BAR), (volatile LAS unsigned*)xb_words);
  int ph = p_.ph_lo;
  const int ph_hi = p_.ph_hi;
  if (ph == 0 && ph < ph_hi) {
    phase0(smem);
    ph++;
    if (ph < ph_hi) GSYNC();
  }
  if (ph == 1 && ph < ph_hi) {
    phase1(smem);
    ph++;
    if (ph < ph_hi) GSYNC();
  }
  for (; ph < ph_hi && ph < NPHASE - 1; ph++) {
    const int l = (ph - 2) / 7, k = (ph - 2) % 7;
    if (k == 0) gemm_phase<EPI_IN>(l, smem);
    else if (k == 1) { qkpost_phase(l); ssm1_phase(l); }
    else if (k == 2) {
      const int first = (blockIdx.x >> 3) & 1;
      for (int s2 = 0; s2 < 2; s2++) {
        __syncthreads();
        if ((s2 ^ first) == 0) attn_phase(smem);
        else ssm2_phase(l, smem);
      }
    }
    else if (k == 3) gemm_phase<EPI_GLU>(l, smem);
    else if (k == 4) gemm_phase<EPI_OUT>(l, smem);
    else if (k == 5) gemm_phase<EPI_F1>(l, smem);
    else gemm_phase<EPI_F2>(l, smem);
    if (ph + 1 < ph_hi) GSYNC();
  }
  if (ph == NPHASE - 1 && ph < ph_hi) final_phase();
}

extern "C" void kernel_launch(void* const* d_in, const int* in_sizes, int n_in, void* d_out, int out_size, void* d_ws,
                              size_t ws_size, hipStream_t stream) {
  static int grid_blocks = 0;
  if (!grid_blocks) {
    int dev = 0, cus = 0;
    (void)hipGetDevice(&dev);
    (void)hipDeviceGetAttribute(&cus, hipDeviceAttributeMultiprocessorCount, dev);
    grid_blocks = cus;
    if (grid_blocks < 8 || (grid_blocks & 7)) grid_blocks = 256;
    if (ws_size < WS_TOTAL) fprintf(stderr, "kernel_launch: workspace too small: %zu < %zu\n", ws_size, (size_t)WS_TOTAL);
  }
  if (ws_size < WS_TOTAL) return;
  Params p{};
  const float** pp = (const float**)&p;
  for (int i = 0; i < 25; i++) pp[i] = (const float*)d_in[i];
  p.out = (float*)d_out;
  p.ws = (char*)d_ws;
  p.ph_lo = 0;
  p.ph_hi = NPHASE;
  (void)hipMemsetAsync((char*)d_ws + OFF_BAR, 0, 16384, stream);
  void* args[] = {&p};
  hipError_t e = hipLaunchCooperativeKernel((void*)mega, dim3(grid_blocks), dim3(512), args, 0, stream);
  if (e != hipSuccess) fprintf(stderr, "cooperative launch failed: %s (grid %d)\n", hipGetErrorString(e), grid_blocks);
}
```

```cpp
#include <hip/hip_runtime.h>
#include <hip/hip_cooperative_groups.h>
#include <cstdio>
namespace cg = cooperative_groups;

typedef __attribute__((ext_vector_type(8))) short bf16x8;
typedef __attribute__((ext_vector_type(16))) float f32x16;
typedef __attribute__((ext_vector_type(2))) __bf16 bf2v;
typedef __attribute__((ext_vector_type(2))) float f2v;
typedef unsigned short u16;

#define DI __device__ __forceinline__
#define MFMA(a, b, c) __builtin_amdgcn_mfma_f32_32x32x16_bf16((a), (b), (c), 0, 0, 0)

constexpr int T_TOK = 32768;
constexpr int NPHASE = 31;
constexpr float QSCALE = 0.125f * 1.4426950408889634f;

constexpr size_t OFF_WT_IN  = 0;
constexpr size_t OFF_WT_GLU = OFF_WT_IN + 10485760;
constexpr size_t OFF_WT_OUT = OFF_WT_GLU + 2097152;
constexpr size_t OFF_WT_F1  = OFF_WT_OUT + 8388608;
constexpr size_t OFF_WT_F2  = OFF_WT_F1 + 46137344;
constexpr size_t OFF_MOD    = OFF_WT_F2 + 23068672;
constexpr size_t OFF_BIAS1  = OFF_MOD + 786432;
constexpr size_t OFF_BIAS2  = OFF_BIAS1 + 163840;
constexpr size_t OFF_ROPE   = OFF_BIAS2 + 720896;
constexpr size_t OFF_SSMA   = OFF_ROPE + 8192;
constexpr size_t OFF_SSMBB  = OFF_SSMA + 262144;
constexpr size_t OFF_SSMCC  = OFF_SSMBB + 1048576;
constexpr size_t OFF_E      = OFF_SSMCC + 1048576;
constexpr size_t OFF_SSX    = OFF_E + 4194304;
constexpr size_t OFF_SSA    = OFF_SSX + 2097152;
constexpr size_t OFF_SSS    = OFF_SSA + 1048576;
constexpr size_t OFF_X      = OFF_SSS + 1048576;
constexpr size_t OFF_ACT    = OFF_X + 134217728;
constexpr size_t OFF_UNION  = OFF_ACT + 67108864;
constexpr size_t OFF_HID    = OFF_UNION;
constexpr size_t OFF_Q      = OFF_UNION;
constexpr size_t OFF_K      = OFF_Q + 33554432;
constexpr size_t OFF_VT     = OFF_K + 8388608;
constexpr size_t OFF_U2     = OFF_VT + 8388608;
constexpr size_t OFF_YG     = OFF_U2 + 33554432;
constexpr size_t OFF_OATT   = OFF_YG + 33554432;
constexpr size_t OFF_OSSM   = OFF_OATT + 33554432;
constexpr size_t OFF_BAR    = OFF_UNION + 184549376;
constexpr size_t WS_TOTAL   = OFF_BAR + 16384;

struct Params {
  const float *x, *c, *w_ada, *b_ada, *norm1, *w_in, *q_norm, *k_norm, *lam_re, *lam_im, *log_dt,
      *b_re, *b_im, *c_re, *c_im, *ssm_d, *w_glu, *b_glu, *attn_out_norm, *ssm_out_norm, *w_out, *norm2,
      *w_ffn_in, *w_ffn_out, *final_norm;
  float* out;
  char* ws;
  int ph_lo, ph_hi;
};

DI unsigned pk(float a, float b) {
  f2v v = {a, b};
  bf2v r = __builtin_convertvector(v, bf2v);
  return __builtin_bit_cast(unsigned, r);
}
DI int tidx() { int t = __builtin_amdgcn_workitem_id_x(); asm volatile("" : "+v"(t)); return t; }
typedef const Params __attribute__((address_space(4)))* KParamPtr;
DI Params kparams() {
#if defined(__HIP_DEVICE_COMPILE__)
  KParamPtr q = (KParamPtr)__builtin_amdgcn_kernarg_segment_ptr();
  asm volatile("" : "+s"(q));
  return *q;
#else
  return Params{};
#endif
}
DI int vtid() { return tidx() & 255; }
DI int vhalf() { return tidx() >> 8; }
DI float bf2f(unsigned short h) { return __uint_as_float(((unsigned)h) << 16); }
DI void st_bf4(u16* dst, float a, float b, float c, float d) {
  uint2 v; v.x = pk(a, b); v.y = pk(c, d);
  *(uint2*)dst = v;
}
DI float4 ld_bf4(const u16* src) {
  uint2 v = *(const uint2*)src;
  float4 r;
  r.x = __uint_as_float(v.x << 16); r.y = __uint_as_float(v.x & 0xffff0000u);
  r.z = __uint_as_float(v.y << 16); r.w = __uint_as_float(v.y & 0xffff0000u);
  return r;
}
DI float shfl_x32(float v, int hi) {
  auto r = __builtin_amdgcn_permlane32_swap(__float_as_uint(v), __float_as_uint(v), false, false);
  return __uint_as_float(hi ? r[0] : r[1]);
}
DI float row16_sum(float v) {
  v += __int_as_float(__builtin_amdgcn_update_dpp(0, __float_as_int(v), 0x121, 0xf, 0xf, false));
  v += __int_as_float(__builtin_amdgcn_update_dpp(0, __float_as_int(v), 0x122, 0xf, 0xf, false));
  v += __int_as_float(__builtin_amdgcn_update_dpp(0, __float_as_int(v), 0x124, 0xf, 0xf, false));
  v += __int_as_float(__builtin_amdgcn_update_dpp(0, __float_as_int(v), 0x128, 0xf, 0xf, false));
  return v;
}
DI float wave_sum(float v) {
  v = row16_sum(v);
  v += __int_as_float(__builtin_amdgcn_ds_swizzle(__float_as_int(v), 0x401F));
  const int hi = (tidx() >> 5) & 1;
  return v + shfl_x32(v, hi);
}
DI size_t tl_idx(int t, int n) { return ((size_t)(n >> 6) * T_TOK + t) * 64 + (n & 63); }
DI int crow(int r, int hf) { return (r & 3) + 8 * (r >> 2) + 4 * hf; }
DI int f1perm(int n) {
  int j = (n < 2816) ? n : n - 2816;
  return (j >> 5) * 64 + (j & 31) + ((n < 2816) ? 0 : 32);
}

DI void transpose_tile(const float* __restrict__ src, int N, u16* __restrict__ dst, int K, int k0, int n0,
                       int permmode, const float* __restrict__ kscale, float* tl) {
  const int tid = vtid();
  __syncthreads();
#pragma unroll 4
  for (int i = 0; i < 16; i++) {
    int r = (tid >> 6) + 4 * i;
    float v = src[(size_t)(k0 + r) * N + n0 + (tid & 63)];
    if (kscale) v *= kscale[k0 + r];
    tl[r * 65 + (tid & 63)] = v;
  }
  __syncthreads();
#pragma unroll 4
  for (int i = 0; i < 8; i++) {
    int n = (tid >> 5) + 8 * i;
    int kp = tid & 31;
    float a = tl[(2 * kp) * 65 + n], b = tl[(2 * kp + 1) * 65 + n];
    int nn = n0 + n;
    int no = permmode ? f1perm(nn) : nn;
    *(unsigned*)(dst + ((size_t)(k0 >> 6) * N + no) * 64 + 2 * kp) = pk(a, b);
  }
}

DI void gemv8_item(const float* vec, int vstride, bool do_silu, const float* __restrict__ W, int N, int j0,
                   const float* bias, float* out, int ostride, int permmode, float* sm) {
  const int tid = vtid();
  float* vs = sm;
  float* red = sm + 8192;
  __syncthreads();
  for (int i = tid; i < 8192; i += 256) {
    int b = i >> 10, k = i & 1023;
    float v = vec[(size_t)b * vstride + k];
    if (do_silu) v = v / (1.f + expf(-v));
    vs[i] = v;
  }
  __syncthreads();
  const int kq = tid >> 6, jj = tid & 63;
  float acc[8];
#pragma unroll
  for (int b = 0; b < 8; b++) acc[b] = 0.f;
#pragma unroll 4
  for (int k = kq * 256; k < kq * 256 + 256; k++) {
    float w = W[(size_t)k * N + j0 + jj];
#pragma unroll
    for (int b = 0; b < 8; b++) acc[b] += vs[b * 1024 + k] * w;
  }
#pragma unroll
  for (int b = 0; b < 8; b++) red[(kq * 8 + b) * 64 + jj] = acc[b];
  __syncthreads();
  for (int o = tid; o < 512; o += 256) {
    int b = o >> 6, j = o & 63;
    float s = red[(0 * 8 + b) * 64 + j] + red[(8 + b) * 64 + j] + red[(16 + b) * 64 + j] + red[(24 + b) * 64 + j];
    int jg = j0 + j;
    if (bias) s += bias[jg];
    int jo = permmode ? f1perm(jg) : jg;
    out[(size_t)b * ostride + jo] = s;
  }
}

DI void ssm_param_item(const Params& p, int idx) {
  const int tid = vtid();
  const int pp = tid & 63, cq = tid >> 6;
  float* SSMA = (float*)(p.ws + OFF_SSMA);
  u16* BB = (u16*)(p.ws + OFF_SSMBB);
  u16* CC = (u16*)(p.ws + OFF_SSMCC);
  double lr = (double)p.lam_re[idx * 64 + pp];
  if (lr > -1e-4) lr = (double)(-1e-4f);
  double li = (double)p.lam_im[idx * 64 + pp];
  double dt = exp((double)p.log_dt[idx]);
  double mag = exp(lr * dt);
  double ar = mag * cos(li * dt), ai = mag * sin(li * dt);
  double den = lr * lr + li * li;
  double nre = ar - 1.0;
  double kre = (nre * lr + ai * li) / den;
  double kim = (ai * lr - nre * li) / den;
  if (cq == 0) {
    double magL = exp(lr * dt * 256.0);
    float4 v;
    v.x = (float)ar; v.y = (float)ai;
    v.z = (float)(magL * cos(li * dt * 256.0)); v.w = (float)(magL * sin(li * dt * 256.0));
    *(float4*)(SSMA + (size_t)(idx * 64 + pp) * 4) = v;
  }
#pragma unroll
  for (int cc = 0; cc < 4; cc++) {
    int c = cq * 4 + cc;
    double br = (double)p.b_re[(size_t)(idx * 64 + pp) * 16 + c];
    double bi = (double)p.b_im[(size_t)(idx * 64 + pp) * 16 + c];
    float bbr = (float)(kre * br - kim * bi);
    float bbi = (float)(kre * bi + kim * br);
    BB[(size_t)(idx * 128 + pp) * 16 + c] = (u16)(pk(bbr, 0.f) & 0xffffu);
    BB[(size_t)(idx * 128 + 64 + pp) * 16 + c] = (u16)(pk(bbi, 0.f) & 0xffffu);
    float cr = p.c_re[(size_t)(idx * 16 + c) * 64 + pp];
    float ci = p.c_im[(size_t)(idx * 16 + c) * 64 + pp];
    *(unsigned*)(CC + (size_t)(idx * 16 + c) * 128 + 2 * pp) = pk(cr, -ci);
  }
}

DI void phase0(char* smem) {
  const Params p = kparams();
  float* sm = (float*)(smem + vhalf() * 40960);
  constexpr int N_TIN = 4 * 16 * 20, N_TGLU = 4 * 8 * 8, N_TOUT = 4 * 16 * 16, N_TF1 = 4 * 16 * 88, N_TF2 = 4 * 44 * 16;
  constexpr int N_MOD = 4 * 96, N_SSM = 256, N_ROPE = 1;
  constexpr int S0 = N_MOD, S1 = S0 + N_TIN, S2 = S1 + N_TGLU, S3 = S2 + N_TOUT, S4 = S3 + N_TF1, S5 = S4 + N_TF2,
                S6 = S5 + N_SSM, S7 = S6 + N_ROPE;
  for (int it = blockIdx.x * 2 + vhalf(); it < S7 + 1; it += gridDim.x * 2) {
    if (it < S0) {
      int l = it / 96, jb = it % 96;
      gemv8_item(p.c, 1024, true, p.w_ada + (size_t)l * 1024 * 6144, 6144, jb * 64, p.b_ada + l * 6144,
                 (float*)(p.ws + OFF_MOD) + (size_t)l * 8 * 6144, 6144, 0, sm);
    } else if (it < S1) {
      int r = it - S0; int l = r / 320; r %= 320; int kt = r / 20, ntile = r % 20;
      transpose_tile(p.w_in + (size_t)l * 1024 * 1280, 1280, (u16*)(p.ws + OFF_WT_IN) + (size_t)l * 1280 * 1024, 1024,
                     kt * 64, ntile * 64, 0, nullptr, sm);
    } else if (it < S2) {
      int r = it - S1; int l = r / 64; r %= 64; int kt = r / 8, ntile = r % 8;
      transpose_tile(p.w_glu + (size_t)l * 512 * 512, 512, (u16*)(p.ws + OFF_WT_GLU) + (size_t)l * 512 * 512, 512,
                     kt * 64, ntile * 64, 0, nullptr, sm);
    } else if (it < S3) {
      int r = it - S2; int l = r / 256; r %= 256; int kt = r / 16, ntile = r % 16;
      const float* ks = (kt < 8) ? (p.attn_out_norm + l * 512) : (p.ssm_out_norm + l * 512 - 512);
      transpose_tile(p.w_out + (size_t)l * 1024 * 1024, 1024, (u16*)(p.ws + OFF_WT_OUT) + (size_t)l * 1024 * 1024, 1024,
                     kt * 64, ntile * 64, 0, ks, sm);
    } else if (it < S4) {
      int r = it - S3; int l = r / 1408; r %= 1408; int kt = r / 88, ntile = r % 88;
      transpose_tile(p.w_ffn_in + (size_t)l * 1024 * 5632, 5632, (u16*)(p.ws + OFF_WT_F1) + (size_t)l * 5632 * 1024, 1024,
                     kt * 64, ntile * 64, 1, nullptr, sm);
    } else if (it < S5) {
      int r = it - S4; int l = r / 704; r %= 704; int kt = r / 16, ntile = r % 16;
      transpose_tile(p.w_ffn_out + (size_t)l * 2816 * 1024, 1024, (u16*)(p.ws + OFF_WT_F2) + (size_t)l * 1024 * 2816, 2816,
                     kt * 64, ntile * 64, 0, nullptr, sm);
    } else if (it < S6) {
      ssm_param_item(p, it - S5);
    } else {
      float* rope = (float*)(p.ws + OFF_ROPE);
      for (int i = vtid(); i < 1024; i += 256) {
        int idx = i >> 4, f = i & 15;
        double ang = (double)idx * pow(10000.0, -(double)f / 16.0);
        rope[i] = (float)cos(ang);
        rope[1024 + i] = (float)sin(ang);
      }
    }
  }
}

DI void phase1(char* smem) {
  const Params p = kparams();
  float* sm = (float*)(smem + vhalf() * 40960);
  const float* MOD = (const float*)(p.ws + OFF_MOD);
  constexpr int N_B1 = 4 * 20, N_B2 = 4 * 88, N_PREP = T_TOK / 4;
  for (int it = blockIdx.x * 2 + vhalf(); it < N_B1 + N_B2 + N_PREP; it += gridDim.x * 2) {
    if (it < N_B1) {
      int l = it / 20, jb = it % 20;
      gemv8_item(MOD + (size_t)l * 8 * 6144 + 0, 6144, false, p.w_in + (size_t)l * 1024 * 1280, 1280, jb * 64, nullptr,
                 (float*)(p.ws + OFF_BIAS1) + (size_t)l * 8 * 1280, 1280, 0, sm);
    } else if (it < N_B1 + N_B2) {
      int r = it - N_B1; int l = r / 88, jb = r % 88;
      gemv8_item(MOD + (size_t)l * 8 * 6144 + 3072, 6144, false, p.w_ffn_in + (size_t)l * 1024 * 5632, 5632, jb * 64, nullptr,
                 (float*)(p.ws + OFF_BIAS2) + (size_t)l * 8 * 5632, 5632, 1, sm);
    } else {
      int r = it - N_B1 - N_B2;
      const int lane = vtid() & 63, wave = vtid() >> 6;
      int t = r * 4 + wave;
      int b = t >> 12;
      const float4* xr = (const float4*)(p.x + (size_t)t * 1024);
      float4 v[4];
      float ss = 0.f;
#pragma unroll
      for (int i = 0; i < 4; i++) {
        v[i] = xr[lane + 64 * i];
        ss += v[i].x * v[i].x + v[i].y * v[i].y + v[i].z * v[i].z + v[i].w * v[i].w;
      }
      ss = wave_sum(ss);
      float* SSX = (float*)(p.ws + OFF_SSX);
      if (lane < 16) SSX[(size_t)t * 16 + lane] = (lane == 0) ? ss : 0.f;
      u16* ACT = (u16*)(p.ws + OFF_ACT);
      const float* sc1 = MOD + (size_t)(0 * 8 + b) * 6144 + 1024;
#pragma unroll
      for (int i = 0; i < 4; i++) {
        int k = (lane + 64 * i) * 4;
        float4 g = *(const float4*)(p.norm1 + k);
        float4 s = *(const float4*)(sc1 + k);
        st_bf4(ACT + tl_idx(t, k), v[i].x * g.x * (1.f + s.x), v[i].y * g.y * (1.f + s.y),
               v[i].z * g.z * (1.f + s.z), v[i].w * g.w * (1.f + s.w));
      }
    }
  }
}

enum { EPI_IN = 0, EPI_GLU = 1, EPI_OUT = 2, EPI_F1 = 3, EPI_F2 = 4 };

DI float row_rinv16(const float* ssx, int t, float invn) {
  const float4* q = (const float4*)(ssx + (size_t)t * 16);
  float4 a = q[0], b = q[1], c = q[2], d = q[3];
  float s = ((a.x + a.y) + (a.z + a.w)) + ((b.x + b.y) + (b.z + b.w)) + ((c.x + c.y) + (c.z + c.w)) + ((d.x + d.y) + (d.z + d.w));
  return rsqrtf(s * invn + 1e-6f);
}
DI float row_rinv8(const float* ss8, int t, float invn) {
  const float4* q = (const float4*)(ss8 + (size_t)t * 8);
  float4 a = q[0], b = q[1];
  float s = ((a.x + a.y) + (a.z + a.w)) + ((b.x + b.y) + (b.z + b.w));
  return rsqrtf(s * invn + 1e-6f);
}

template <int EPI>
DI void gemm_tile(const Params& p, const int l, const int mt, const int nt, char* smem, uint4& ra0, uint4& ra1, uint4& ra2, uint4& ra3,
               uint4& rb0, uint4& rb1, uint4& rb2, uint4& rb3, const bool first, const bool has_next, const int mt_next, const int nt_next) {
  constexpr int TJ = 4;
  constexpr int K = (EPI == EPI_GLU) ? 512 : (EPI == EPI_F2 ? 2816 : 1024);
  constexpr int KT = K / 64;
  u16* As = (u16*)smem;
  u16* Bs = As + 256 * 72;
  const int tid = tidx(), lane = tid & 63, wave = tid >> 6;
  const int wm = wave >> 2, wn = wave & 3;
  const int hf = lane >> 5, li = lane & 31;
  const int m0 = mt * 256, n0 = nt * 256;

  const u16* A0;
  const u16* A1 = nullptr;
  const u16* W;
  if (EPI == EPI_IN) { A0 = (const u16*)(p.ws + OFF_ACT); W = (const u16*)(p.ws + OFF_WT_IN) + (size_t)l * 1280 * 1024; }
  else if (EPI == EPI_GLU) { A0 = (const u16*)(p.ws + OFF_YG); W = (const u16*)(p.ws + OFF_WT_GLU) + (size_t)l * 512 * 512; }
  else if (EPI == EPI_OUT) { A0 = (const u16*)(p.ws + OFF_OATT); A1 = (const u16*)(p.ws + OFF_OSSM); W = (const u16*)(p.ws + OFF_WT_OUT) + (size_t)l * 1024 * 1024; }
  else if (EPI == EPI_F1) { A0 = (const u16*)(p.ws + OFF_ACT); W = (const u16*)(p.ws + OFF_WT_F1) + (size_t)l * 5632 * 1024; }
  else { A0 = (const u16*)(p.ws + OFF_HID); W = (const u16*)(p.ws + OFF_WT_F2) + (size_t)l * 1024 * 2816; }

  const int lrow = tid >> 3, lc8 = tid & 7;
  constexpr int NW = (EPI == EPI_IN) ? 1280 : (EPI == EPI_GLU ? 512 : (EPI == EPI_F1 ? 5632 : 1024));
  constexpr size_t AKT = (size_t)T_TOK * 64, WKT = (size_t)NW * 64;
  const u16* ag0 = A0 + (size_t)(m0 + lrow) * 64 + lc8 * 8;
  const u16* ag1 = (EPI == EPI_OUT) ? (A1 + (size_t)(m0 + lrow) * 64 + lc8 * 8) : nullptr;
  const u16* wg = W + (size_t)(n0 + lrow) * 64 + lc8 * 8;

  f32x16 acc[2][TJ];
#pragma unroll
  for (int i = 0; i < 2; i++)
#pragma unroll
    for (int j = 0; j < TJ; j++)
#pragma unroll
      for (int r = 0; r < 16; r++) acc[i][j][r] = 0.f;

#define GEMM_GLOAD_R(kt_, A0_, A1_, A2_, A3_, B0_, B1_, B2_, B3_)                                 \
  {                                                                                              \
    const u16* ap;                                                                               \
    if (EPI == EPI_OUT) ap = ((kt_) < 8) ? (ag0 + (kt_) * AKT) : (ag1 + (long)((kt_) - 8) * (long)AKT);      \
    else ap = ag0 + (kt_) * AKT;                                                                 \
    const u16* wp = wg + (kt_) * WKT;                                                            \
    A0_ = *(const uint4*)(ap);                                                                   \
    A1_ = *(const uint4*)(ap + 64 * 64);                                                         \
    A2_ = *(const uint4*)(ap + 128 * 64);                                                        \
    A3_ = *(const uint4*)(ap + 192 * 64);                                                        \
    B0_ = *(const uint4*)(wp);                                                                   \
    B1_ = *(const uint4*)(wp + 64 * 64);                                                         \
    B2_ = *(const uint4*)(wp + 128 * 64);                                                        \
    B3_ = *(const uint4*)(wp + 192 * 64);                                                        \
  }
#define GEMM_LSTORE_R(boff_, A0_, A1_, A2_, A3_, B0_, B1_, B2_, B3_) \
  {                                                                \
    u16* a_ = As + (boff_) + lrow * 72 + lc8 * 8;                  \
    u16* b_ = Bs + (boff_) + lrow * 72 + lc8 * 8;                  \
    *(uint4*)(a_) = A0_;                                           \
    *(uint4*)(a_ + 64 * 72) = A1_;                                 \
    *(uint4*)(a_ + 128 * 72) = A2_;                                \
    *(uint4*)(a_ + 192 * 72) = A3_;                                \
    *(uint4*)(b_) = B0_;                                           \
    *(uint4*)(b_ + 64 * 72) = B1_;                                 \
    *(uint4*)(b_ + 128 * 72) = B2_;                                \
    *(uint4*)(b_ + 192 * 72) = B3_;                                \
  }
#define GEMM_COMPUTE(cur_, DOST_, oth_, A0_, A1_, A2_, A3_, B0_, B1_, B2_, B3_)                                          \
  {                                                                                                                     \
    u16* a_ = As + (oth_) + lrow * 72 + lc8 * 8;                                                                        \
    u16* b_ = Bs + (oth_) + lrow * 72 + lc8 * 8;                                                                        \
    _Pragma("unroll") for (int s = 0; s < 4; s++) {                                                                     \
      bf16x8 wf[2], af[TJ];                                                                                             \
      _Pragma("unroll") for (int i = 0; i < 2; i++)                                                                     \
        wf[i] = *(const bf16x8*)(Bs + (cur_) + (wn * 64 + i * 32 + li) * 72 + s * 16 + hf * 8);                         \
      _Pragma("unroll") for (int j = 0; j < TJ; j++)                                                                    \
        af[j] = *(const bf16x8*)(As + (cur_) + (wm * 128 + j * 32 + li) * 72 + s * 16 + hf * 8);                        \
      _Pragma("unroll") for (int i = 0; i < 2; i++)                                                                     \
        _Pragma("unroll") for (int j = 0; j < TJ; j++) acc[i][j] = MFMA(wf[i], af[j], acc[i][j]);                       \
        \
      if (DOST_) {                                                                                                      \
        if (s == 0) { *(uint4*)(a_) = A0_; *(uint4*)(a_ + 64 * 72) = A1_; }                                             \
        if (s == 1) { *(uint4*)(a_ + 128 * 72) = A2_; *(uint4*)(a_ + 192 * 72) = A3_; }                                 \
        if (s == 2) { *(uint4*)(b_) = B0_; *(uint4*)(b_ + 64 * 72) = B1_; }                                             \
        if (s == 3) { *(uint4*)(b_ + 128 * 72) = B2_; *(uint4*)(b_ + 192 * 72) = B3_; }                                 \
      }                                                                                                                 \
    }                                                                                                                   \
  }
  constexpr int BUF = 2 * 256 * 72;
  uint4 sa0, sa1, sa2, sa3, sb0, sb1, sb2, sb3;
  if (first) GEMM_GLOAD_R(0, ra0, ra1, ra2, ra3, rb0, rb1, rb2, rb3);
  GEMM_GLOAD_R(1, sa0, sa1, sa2, sa3, sb0, sb1, sb2, sb3);
  int tok[TJ];
#pragma unroll
  for (int j = 0; j < TJ; j++) tok[j] = m0 + wm * 128 + j * 32 + li;

  __syncthreads();
  GEMM_LSTORE_R(0, ra0, ra1, ra2, ra3, rb0, rb1, rb2, rb3);
  GEMM_GLOAD_R(2, ra0, ra1, ra2, ra3, rb0, rb1, rb2, rb3);
  __syncthreads();
#pragma unroll 1
  for (int kt = 0; kt < KT; kt += 2) {
    if (EPI == EPI_OUT) {
      if (kt == 8) {
#pragma unroll
        for (int j = 0; j < TJ; j++) {
          const float ra_ = row_rinv8((const float*)(p.ws + OFF_SSA), tok[j], 1.f / 512.f);
          const float rs_ = row_rinv8((const float*)(p.ws + OFF_SSS), tok[j], 1.f / 512.f);
          const float mr = ra_ / rs_;
#pragma unroll
          for (int i = 0; i < 2; i++)
#pragma unroll
            for (int r = 0; r < 16; r++) acc[i][j][r] *= mr;
        }
      }
    }
    GEMM_COMPUTE(0, true, BUF, sa0, sa1, sa2, sa3, sb0, sb1, sb2, sb3);
    if (kt + 3 < KT) GEMM_GLOAD_R(kt + 3, sa0, sa1, sa2, sa3, sb0, sb1, sb2, sb3);
    __syncthreads();
    GEMM_COMPUTE(BUF, (kt + 2 < KT), 0, ra0, ra1, ra2, ra3, rb0, rb1, rb2, rb3);
    if (kt + 4 < KT) GEMM_GLOAD_R(kt + 4, ra0, ra1, ra2, ra3, rb0, rb1, rb2, rb3);
    __syncthreads();
  }
  float rinv_all[TJ];
#pragma unroll
  for (int j = 0; j < TJ; j++) rinv_all[j] = (EPI == EPI_IN || EPI == EPI_F1) ? row_rinv16((const float*)(p.ws + OFF_SSX), tok[j], 1.f / 1024.f) : 1.f;
  if (has_next && EPI != EPI_OUT && EPI != EPI_F2) {
    const u16* ap = A0 + (size_t)(mt_next * 256 + lrow) * 64 + lc8 * 8;
    const u16* wp = W + (size_t)(nt_next * 256 + lrow) * 64 + lc8 * 8;
    ra0 = *(const uint4*)(ap);
    ra1 = *(const uint4*)(ap + 64 * 64);
    ra2 = *(const uint4*)(ap + 128 * 64);
    ra3 = *(const uint4*)(ap + 192 * 64);
    rb0 = *(const uint4*)(wp);
    rb1 = *(const uint4*)(wp + 64 * 64);
    rb2 = *(const uint4*)(wp + 128 * 64);
    rb3 = *(const uint4*)(wp + 192 * 64);
  }

  const int b = m0 >> 12;
  const int nbase = n0 + wn * 64;
  const float* MOD = (const float*)(p.ws + OFF_MOD);

  if (EPI == EPI_IN) {
    const float* bias = (const float*)(p.ws + OFF_BIAS1) + (size_t)(l * 8 + b) * 1280;
    const float* SSX = (const float*)(p.ws + OFF_SSX);
    float rinv[TJ];
#pragma unroll
    for (int j = 0; j < TJ; j++) rinv[j] = rinv_all[j];
#pragma unroll
    for (int i = 0; i < 2; i++)
#pragma unroll
      for (int q4 = 0; q4 < 4; q4++) {
        float4 b4 = *(const float4*)(bias + nbase + i * 32 + 8 * q4 + 4 * hf);
#pragma unroll
        for (int j = 0; j < TJ; j++) {
          acc[i][j][4 * q4 + 0] = acc[i][j][4 * q4 + 0] * rinv[j] + b4.x;
          acc[i][j][4 * q4 + 1] = acc[i][j][4 * q4 + 1] * rinv[j] + b4.y;
          acc[i][j][4 * q4 + 2] = acc[i][j][4 * q4 + 2] * rinv[j] + b4.z;
          acc[i][j][4 * q4 + 3] = acc[i][j][4 * q4 + 3] * rinv[j] + b4.w;
        }
      }
    if (nbase < 640) {
#pragma unroll
      for (int j = 0; j < TJ; j++) {
        const int t = tok[j], pos = t & 4095;
#pragma unroll
        for (int i = 0; i < 2; i++)
#pragma unroll
          for (int q4 = 0; q4 < 4; q4++) {
            const int d0 = i * 32 + 8 * q4 + 4 * hf;
            u16* dst = (nbase < 512) ? ((u16*)(p.ws + OFF_Q) + (size_t)t * 512 + nbase + d0)
                                     : ((u16*)(p.ws + OFF_K) + ((size_t)(b * 2 + ((nbase - 512) >> 6)) * 4096 + pos) * 64 + d0);
            st_bf4(dst, acc[i][j][4 * q4 + 0], acc[i][j][4 * q4 + 1], acc[i][j][4 * q4 + 2], acc[i][j][4 * q4 + 3]);
          }
      }
    } else if (nbase < 768) {
      u16* VT = (u16*)(p.ws + OFF_VT);
      const int vh = (nbase - 640) >> 6;
#pragma unroll
      for (int j = 0; j < TJ; j++) {
        const int pos = tok[j] & 4095;
#pragma unroll
        for (int i = 0; i < 2; i++)
#pragma unroll
          for (int r = 0; r < 16; r++) {
            int d = i * 32 + crow(r, hf);
            VT[((size_t)(b * 2 + vh) * 64 + d) * 4096 + pos] = (u16)(pk(acc[i][j][r], 0.f) & 0xffffu);
          }
      }
    } else {
      u16* U2 = (u16*)(p.ws + OFF_U2);
      const int ch0 = nbase - 768;
#pragma unroll
      for (int j = 0; j < TJ; j++) {
        const int pos = tok[j] & 4095;
#pragma unroll
        for (int i = 0; i < 2; i++)
#pragma unroll
          for (int q4 = 0; q4 < 4; q4++) {
            int ch = ch0 + i * 32 + 8 * q4 + 4 * hf;
            int g = ch >> 4, c0 = ch & 15;
            st_bf4(U2 + (((size_t)(b * 32 + g)) * 4096 + pos) * 16 + c0, acc[i][j][4 * q4 + 0], acc[i][j][4 * q4 + 1],
                   acc[i][j][4 * q4 + 2], acc[i][j][4 * q4 + 3]);
          }
      }
    }
  } else if (EPI == EPI_GLU) {
    const float* bg = p.b_glu + l * 512;
    const u16* YG = (const u16*)(p.ws + OFF_YG);
    u16* OSSM = (u16*)(p.ws + OFF_OSSM);
    float* SSS = (float*)(p.ws + OFF_SSS);
#pragma unroll
    for (int j = 0; j < TJ; j++) {
      const int t = tok[j];
      float ss = 0.f;
#pragma unroll
      for (int i = 0; i < 2; i++)
#pragma unroll
        for (int q4 = 0; q4 < 4; q4++) {
          const int n = nbase + i * 32 + 8 * q4 + 4 * hf;
          float4 b4 = *(const float4*)(bg + n);
          float4 y = ld_bf4(YG + tl_idx(t, n));
          float o0 = y.x / (1.f + __expf(-(acc[i][j][4 * q4 + 0] + b4.x)));
          float o1 = y.y / (1.f + __expf(-(acc[i][j][4 * q4 + 1] + b4.y)));
          float o2 = y.z / (1.f + __expf(-(acc[i][j][4 * q4 + 2] + b4.z)));
          float o3 = y.w / (1.f + __expf(-(acc[i][j][4 * q4 + 3] + b4.w)));
          ss += o0 * o0 + o1 * o1 + o2 * o2 + o3 * o3;
          st_bf4(OSSM + tl_idx(t, n), o0, o1, o2, o3);
        }
      ss += shfl_x32(ss, hf);
      if (hf == 0) SSS[(size_t)t * 8 + (nbase >> 6)] = ss;
    }
  } else if (EPI == EPI_OUT || EPI == EPI_F2) {
    const float* gate = MOD + (size_t)(l * 8 + b) * 6144 + (EPI == EPI_OUT ? 2048 : 5120);
    const bool has_next = (EPI == EPI_OUT) || (l < 3);
    const float* nrm = (EPI == EPI_OUT) ? (p.norm2 + l * 1024) : (p.norm1 + (l + 1) * 1024);
    const float* scn = (EPI == EPI_OUT) ? (MOD + (size_t)(l * 8 + b) * 6144 + 4096) : (MOD + (size_t)((l + 1) * 8 + b) * 6144 + 1024);
    const float* xin = (EPI == EPI_OUT && l == 0) ? p.x : (const float*)(p.ws + OFF_X);
    float* X = (float*)(p.ws + OFF_X);
    u16* ACT = (u16*)(p.ws + OFF_ACT);
    float* SSX = (float*)(p.ws + OFF_SSX);
    float* stg = (float*)smem + wave * (32 * 68);
    const int rr = lane >> 4, c4 = (lane & 15) * 4;
    const int n = nbase + c4;
    const float4 g4 = *(const float4*)(gate + n);
    float4 nsc = make_float4(0.f, 0.f, 0.f, 0.f);
    if (has_next) {
      const float4 nr = *(const float4*)(nrm + n);
      const float4 sc = *(const float4*)(scn + n);
      nsc = make_float4(nr.x * (1.f + sc.x), nr.y * (1.f + sc.y), nr.z * (1.f + sc.z), nr.w * (1.f + sc.w));
    }
    float4 xi[8], xn[8];
    float fj[TJ];
#pragma unroll
    for (int j = 0; j < TJ; j++) fj[j] = (EPI == EPI_OUT) ? row_rinv8((const float*)(p.ws + OFF_SSS), tok[j], 1.f / 512.f) : 1.f;
#pragma unroll
    for (int it = 0; it < 8; it++) xi[it] = *(const float4*)(xin + (size_t)(m0 + wm * 128 + rr + 4 * it) * 1024 + n);
#pragma unroll
    for (int j = 0; j < TJ; j++) {
#pragma unroll
      for (int i = 0; i < 2; i++)
#pragma unroll
        for (int q4 = 0; q4 < 4; q4++)
          *(float4*)(stg + li * 68 + i * 32 + 8 * q4 + 4 * hf) =
              make_float4(acc[i][j][4 * q4 + 0] * fj[j], acc[i][j][4 * q4 + 1] * fj[j], acc[i][j][4 * q4 + 2] * fj[j], acc[i][j][4 * q4 + 3] * fj[j]);
      asm volatile("s_waitcnt lgkmcnt(0)" ::: "memory");
      if (j + 1 < TJ) {
#pragma unroll
        for (int it = 0; it < 8; it++) xn[it] = *(const float4*)(xin + (size_t)(m0 + wm * 128 + (j + 1) * 32 + rr + 4 * it) * 1024 + n);
      }
#pragma unroll
      for (int it = 0; it < 8; it++) {
        const int row = rr + 4 * it;
        const int t = m0 + wm * 128 + j * 32 + row;
        const float4 a = *(const float4*)(stg + row * 68 + c4);
        float4 y;
        y.x = xi[it].x + g4.x * a.x;
        y.y = xi[it].y + g4.y * a.y;
        y.z = xi[it].z + g4.z * a.z;
        y.w = xi[it].w + g4.w * a.w;
        *(float4*)(X + (size_t)t * 1024 + n) = y;
        float ss = y.x * y.x + y.y * y.y + y.z * y.z + y.w * y.w;
        ss = row16_sum(ss);
        if ((lane & 15) == 0) SSX[(size_t)t * 16 + (nbase >> 6)] = ss;
        if (has_next) st_bf4(ACT + tl_idx(t, n), y.x * nsc.x, y.y * nsc.y, y.z * nsc.z, y.w * nsc.w);
      }
      asm volatile("s_waitcnt lgkmcnt(0)" ::: "memory");
      if (j + 1 < TJ) {
#pragma unroll
        for (int it = 0; it < 8; it++) xi[it] = xn[it];
      }
    }
  } else {
    const float* bias = (const float*)(p.ws + OFF_BIAS2) + (size_t)(l * 8 + b) * 5632;
    const float* SSX = (const float*)(p.ws + OFF_SSX);
    u16* HID = (u16*)(p.ws + OFF_HID);
    const int jbase = nbase >> 1;
#pragma unroll
    for (int j = 0; j < TJ; j++) {
      const int t = tok[j];
      const float rv = rinv_all[j];
#pragma unroll
      for (int q4 = 0; q4 < 4; q4++) {
        const int ng = nbase + 8 * q4 + 4 * hf;
        float4 bg4 = *(const float4*)(bias + ng);
        float4 bu4 = *(const float4*)(bias + ng + 32);
        float zg0 = acc[0][j][4 * q4 + 0] * rv + bg4.x, zu0 = acc[1][j][4 * q4 + 0] * rv + bu4.x;
        float zg1 = acc[0][j][4 * q4 + 1] * rv + bg4.y, zu1 = acc[1][j][4 * q4 + 1] * rv + bu4.y;
        float zg2 = acc[0][j][4 * q4 + 2] * rv + bg4.z, zu2 = acc[1][j][4 * q4 + 2] * rv + bu4.z;
        float zg3 = acc[0][j][4 * q4 + 3] * rv + bg4.w, zu3 = acc[1][j][4 * q4 + 3] * rv + bu4.w;
        float h0 = zg0 / (1.f + __expf(-zg0)) * zu0;
        float h1 = zg1 / (1.f + __expf(-zg1)) * zu1;
        float h2 = zg2 / (1.f + __expf(-zg2)) * zu2;
        float h3 = zg3 / (1.f + __expf(-zg3)) * zu3;
        st_bf4(HID + tl_idx(t, jbase + 8 * q4 + 4 * hf), h0, h1, h2, h3);
      }
    }
  }
}

template <int EPI>
DI void gemm_phase(int l, char* smem) {
  const Params p = kparams();
  constexpr int NT = (EPI == EPI_IN) ? 5 : (EPI == EPI_GLU ? 2 : (EPI == EPI_F1 ? 22 : 4));
  const int g8 = gridDim.x >> 3;
  const int xg = blockIdx.x & 7, lb = blockIdx.x >> 3;
  uint4 ra0, ra1, ra2, ra3, rb0, rb1, rb2, rb3;
  bool first = true;
  for (int q = lb; q < 16 * NT; q += g8) {
    const int mg = q / (8 * NT);
    const int rem = q - mg * 8 * NT;
    const int qn = q + g8;
    const bool has_next = qn < 16 * NT;
    const int mgn = qn / (8 * NT);
    const int remn = qn - mgn * 8 * NT;
    const int ntc = (mg & 1) ? (NT - 1 - (rem >> 3)) : (rem >> 3);
    const int ntn = (mgn & 1) ? (NT - 1 - (remn >> 3)) : (remn >> 3);
    gemm_tile<EPI>(p, l, xg * 16 + mg * 8 + (rem & 7), ntc, smem, ra0, ra1, ra2, ra3, rb0, rb1, rb2, rb3, first, has_next,
                   xg * 16 + mgn * 8 + (remn & 7), ntn);
    first = (EPI == EPI_OUT || EPI == EPI_F2);
  }
}

DI void attn_item(const Params& p, int item, char* smem) {
  u16* Ks = (u16*)smem;
  u16* Vs = Ks + 2 * 64 * 72;
  constexpr int ABUF = 64 * 72;
  const int tid = tidx(), lane = tid & 63, wave = tid >> 6;
  const int hf = lane >> 5, li = lane & 31;
  const int xcd = item & 7, local = item >> 3;
  const int pair = xcd * 2 + (local >> 5);
  const int within = local & 31;
  const int hq = within >> 3, qb = within & 7;
  const int b = pair >> 1, kvh = pair & 1, h = kvh * 4 + hq;
  const int t0 = b * 4096 + qb * 512 + wave * 64 + li;

  const u16* Q = (const u16*)(p.ws + OFF_Q);
  bf16x8 qf[2][4];
#pragma unroll
  for (int u = 0; u < 2; u++)
#pragma unroll
    for (int s = 0; s < 4; s++) qf[u][s] = *(const bf16x8*)(Q + (size_t)(t0 + 32 * u) * 512 + h * 64 + 16 * s + 8 * hf);

  f32x16 o0[2], o1[2];
  float m_run[2], l_run[2];
#pragma unroll
  for (int u = 0; u < 2; u++) {
#pragma unroll
    for (int r = 0; r < 16; r++) { o0[u][r] = 0.f; o1[u][r] = 0.f; }
    m_run[u] = -1e30f; l_run[u] = 0.f;
  }

  const int lrow = tid >> 3, lc8 = tid & 7;
  const u16* Kg = (const u16*)(p.ws + OFF_K) + (size_t)pair * 4096 * 64 + (size_t)lrow * 64 + lc8 * 8;
  const u16* Vg = (const u16*)(p.ws + OFF_VT) + (size_t)pair * 64 * 4096 + (size_t)lrow * 4096 + lc8 * 8;
  uint4 rk0, rv0;
#define ATT_GLOAD(kt_)                                                   \
  {                                                                      \
    rk0 = *(const uint4*)(Kg + (size_t)((kt_) * 64) * 64);               \
    rv0 = *(const uint4*)(Vg + (kt_) * 64);                              \
  }
  ATT_GLOAD(0);
  const int kap = (li & 0x13) | ((li & 4) << 1) | ((li & 8) >> 1);
  __syncthreads();
  *(uint4*)(Ks + (lrow) * 72 + lc8 * 8) = rk0;
  *(uint4*)(Vs + (lrow) * 72 + lc8 * 8) = rv0;
  ATT_GLOAD(1);
  __syncthreads();

  for (int kt = 0; kt < 64; kt++) {
    const int cur = (kt & 1) * ABUF;
    if (kt + 1 < 64) {
      *(uint4*)(Ks + (ABUF - cur) + (lrow) * 72 + lc8 * 8) = rk0;
      *(uint4*)(Vs + (ABUF - cur) + (lrow) * 72 + lc8 * 8) = rv0;
    }
    if (kt + 2 < 64) ATT_GLOAD(kt + 2);

    f32x16 s0[2], s1[2];
#pragma unroll
    for (int u = 0; u < 2; u++)
#pragma unroll
      for (int r = 0; r < 16; r++) { s0[u][r] = 0.f; s1[u][r] = 0.f; }
#pragma unroll
    for (int s = 0; s < 4; s++) {
      const bf16x8 kf0 = *(const bf16x8*)(Ks + cur + kap * 72 + 16 * s + 8 * hf);
      const bf16x8 kf1 = *(const bf16x8*)(Ks + cur + (32 + kap) * 72 + 16 * s + 8 * hf);
#pragma unroll
      for (int u = 0; u < 2; u++) {
        s0[u] = MFMA(kf0, qf[u][s], s0[u]);
        s1[u] = MFMA(kf1, qf[u][s], s1[u]);
      }
    }
    bf16x8 pb[2][4];
#pragma unroll
    for (int u = 0; u < 2; u++) {
      float mx = s0[u][0];
#pragma unroll
      for (int r = 1; r < 16; r++) mx = fmaxf(mx, s0[u][r]);
#pragma unroll
      for (int r = 0; r < 16; r++) mx = fmaxf(mx, s1[u][r]);
      mx = fmaxf(mx, shfl_x32(mx, hf));
      const float mnew = fmaxf(m_run[u], mx);
      const float alpha = __builtin_amdgcn_exp2f(m_run[u] - mnew);
      m_run[u] = mnew;
      float ps = 0.f;
#pragma unroll
      for (int r = 0; r < 16; r++) { s0[u][r] = __builtin_amdgcn_exp2f(s0[u][r] - mnew); ps += s0[u][r]; }
#pragma unroll
      for (int r = 0; r < 16; r++) { s1[u][r] = __builtin_amdgcn_exp2f(s1[u][r] - mnew); ps += s1[u][r]; }
      l_run[u] = l_run[u] * alpha + ps;
#pragma unroll
      for (int r = 0; r < 16; r++) { o0[u][r] *= alpha; o1[u][r] *= alpha; }
#pragma unroll
      for (int sp = 0; sp < 2; sp++) {
        uint4 ua = make_uint4(pk(s0[u][8 * sp + 0], s0[u][8 * sp + 1]), pk(s0[u][8 * sp + 2], s0[u][8 * sp + 3]),
                              pk(s0[u][8 * sp + 4], s0[u][8 * sp + 5]), pk(s0[u][8 * sp + 6], s0[u][8 * sp + 7]));
        uint4 ub = make_uint4(pk(s1[u][8 * sp + 0], s1[u][8 * sp + 1]), pk(s1[u][8 * sp + 2], s1[u][8 * sp + 3]),
                              pk(s1[u][8 * sp + 4], s1[u][8 * sp + 5]), pk(s1[u][8 * sp + 6], s1[u][8 * sp + 7]));
        pb[u][sp] = __builtin_bit_cast(bf16x8, ua);
        pb[u][2 + sp] = __builtin_bit_cast(bf16x8, ub);
      }
    }
#pragma unroll
    for (int c = 0; c < 4; c++) {
      const bf16x8 vf0 = *(const bf16x8*)(Vs + cur + li * 72 + 16 * c + 8 * hf);
      const bf16x8 vf1 = *(const bf16x8*)(Vs + cur + (32 + li) * 72 + 16 * c + 8 * hf);
#pragma unroll
      for (int u = 0; u < 2; u++) {
        o0[u] = MFMA(vf0, pb[u][c], o0[u]);
        o1[u] = MFMA(vf1, pb[u][c], o1[u]);
      }
    }
    __syncthreads();
  }
  u16* OATT = (u16*)(p.ws + OFF_OATT);
#pragma unroll
  for (int u = 0; u < 2; u++) {
    const int t = t0 + 32 * u;
    const float ltot = l_run[u] + shfl_x32(l_run[u], hf);
    const float inv = 1.f / ltot;
    float ss = 0.f;
#pragma unroll
    for (int q4 = 0; q4 < 4; q4++) {
      float a0 = o0[u][4 * q4 + 0] * inv, a1 = o0[u][4 * q4 + 1] * inv, a2 = o0[u][4 * q4 + 2] * inv, a3 = o0[u][4 * q4 + 3] * inv;
      float c0 = o1[u][4 * q4 + 0] * inv, c1 = o1[u][4 * q4 + 1] * inv, c2 = o1[u][4 * q4 + 2] * inv, c3 = o1[u][4 * q4 + 3] * inv;
      ss += a0 * a0 + a1 * a1 + a2 * a2 + a3 * a3 + c0 * c0 + c1 * c1 + c2 * c2 + c3 * c3;
      st_bf4(OATT + tl_idx(t, h * 64 + 8 * q4 + 4 * hf), a0, a1, a2, a3);
      st_bf4(OATT + tl_idx(t, h * 64 + 32 + 8 * q4 + 4 * hf), c0, c1, c2, c3);
    }
    ss += shfl_x32(ss, hf);
    if (hf == 0) ((float*)(p.ws + OFF_SSA))[(size_t)t * 8 + h] = ss;
  }
}

DI bf16x8 ssm_ufrag(const u16* U2, int bp, int g, int tb, int li, int hf) {
  const int seq = (li >> 2) & 1, step = ((li >> 3) << 2) | (li & 3);
  return *(const bf16x8*)(U2 + (((size_t)((2 * bp + seq) * 32 + g)) * 4096 + tb + step) * 16 + 8 * hf);
}

DI void ssm_scan16(const f32x16& x0, const f32x16& x1, const f32x16& x2, const f32x16& x3, const float4 a0, const float4 a1,
                   float& h0r, float& h0i, float& h1r, float& h1i, const int dir) {
  if (dir == 0) {
#pragma unroll
    for (int r = 0; r < 16; r++) {
      float nr = a0.x * h0r - a0.y * h0i + x0[r], ni = a0.x * h0i + a0.y * h0r + x2[r];
      h0r = nr; h0i = ni;
      float mr = a1.x * h1r - a1.y * h1i + x1[r], mi = a1.x * h1i + a1.y * h1r + x3[r];
      h1r = mr; h1i = mi;
    }
  } else {
#pragma unroll
    for (int r = 15; r >= 0; r--) {
      float nr = a0.x * h0r - a0.y * h0i + x0[r], ni = a0.x * h0i + a0.y * h0r + x2[r];
      h0r = nr; h0i = ni;
      float mr = a1.x * h1r - a1.y * h1i + x1[r], mi = a1.x * h1i + a1.y * h1r + x3[r];
      h1r = mr; h1i = mi;
    }
  }
}

DI void ssm1_item(const Params& p, int l, int item) {
  const int tid = vtid(), lane = tid & 63, wave = __builtin_amdgcn_readfirstlane(tid >> 6);
  const int hf = lane >> 5, li = lane & 31;
  const int w = item * 4 + wave;
  const int ch = w & 15, bp = (w >> 4) & 3, g = (w >> 6) & 31, dir = w >> 11;
  const int idx = (l * 2 + dir) * 32 + g;
  const u16* U2 = (const u16*)(p.ws + OFF_U2);
  const u16* BB = (const u16*)(p.ws + OFF_SSMBB) + (size_t)idx * 128 * 16;
  const float* SA = (const float*)(p.ws + OFF_SSMA) + (size_t)idx * 64 * 4;
  bf16x8 bbf[4];
#pragma unroll
  for (int j = 0; j < 4; j++) bbf[j] = *(const bf16x8*)(BB + (32 * j + li) * 16 + 8 * hf);
  const float4 a0 = *(const float4*)(SA + li * 4);
  const float4 a1 = *(const float4*)(SA + (li + 32) * 4);
  float h0r = 0.f, h0i = 0.f, h1r = 0.f, h1i = 0.f;
  f32x16 zero;
#pragma unroll
  for (int r = 0; r < 16; r++) zero[r] = 0.f;
#define SSM_TB(it_) (ch * 256 + (dir ? (15 - (it_)) : (it_)) * 16)
  bf16x8 q0 = ssm_ufrag(U2, bp, g, SSM_TB(0), li, hf), q1 = ssm_ufrag(U2, bp, g, SSM_TB(1), li, hf);
  bf16x8 q2 = ssm_ufrag(U2, bp, g, SSM_TB(2), li, hf), q3 = ssm_ufrag(U2, bp, g, SSM_TB(3), li, hf);
#pragma unroll 1
  for (int it = 0; it < 16; it++) {
    const bf16x8 uf = q0;
    q0 = q1; q1 = q2; q2 = q3;
    const int itn = (it + 4 < 16) ? (it + 4) : 15;
    q3 = ssm_ufrag(U2, bp, g, SSM_TB(itn), li, hf);
    f32x16 x0 = MFMA(uf, bbf[0], zero), x1 = MFMA(uf, bbf[1], zero), x2 = MFMA(uf, bbf[2], zero), x3 = MFMA(uf, bbf[3], zero);
    ssm_scan16(x0, x1, x2, x3, a0, a1, h0r, h0i, h1r, h1i, dir);
  }
  float* E = (float*)(p.ws + OFF_E) + ((((size_t)(dir * 32 + g) * 8 + (2 * bp + hf)) * 16 + ch) * 64) * 2;
  *(float2*)(E + li * 2) = make_float2(h0r, h0i);
  *(float2*)(E + (li + 32) * 2) = make_float2(h1r, h1i);
}

DI void ssm2_item(const Params& p, int l, int item, char* smem) {
  const int tid = vtid(), lane = tid & 63, wave = __builtin_amdgcn_readfirstlane(tid >> 6);
  const int hf = lane >> 5, li = lane & 31;
  const int w = item * 4 + wave;
  const int ch = w & 15, bp = (w >> 4) & 3, g = w >> 6;
  u16* Hs = (u16*)smem + wave * (32 * 136);
  const u16* U2 = (const u16*)(p.ws + OFF_U2);
  float* YF = (float*)(p.ws + OFF_ACT);
  u16* YG = (u16*)(p.ws + OFF_YG);
  f32x16 zero;
#pragma unroll
  for (int r = 0; r < 16; r++) zero[r] = 0.f;
  const int oseq = li >> 4, ostep = li & 15;
  const int ob = 2 * bp + oseq;

  for (int dir = 0; dir < 2; dir++) {
    const int idx = (l * 2 + dir) * 32 + g;
    const u16* BB = (const u16*)(p.ws + OFF_SSMBB) + (size_t)idx * 128 * 16;
    const u16* CC = (const u16*)(p.ws + OFF_SSMCC) + (size_t)idx * 16 * 128;
    const float* SA = (const float*)(p.ws + OFF_SSMA) + (size_t)idx * 64 * 4;
    bf16x8 bbf[4], ccf[8];
#pragma unroll
    for (int j = 0; j < 4; j++) bbf[j] = *(const bf16x8*)(BB + (32 * j + li) * 16 + 8 * hf);
#pragma unroll
    for (int s = 0; s < 8; s++) {
      bf16x8 v = *(const bf16x8*)(CC + (li & 15) * 128 + 16 * s + 8 * hf);
      if (li >= 16) {
#pragma unroll
        for (int e = 0; e < 8; e++) v[e] = 0;
      }
      ccf[s] = v;
    }
    const float4 a0 = *(const float4*)(SA + li * 4);
    const float4 a1 = *(const float4*)(SA + (li + 32) * 4);
    float h0r = 0.f, h0i = 0.f, h1r = 0.f, h1i = 0.f;
    {
      const float* E = (const float*)(p.ws + OFF_E) + ((((size_t)(dir * 32 + g) * 8 + (2 * bp + hf)) * 16) * 64) * 2;
      const int n = dir ? (15 - ch) : ch;
      for (int i0 = 0; i0 < n; i0 += 4) {
        float2 e0[4], e1[4];
#pragma unroll
        for (int u = 0; u < 4; u++) {
          int ii = i0 + u; if (ii > n - 1) ii = n - 1;
          const int ci = dir ? (15 - ii) : ii;
          e0[u] = *(const float2*)(E + (size_t)ci * 128 + li * 2);
          e1[u] = *(const float2*)(E + (size_t)ci * 128 + (li + 32) * 2);
        }
#pragma unroll
        for (int u = 0; u < 4; u++) {
          if (i0 + u < n) {
            float nr = a0.z * h0r - a0.w * h0i + e0[u].x, ni = a0.z * h0i + a0.w * h0r + e0[u].y;
            h0r = nr; h0i = ni;
            float mr = a1.z * h1r - a1.w * h1i + e1[u].x, mi = a1.z * h1i + a1.w * h1r + e1[u].y;
            h1r = mr; h1i = mi;
          }
        }
      }
    }
    bf16x8 ufn = ssm_ufrag(U2, bp, g, ch * 256 + (dir ? 15 : 0) * 16, li, hf);
    for (int it = 0; it < 16; it++) {
      const int tb = ch * 256 + (dir ? (15 - it) : it) * 16;
      const bf16x8 uf = ufn;
      f32x16 x0 = MFMA(uf, bbf[0], zero), x1 = MFMA(uf, bbf[1], zero), x2 = MFMA(uf, bbf[2], zero), x3 = MFMA(uf, bbf[3], zero);
      if (it + 1 < 16) ufn = ssm_ufrag(U2, bp, g, ch * 256 + (dir ? (14 - it) : (it + 1)) * 16, li, hf);
      const int tt = tb + ostep;
      const size_t yoff = (((size_t)(ob * 32 + g)) * 4096 + tt) * 16;
      float4 f0 = make_float4(0.f, 0.f, 0.f, 0.f), f1 = f0, u0 = f0, u1 = f0;
      if (dir) {
        f0 = *(const float4*)(YF + yoff + 4 * hf);
        f1 = *(const float4*)(YF + yoff + 8 + 4 * hf);
        u0 = ld_bf4(U2 + yoff + 4 * hf);
        u1 = ld_bf4(U2 + yoff + 8 + 4 * hf);
      }
      asm volatile("s_waitcnt lgkmcnt(0)" ::: "memory");
      if (dir == 0) {
#pragma unroll
        for (int r = 0; r < 16; r++) {
          float nr = a0.x * h0r - a0.y * h0i + x0[r], ni = a0.x * h0i + a0.y * h0r + x2[r];
          h0r = nr; h0i = ni;
          float mr = a1.x * h1r - a1.y * h1i + x1[r], mi = a1.x * h1i + a1.y * h1r + x3[r];
          h1r = mr; h1i = mi;
          *(unsigned*)(Hs + (hf * 16 + r) * 136 + 2 * li) = pk(h0r, h0i);
          *(unsigned*)(Hs + (hf * 16 + r) * 136 + 2 * (li + 32)) = pk(h1r, h1i);
        }
      } else {
#pragma unroll
        for (int r = 15; r >= 0; r--) {
          float nr = a0.x * h0r - a0.y * h0i + x0[r], ni = a0.x * h0i + a0.y * h0r + x2[r];
          h0r = nr; h0i = ni;
          float mr = a1.x * h1r - a1.y * h1i + x1[r], mi = a1.x * h1i + a1.y * h1r + x3[r];
          h1r = mr; h1i = mi;
          *(unsigned*)(Hs + (hf * 16 + r) * 136 + 2 * li) = pk(h0r, h0i);
          *(unsigned*)(Hs + (hf * 16 + r) * 136 + 2 * (li + 32)) = pk(h1r, h1i);
        }
      }
      asm volatile("s_waitcnt lgkmcnt(0)" ::: "memory");
      f32x16 y = zero;
#pragma unroll
      for (int s = 0; s < 8; s++) {
        bf16x8 hfv = *(const bf16x8*)(Hs + li * 136 + 16 * s + 8 * hf);
        y = MFMA(ccf[s], hfv, y);
      }
      if (dir == 0) {
        *(float4*)(YF + yoff + 4 * hf) = make_float4(y[0], y[1], y[2], y[3]);
        *(float4*)(YF + yoff + 8 + 4 * hf) = make_float4(y[4], y[5], y[6], y[7]);
      } else {
        float4 d0 = *(const float4*)(p.ssm_d + l * 512 + g * 16 + 4 * hf);
        float4 d1 = *(const float4*)(p.ssm_d + l * 512 + g * 16 + 8 + 4 * hf);
        float v[8];
        v[0] = f0.x + y[0] + d0.x * u0.x; v[1] = f0.y + y[1] + d0.y * u0.y;
        v[2] = f0.z + y[2] + d0.z * u0.z; v[3] = f0.w + y[3] + d0.w * u0.w;
        v[4] = f1.x + y[4] + d1.x * u1.x; v[5] = f1.y + y[5] + d1.y * u1.y;
        v[6] = f1.z + y[6] + d1.z * u1.z; v[7] = f1.w + y[7] + d1.w * u1.w;
#pragma unroll
        for (int e = 0; e < 8; e++) {
          float xx = v[e];
          float z = 0.7978845608028654f * (xx + 0.044715f * xx * xx * xx);
          float th = 1.f - 2.f / (__expf(2.f * z) + 1.f);
          v[e] = 0.5f * xx * (1.f + th);
        }
        u16* yg = YG + tl_idx(ob * 4096 + tt, g * 16);
        st_bf4(yg + 4 * hf, v[0], v[1], v[2], v[3]);
        st_bf4(yg + 8 + 4 * hf, v[4], v[5], v[6], v[7]);
      }
    }
    asm volatile("s_waitcnt lgkmcnt(0)" ::: "memory");
  }
}

DI void qkpost_phase(int l) {
  const Params p = kparams();
  const float* ROPE = (const float*)(p.ws + OFF_ROPE);
  const int nrows = T_TOK * 8 + T_TOK * 2;
  for (int r = blockIdx.x * 512 + tidx(); r < nrows; r += gridDim.x * 512) {
    const bool isq = r < T_TOK * 8;
    const int rk = r - T_TOK * 8;
    u16* row = isq ? ((u16*)(p.ws + OFF_Q) + (size_t)r * 64) : ((u16*)(p.ws + OFF_K) + (size_t)rk * 64);
    const int pos = isq ? ((r >> 3) & 4095) : (rk & 4095);
    const float* gn = isq ? (p.q_norm + l * 64) : (p.k_norm + l * 64);
    const float osc = isq ? QSCALE : 1.f;
    float v[64];
#pragma unroll
    for (int c = 0; c < 8; c++) {
      uint4 raw = ((const uint4*)row)[c];
      v[8 * c + 0] = __uint_as_float(raw.x << 16); v[8 * c + 1] = __uint_as_float(raw.x & 0xffff0000u);
      v[8 * c + 2] = __uint_as_float(raw.y << 16); v[8 * c + 3] = __uint_as_float(raw.y & 0xffff0000u);
      v[8 * c + 4] = __uint_as_float(raw.z << 16); v[8 * c + 5] = __uint_as_float(raw.z & 0xffff0000u);
      v[8 * c + 6] = __uint_as_float(raw.w << 16); v[8 * c + 7] = __uint_as_float(raw.w & 0xffff0000u);
    }
    float ss = 0.f;
#pragma unroll
    for (int e = 0; e < 64; e++) ss += v[e] * v[e];
    const float rn = rsqrtf(ss * (1.f / 64.f) + 1e-6f) * osc;
    const int irow = pos >> 6, icol = pos & 63;
    float tc[32], ts[32];
#pragma unroll
    for (int q = 0; q < 4; q++) {
      const float4 c0 = *(const float4*)(ROPE + irow * 16 + 4 * q), s0 = *(const float4*)(ROPE + 1024 + irow * 16 + 4 * q);
      const float4 c1 = *(const float4*)(ROPE + icol * 16 + 4 * q), s1 = *(const float4*)(ROPE + 1024 + icol * 16 + 4 * q);
      tc[4 * q + 0] = c0.x; tc[4 * q + 1] = c0.y; tc[4 * q + 2] = c0.z; tc[4 * q + 3] = c0.w;
      ts[4 * q + 0] = s0.x; ts[4 * q + 1] = s0.y; ts[4 * q + 2] = s0.z; ts[4 * q + 3] = s0.w;
      tc[16 + 4 * q + 0] = c1.x; tc[16 + 4 * q + 1] = c1.y; tc[16 + 4 * q + 2] = c1.z; tc[16 + 4 * q + 3] = c1.w;
      ts[16 + 4 * q + 0] = s1.x; ts[16 + 4 * q + 1] = s1.y; ts[16 + 4 * q + 2] = s1.z; ts[16 + 4 * q + 3] = s1.w;
    }
#pragma unroll
    for (int c = 0; c < 8; c++) {
      float o[8];
#pragma unroll
      for (int e = 0; e < 4; e++) {
        const int pi = 4 * c + e;
        const float cs = tc[pi], sn = ts[pi];
        const float y0 = v[2 * pi] * rn * gn[2 * pi], y1 = v[2 * pi + 1] * rn * gn[2 * pi + 1];
        o[2 * e] = y0 * cs - y1 * sn;
        o[2 * e + 1] = y0 * sn + y1 * cs;
      }
      uint4 w;
      w.x = pk(o[0], o[1]); w.y = pk(o[2], o[3]); w.z = pk(o[4], o[5]); w.w = pk(o[6], o[7]);
      ((uint4*)row)[c] = w;
    }
  }
}

DI void attn_phase(char* smem) {
  const Params p = kparams();
  for (int lq = blockIdx.x >> 3; lq < 64; lq += (gridDim.x >> 3)) attn_item(p, (blockIdx.x & 7) + 8 * lq, smem);
}
DI void ssm1_phase(int l) {
  const Params p = kparams();
  for (int it = blockIdx.x * 2 + vhalf(); it < 1024; it += gridDim.x * 2) ssm1_item(p, l, it);
}
DI void ssm2_phase(int l, char* smem) {
  const Params p = kparams();
  char* sm = smem + vhalf() * 40960;
  for (int it = blockIdx.x * 2 + vhalf(); it < 512; it += gridDim.x * 2) ssm2_item(p, l, it, sm);
}

DI void final_phase() {
  const Params p = kparams();
  const float* X = (const float*)(p.ws + OFF_X);
  const float* SSX = (const float*)(p.ws + OFF_SSX);
  const int total = T_TOK * 256;
  for (int i = blockIdx.x * 512 + tidx(); i < total; i += gridDim.x * 512) {
    int t = i >> 8, n = (i & 255) * 4;
    float rv = row_rinv16(SSX, t, 1.f / 1024.f);
    float4 x = *(const float4*)(X + (size_t)t * 1024 + n);
    float4 g = *(const float4*)(p.final_norm + n);
    float4 o;
    o.x = x.x * rv * g.x; o.y = x.y * rv * g.y; o.z = x.z * rv * g.z; o.w = x.w * rv * g.w;
    *(float4*)(p.out + (size_t)t * 1024 + n) = o;
  }
}

#define XB_TMO      128
#define XB_XCNT(j)  (256  + 64 * (j))
#define XB_XSUB(j)  (1280 + 64 * (j))
#define XB_XGEN(j)  (2304 + 64 * (j))
#define XB_TOP      3328
#define XB_TOPGEN   3392
#define XCD_BAR_WORDS 3456
#define XB_SPIN_CAP (1u << 18)
#define LAS __attribute__((address_space(3)))

__device__ __forceinline__ unsigned xb_ld(unsigned* p)              { return __hip_atomic_load(p, __ATOMIC_RELAXED, __HIP_MEMORY_SCOPE_AGENT); }
__device__ __forceinline__ unsigned xb_add(unsigned* p, unsigned v) { return __hip_atomic_fetch_add(p, v, __ATOMIC_RELAXED, __HIP_MEMORY_SCOPE_AGENT); }
__device__ __forceinline__ unsigned xb_xcc_id() { return (unsigned)__builtin_amdgcn_s_getreg((3 << 11) | 20) & 0xFu; }
#define XB_SPIN(cond, bar) do { unsigned _sp = 0; while (cond) { __builtin_amdgcn_s_sleep(1); \
    if ((++_sp & 255u) == 0u) { if (xb_ld(&(bar)[XB_TMO])) break; if (_sp > XB_SPIN_CAP) { atomicAdd(&(bar)[XB_TMO], 1u); break; } } } } while (0)

struct XcdBarrier {
    unsigned* bar; unsigned x;
    volatile LAS unsigned* st;
};

__device__ __forceinline__ XcdBarrier xcd_barrier_post(unsigned* bar, volatile LAS unsigned* st) {
    XcdBarrier b; b.bar = bar; b.x = xb_xcc_id(); b.st = st;
    if (threadIdx.x == 0) (void)xb_add(&bar[XB_XCNT(b.x)], 1u);
    return b;
}
__device__ __forceinline__ void xcd_barrier_complete(unsigned* bar, unsigned x, unsigned& nloc, unsigned& nx) {
    const unsigned G = gridDim.x * gridDim.y * gridDim.z;
    unsigned sum, cnt, mine, sp = 0u;
    for (;;) {
        sum = 0u; cnt = 0u; mine = 0u;
#pragma unroll
        for (unsigned j = 0; j < 16; ++j) { const unsigned c = xb_ld(&bar[XB_XCNT(j)]); sum += c; cnt += (c > 0u) ? 1u : 0u; mine = (j == x) ? c : mine; }
        if (sum == G) break;
        __builtin_amdgcn_s_sleep(1);
        if ((++sp & 255u) == 0u) { if (xb_ld(&bar[XB_TMO])) break; if (sp > XB_SPIN_CAP) { atomicAdd(&bar[XB_TMO], 1u); break; } }
    }
    nloc = mine > 0u ? mine : 1u; nx = cnt > 0u ? cnt : 1u;
}

__device__ __forceinline__ void xcd_barrier(const XcdBarrier& b) {
    asm volatile("s_waitcnt vmcnt(0)" ::: "memory");
    __syncthreads();
    if (threadIdx.x == 0) {
        unsigned* bar = b.bar;
        __builtin_amdgcn_s_waitcnt(0);
        unsigned nloc = b.st[0], nx = b.st[1];
        if (nloc == 0u) { xcd_barrier_complete(bar, b.x, nloc, nx); b.st[0] = nloc; b.st[1] = nx; }
        const unsigned old = xb_add(&bar[XB_XSUB(b.x)], 1u);
        const unsigned gen = old / nloc;
        if (old + 1u == (gen + 1u) * nloc) {
            __builtin_amdgcn_fence(__ATOMIC_RELEASE, "agent");
            asm volatile("s_waitcnt vmcnt(0)" ::: "memory");
            const unsigned og = xb_add(&bar[XB_TOP], 1u);
            const unsigned tg = og / nx;
            if (og + 1u == (tg + 1u) * nx) xb_add(&bar[XB_TOPGEN], 1u);
            else XB_SPIN(xb_ld(&bar[XB_TOPGEN]) == tg, bar);
            __builtin_amdgcn_fence(__ATOMIC_ACQUIRE, "agent");
            xb_add(&bar[XB_XGEN(b.x)], 1u);
            asm volatile("s_waitcnt vmcnt(0)" ::: "memory");
        } else {
            XB_SPIN(xb_ld(&bar[XB_XGEN(b.x)]) == gen, bar);
            __builtin_amdgcn_fence(__ATOMIC_ACQUIRE, "agent");
            asm volatile("s_waitcnt vmcnt(0)" ::: "memory");
        }
    }
    __syncthreads();
}
#define GSYNC() do { XcdBarrier xb_; xb_.bar = (unsigned*)(kparams().ws + OFF_BAR); xb_.x = xb_xcc_id(); xb_.st = (volatile LAS unsigned*)xb_words; xcd_barrier(xb_); } while (0)

__global__ void __launch_bounds__(512) mega(Params p_) {
  __shared__ __attribute__((aligned(16))) char smem[147456];
  cg::grid_group grid = cg::this_grid();
  __shared__ __attribute__((aligned(16))) unsigned xb_words[4];
  if (tidx() < 4) xb_words[tidx()] = 0u;
  __syncthreads();
  if (p_.ph_lo < 0) grid.sync();
  (void)xcd_barrier_post((unsigned*)(p_.ws + OFF_BAR), (volatile LAS unsigned*)xb_words);
  int ph = p_.ph_lo;
  const int ph_hi = p_.ph_hi;
  if (ph == 0 && ph < ph_hi) {
    phase0(smem);
    ph++;
    if (ph < ph_hi) GSYNC();
  }
  if (ph == 1 && ph < ph_hi) {
    phase1(smem);
    ph++;
    if (ph < ph_hi) GSYNC();
  }
  for (; ph < ph_hi && ph < NPHASE - 1; ph++) {
    const int l = (ph - 2) / 7, k = (ph - 2) % 7;
    if (k == 0) gemm_phase<EPI_IN>(l, smem);
    else if (k == 1) { qkpost_phase(l); ssm1_phase(l); }
    else if (k == 2) {
      const int first = (blockIdx.x >> 3) & 1;
      for (int s2 = 0; s2 < 2; s2++) {
        __syncthreads();
        if ((s2 ^ first) == 0) attn_phase(smem);
        else ssm2_phase(l, smem);
      }
    }
    else if (k == 3) gemm_phase<EPI_GLU>(l, smem);
    else if (k == 4) gemm_phase<EPI_OUT>(l, smem);
    else if (k == 5) gemm_phase<EPI_F1>(l, smem);
    else gemm_phase<EPI_F2>(l, smem);
    if (ph + 1 < ph_hi) GSYNC();
  }
  if (ph == NPHASE - 1 && ph < ph_hi) final_phase();
}

extern "C" void kernel_launch(void* const* d_in, const int* in_sizes, int n_in, void* d_out, int out_size, void* d_ws,
                              size_t ws_size, hipStream_t stream) {
  static int grid_blocks = 0;
  if (!grid_blocks) {
    int dev = 0, cus = 0;
    (void)hipGetDevice(&dev);
    (void)hipDeviceGetAttribute(&cus, hipDeviceAttributeMultiprocessorCount, dev);
    grid_blocks = cus;
    if (grid_blocks < 8 || (grid_blocks & 7)) grid_blocks = 256;
    if (ws_size < WS_TOTAL) fprintf(stderr, "kernel_launch: workspace too small: %zu < %zu\n", ws_size, (size_t)WS_TOTAL);
  }
  if (ws_size < WS_TOTAL) return;
  Params p{};
  const float** pp = (const float**)&p;
  for (int i = 0; i < 25; i++) pp[i] = (const float*)d_in[i];
  p.out = (float*)d_out;
  p.ws = (char*)d_ws;
  p.ph_lo = 0;
  p.ph_hi = NPHASE;
  (void)hipMemsetAsync((char*)d_ws + OFF_BAR, 0, 16384, stream);
  void* args[] = {&p};
  hipError_t e = hipLaunchCooperativeKernel((void*)mega, dim3(grid_blocks), dim3(512), args, 0, stream);
  if (e != hipSuccess) fprintf(stderr, "cooperative launch failed: %s (grid %d)\n", hipGetErrorString(e), grid_blocks);
}
```
